# Optimizing an MI355X kernel written in HIP

```python
import jax
import jax.numpy as jnp
from jax import lax
import numpy as np

D_MODEL = 1024
BATCH = 4
SEQ = 8192
DEPTH = 2

D_MIX = D_MODEL
SB_HEAD_DIM = 64
D_SB = D_MIX // 2
SB_HEADS = D_SB // SB_HEAD_DIM
BLOCK_Q = 128
D_LRU = D_MIX // 4
LRU_BLOCKS = 4
LRU_BLOCK = D_LRU // LRU_BLOCKS
LRU_CONV_WIDTH = 4
LRU_C = 8.0
D_CONF = D_MIX // 4
CONF_CONV_WIDTH = 31
D_IN = 3 * D_SB + 2 * D_LRU + 2 * D_CONF
N_GROUPS = 4
EXPERTS_PER_GROUP = 8
N_EXPERTS = N_GROUPS * EXPERTS_PER_GROUP
TOP_K_FINE = 2
D_EXPERT = D_MODEL // 2
MOE_BLOCK = 256
EPS = 1e-6

kernel_name = 'hybrid_stickbreak_rglru_conformer_hmoe'


def rms_norm(x, g):
    xf = x.astype(jnp.float32)
    y = xf * lax.rsqrt(jnp.mean(xf * xf, axis=-1, keepdims=True) + EPS)
    return (y * g.astype(jnp.float32)).astype(x.dtype)


def layer_norm(x, g, b):
    xf = x.astype(jnp.float32)
    mu = jnp.mean(xf, axis=-1, keepdims=True)
    xc = xf - mu
    var = jnp.mean(xc * xc, axis=-1, keepdims=True)
    return xc * lax.rsqrt(var + EPS) * g.astype(jnp.float32) + b.astype(jnp.float32)


def causal_depthwise_conv(x, w, b):
    k_width, chans = w.shape
    y = lax.conv_general_dilated(
        x, w.astype(x.dtype)[:, None, :], window_strides=(1,),
        padding=[(k_width - 1, 0)], dimension_numbers=('NWC', 'WIO', 'NWC'),
        feature_group_count=chans)
    return y + b.astype(x.dtype)


def stick_breaking_attention(q, k, v):
    seq = q.shape[2]
    scale = SB_HEAD_DIM ** -0.5
    outs = []
    for i in range(seq // BLOCK_Q):
        q0 = i * BLOCK_Q
        kv_len = q0 + BLOCK_Q
        qb = q[:, :, q0:kv_len]
        kb = k[:, :, :kv_len]
        vb = v[:, :, :kv_len]
        z = jnp.einsum('bhqd,bhkd->bhqk', qb, kb, preferred_element_type=jnp.float32) * scale
        t_pos = q0 + jnp.arange(BLOCK_Q, dtype=jnp.int32)[:, None]
        s_pos = jnp.arange(kv_len, dtype=jnp.int32)[None, :]
        mask = s_pos < t_pos
        log_keep = jnp.where(mask, jax.nn.log_sigmoid(-z), 0.0)
        suffix = lax.cumsum(log_keep, axis=3, reverse=True) - log_keep
        wts = jnp.where(mask, jnp.exp(jax.nn.log_sigmoid(z) + suffix), 0.0)
        outs.append(jnp.einsum('bhqk,bhkd->bhqd', wts.astype(vb.dtype), vb))
    return jnp.concatenate(outs, axis=2)


def _linear_combine(c1, c2):
    a1, b1 = c1
    a2, b2 = c2
    return a1 * a2, a2 * b1 + b2


def rg_lru_branch(xr, xg, conv_w, conv_b, wa, ba, wx, bx, lam):
    f32 = jnp.float32
    bsz, seq, _ = xr.shape
    xr = causal_depthwise_conv(xr, conv_w, conv_b)
    xblk = xr.reshape(bsz, seq, LRU_BLOCKS, LRU_BLOCK)
    gate_r = jnp.einsum('bsnc,ncd->bsnd', xblk, wa).reshape(bsz, seq, D_LRU) + ba
    gate_i = jnp.einsum('bsnc,ncd->bsnd', xblk, wx).reshape(bsz, seq, D_LRU) + bx
    log_a = LRU_C * jax.nn.sigmoid(gate_r.astype(f32)) * jax.nn.log_sigmoid(lam.astype(f32))
    a = jnp.exp(log_a)
    u = jnp.sqrt(-jnp.expm1(2.0 * log_a)) * (jax.nn.sigmoid(gate_i.astype(f32)) * xr.astype(f32))
    _, h = lax.associative_scan(_linear_combine, (a, u), axis=1)
    return (h * jax.nn.gelu(xg.astype(f32))).astype(xr.dtype)


def conformer_conv(xc, dw_w, dw_b, ln_g, ln_b, pw_w, pw_b):
    val, gate = jnp.split(xc, 2, axis=-1)
    u = val * jax.nn.sigmoid(gate)
    u = causal_depthwise_conv(u, dw_w, dw_b)
    u = jax.nn.silu(layer_norm(u, ln_g, ln_b)).astype(xc.dtype)
    return jnp.einsum('bsc,ce->bse', u, pw_w) + pw_b


def hierarchical_moe(h, w_coarse, w_fine, w_gate, w_up, w_down):
    n_tok, d = h.shape
    f32 = jnp.float32
    logits_c = jnp.einsum('nd,dg->ng', h, w_coarse, preferred_element_type=f32)
    probs_c = jax.nn.softmax(logits_c, axis=-1)
    grp = jnp.argmax(logits_c, axis=-1).astype(jnp.int32)
    w_grp = jnp.take_along_axis(probs_c, grp[:, None], axis=-1)
    logits_f = jnp.einsum('nd,de->ne', h, w_fine, preferred_element_type=f32)
    logits_f = logits_f.reshape(n_tok, N_GROUPS, EXPERTS_PER_GROUP)
    logits_f = jnp.take_along_axis(logits_f, grp[:, None, None], axis=1)[:, 0]
    top_val, top_idx = lax.top_k(logits_f, TOP_K_FINE)
    gate = (jax.nn.softmax(top_val, axis=-1) * w_grp).astype(h.dtype)
    expert = grp[:, None] * EXPERTS_PER_GROUP + top_idx.astype(jnp.int32)

    n_asg = n_tok * TOP_K_FINE
    flat_e = expert.reshape(n_asg)
    flat_tok = jnp.repeat(jnp.arange(n_tok, dtype=jnp.int32), TOP_K_FINE)
    flat_gate = gate.reshape(n_asg)
    order = jnp.argsort(flat_e)
    sorted_e = flat_e[order]
    counts = jnp.bincount(flat_e, length=N_EXPERTS).astype(jnp.int32)
    padded = (counts + MOE_BLOCK - 1) // MOE_BLOCK * MOE_BLOCK
    starts = jnp.cumsum(counts) - counts
    padded_ends = jnp.cumsum(padded)
    padded_starts = padded_ends - padded
    dest = padded_starts[sorted_e] + jnp.arange(n_asg, dtype=jnp.int32) - starts[sorted_e]
    n_blocks = -(-n_asg // MOE_BLOCK) + N_EXPERTS
    n_slots = n_blocks * MOE_BLOCK
    slot_tok = jnp.full((n_slots,), n_tok, jnp.int32).at[dest].set(flat_tok[order])
    slot_gate = jnp.zeros((n_slots,), h.dtype).at[dest].set(flat_gate[order])
    block_start = jnp.arange(n_blocks, dtype=jnp.int32) * MOE_BLOCK
    block_e = jnp.minimum(jnp.searchsorted(padded_ends, block_start, side='right'),
                          N_EXPERTS - 1).astype(jnp.int32)
    h_pad = jnp.concatenate([h, jnp.zeros((1, d), h.dtype)], axis=0)
    xb = h_pad[slot_tok].reshape(n_blocks, MOE_BLOCK, d)

    def run_block(args):
        xe, e = args
        return (jax.nn.silu(xe @ w_gate[e]) * (xe @ w_up[e])) @ w_down[e]

    yb = lax.map(run_block, (xb, block_e)).reshape(n_slots, d)
    y = jnp.zeros((n_tok + 1, d), yb.dtype).at[slot_tok].add(yb * slot_gate[:, None])
    return y[:n_tok]


def setup_inputs(seed: int = 0) -> dict:
    key = jax.random.key(seed)
    ks = jax.random.split(key, 28)
    f32 = jnp.float32
    L = DEPTH

    def nrm(k, shape, scale):
        return jax.random.normal(k, shape, f32) * scale

    def gain(k, shape):
        return 1.0 + 0.05 * jax.random.normal(k, shape, f32)

    a_c = jax.random.uniform(ks[11], (L, D_LRU), f32, 0.9, 0.999)
    a0 = a_c ** (1.0 / LRU_C)
    lam = jnp.log(a0) - jnp.log1p(-a0)

    return {
        'x': jax.random.normal(ks[0], (BATCH, SEQ, D_MODEL), f32),
        'norm1_g': gain(ks[1], (L, D_MODEL)),
        'w_in': nrm(ks[2], (L, D_MODEL, D_IN), D_MODEL ** -0.5),
        'q_norm_g': gain(ks[3], (L, SB_HEAD_DIM)),
        'k_norm_g': gain(ks[4], (L, SB_HEAD_DIM)),
        'lru_conv_w': nrm(ks[5], (L, LRU_CONV_WIDTH, D_LRU), LRU_CONV_WIDTH ** -0.5),
        'lru_conv_b': nrm(ks[6], (L, D_LRU), 0.02),
        'lru_wa': nrm(ks[7], (L, LRU_BLOCKS, LRU_BLOCK, LRU_BLOCK), LRU_BLOCK ** -0.5),
        'lru_ba': nrm(ks[8], (L, D_LRU), 0.02),
        'lru_wx': nrm(ks[9], (L, LRU_BLOCKS, LRU_BLOCK, LRU_BLOCK), LRU_BLOCK ** -0.5),
        'lru_bx': nrm(ks[10], (L, D_LRU), 0.02),
        'lru_lambda': lam,
        'conf_dw_w': nrm(ks[12], (L, CONF_CONV_WIDTH, D_CONF), CONF_CONV_WIDTH ** -0.5),
        'conf_dw_b': nrm(ks[13], (L, D_CONF), 0.02),
        'conf_ln_g': gain(ks[14], (L, D_CONF)),
        'conf_ln_b': nrm(ks[15], (L, D_CONF), 0.02),
        'conf_pw_w': nrm(ks[16], (L, D_CONF, D_CONF), D_CONF ** -0.5),
        'conf_pw_b': nrm(ks[17], (L, D_CONF), 0.02),
        'out_norm_g': gain(ks[18], (L, D_MIX)),
        'w_out': nrm(ks[19], (L, D_MIX, D_MODEL), D_MIX ** -0.5),
        'norm2_g': gain(ks[20], (L, D_MODEL)),
        'router_coarse': nrm(ks[21], (L, D_MODEL, N_GROUPS), D_MODEL ** -0.5),
        'router_fine': nrm(ks[22], (L, D_MODEL, N_EXPERTS), D_MODEL ** -0.5),
        'exp_w_gate': nrm(ks[23], (L, N_EXPERTS, D_MODEL, D_EXPERT), D_MODEL ** -0.5),
        'exp_w_up': nrm(ks[24], (L, N_EXPERTS, D_MODEL, D_EXPERT), D_MODEL ** -0.5),
        'exp_w_down': nrm(ks[25], (L, N_EXPERTS, D_EXPERT, D_MODEL), D_EXPERT ** -0.5),
    }


def reference(x, norm1_g, w_in, q_norm_g, k_norm_g, lru_conv_w, lru_conv_b, lru_wa, lru_ba,
              lru_wx, lru_bx, lru_lambda, conf_dw_w, conf_dw_b, conf_ln_g, conf_ln_b,
              conf_pw_w, conf_pw_b, out_norm_g, w_out, norm2_g, router_coarse, router_fine,
              exp_w_gate, exp_w_up, exp_w_down):
    bsz, seq, d = x.shape
    splits = [D_SB, 2 * D_SB, 3 * D_SB, 3 * D_SB + D_LRU, 3 * D_SB + 2 * D_LRU]
    for l in range(DEPTH):
        h = rms_norm(x, norm1_g[l])
        proj = jnp.einsum('bsd,de->bse', h, w_in[l])
        q, k, v, xr, xg, xc = jnp.split(proj, splits, axis=-1)
        q = rms_norm(q.reshape(bsz, seq, SB_HEADS, SB_HEAD_DIM), q_norm_g[l]).transpose(0, 2, 1, 3)
        k = rms_norm(k.reshape(bsz, seq, SB_HEADS, SB_HEAD_DIM), k_norm_g[l]).transpose(0, 2, 1, 3)
        v = v.reshape(bsz, seq, SB_HEADS, SB_HEAD_DIM).transpose(0, 2, 1, 3)
        y_a = stick_breaking_attention(q, k, v).transpose(0, 2, 1, 3).reshape(bsz, seq, D_SB)
        y_b = rg_lru_branch(xr, xg, lru_conv_w[l], lru_conv_b[l], lru_wa[l], lru_ba[l],
                            lru_wx[l], lru_bx[l], lru_lambda[l])
        y_c = conformer_conv(xc, conf_dw_w[l], conf_dw_b[l], conf_ln_g[l], conf_ln_b[l],
                             conf_pw_w[l], conf_pw_b[l])
        g_out = out_norm_g[l]
        y = jnp.concatenate([
            rms_norm(y_a, g_out[:D_SB]),
            rms_norm(y_b, g_out[D_SB:D_SB + D_LRU]),
            rms_norm(y_c, g_out[D_SB + D_LRU:]),
        ], axis=-1)
        x = x + jnp.einsum('bse,ed->bsd', y, w_out[l])
        h2 = rms_norm(x, norm2_g[l]).reshape(bsz * seq, d)
        x = x + hierarchical_moe(h2, router_coarse[l], router_fine[l], exp_w_gate[l],
                                 exp_w_up[l], exp_w_down[l]).reshape(bsz, seq, d)
    return x
```

```cpp
#define MK_PER_PHASE 1
#include <hip/hip_runtime.h>
#include <cstdio>
#include <cstdint>
namespace pg8 {
#define PG8_LAS __attribute__((address_space(3)))
typedef unsigned short bf16_t;
typedef short bf16x8 __attribute__((ext_vector_type(8)));
typedef float f32x4 __attribute__((ext_vector_type(4)));
typedef unsigned u32x4 __attribute__((ext_vector_type(4)));
constexpr int BM = 256, BK = 64, HALF = 128, HTB = HALF * BK * 2  , STAGE_BYTES = 8 * HTB, NXCD = 8, WGM = 8;

__host__ __device__ __forceinline__ int lds_byte(int r, int c) { const int st = (r >> 4) * 2 + (c >> 5), rr = r & 15, cc = c & 31, ob = rr * 64 + cc * 2; return st * 1024 + (ob ^ (((ob >> 9) & 1) << 5)); }
__host__ __device__ __forceinline__ void stage_rc(int b, int& R, int& C) { const int st = b / 1024, sb = b % 1024, swz = sb ^ (((sb >> 9) & 1) << 5); R = (st >> 1) * 16 + swz / 64; C = (st & 1) * 32 + (swz % 64) / 2; }
__host__ __device__ __forceinline__ int perm32(int rho) { const int n = rho >> 4, i = rho & 15; return 8 * (i >> 2) + 4 * n + (i & 3); }

struct Unit { int pm, pn; };
struct Gemm { const bf16_t* A; const bf16_t* Bt; int M, N, K; };

struct StaticOrder {
    int nM, nN, nwg, G, c;
    __host__ __device__ void init(int M, int N, int G_, int c_) { nM = M / BM; nN = N / BM; nwg = nM * nN; G = G_; c = c_; }
    __host__ __device__ bool next(int i, Unit& u) const {
        const long L = (long)i * G + c; if (L >= nwg) return false;
        int wgid = (int)L; { const int q = nwg / NXCD, r = nwg % NXCD, xcd = wgid % NXCD, off = wgid / NXCD; wgid = (xcd < r ? xcd * (q + 1) : r * (q + 1) + (xcd - r) * q) + off; }
        const int nig = WGM * nN, gid = wgid / nig, fm = gid * WGM, gsz = (nM - fm) < WGM ? (nM - fm) : WGM;
        u.pm = fm + ((wgid % nig) % gsz); u.pn = (wgid % nig) / gsz; return true;
    }
    __device__ __forceinline__ void a_ready(const Unit&) const {}
    __device__ __forceinline__ void done(const Unit&) const {}
};
__device__ __forceinline__ unsigned cvt_pk_bf16(float lo, float hi) { unsigned r; asm volatile("v_cvt_pk_bf16_f32 %0, %1, %2" : "=v"(r) : "v"(lo), "v"(hi)); return r; }
typedef float f32x2 __attribute__((ext_vector_type(2)));
typedef float f32x2 __attribute__((ext_vector_type(2)));
typedef unsigned u32x2 __attribute__((ext_vector_type(2)));
struct EpiProj {
    static constexpr bool PERM = true, AFTER_DRAIN = false;
    bf16_t* P; const float* rs; const float* gq; const float* gk; int ldp; float qscale;
    __device__ __forceinline__ void operator()(const f32x4 (&acc)[2][2][4][2], const Unit& u, int wr, int wc, int fr, int fq) const {
        const int pn = u.pn; const bool headnorm = pn < 4;
        f32x4 g[2][2];
        if (headnorm) { const float* gp = (pn < 2) ? gq : gk; const float s = (pn < 2) ? qscale : 1.0f;
#pragma unroll
            for (int bj = 0; bj < 2; ++bj)
#pragma unroll
                for (int n = 0; n < 2; ++n) g[bj][n] = *(const f32x4*)(gp + 32 * bj + 8 * fq + 4 * n) * s; }
#pragma unroll
        for (int ai = 0; ai < 2; ++ai)
#pragma unroll
            for (int m = 0; m < 4; ++m) {
                asm volatile("" ::: "memory");
                const int row = u.pm * BM + ai * HALF + wr * 64 + m * 16 + fr; const float r = rs[row];
                f32x4 v[2][2];
#pragma unroll
                for (int bj = 0; bj < 2; ++bj)
#pragma unroll
                    for (int n = 0; n < 2; ++n) v[bj][n] = acc[ai][bj][m][n] * r;
                if (headnorm) { float ss = 0.f;
#pragma unroll
                    for (int bj = 0; bj < 2; ++bj)
#pragma unroll
                        for (int n = 0; n < 2; ++n) { const f32x4 x = v[bj][n]; ss += (x[0] * x[0] + x[1] * x[1]) + (x[2] * x[2] + x[3] * x[3]); }
                    ss += __shfl_xor(ss, 16); ss += __shfl_xor(ss, 32);
                    const float sc = __builtin_amdgcn_rsqf(ss * (1.0f / 64.0f) + 1e-6f);
#pragma unroll
                    for (int bj = 0; bj < 2; ++bj)
#pragma unroll
                        for (int n = 0; n < 2; ++n) v[bj][n] = v[bj][n] * g[bj][n] * sc; }
                bf16_t* rowp = P + (size_t)row * ldp + pn * BM + 64 * wc + 8 * fq;
#pragma unroll
                for (int bj = 0; bj < 2; ++bj) { u32x4 w; w.x = cvt_pk_bf16(v[bj][0][0], v[bj][0][1]); w.y = cvt_pk_bf16(v[bj][0][2], v[bj][0][3]); w.z = cvt_pk_bf16(v[bj][1][0], v[bj][1][1]); w.w = cvt_pk_bf16(v[bj][1][2], v[bj][1][3]);
                    *(u32x4*)(rowp + 32 * bj) = w; }
            }
    }
};
struct EpiResid {
    static constexpr bool PERM = false, AFTER_DRAIN = false;
    const float* base; float* out; int ldc;
    __device__ __forceinline__ void operator()(const f32x4 (&acc)[2][2][4][2], const Unit& u, int wr, int wc, int fr, int fq) const {
        const int col0 = u.pn * BM + wc * 32 + 4 * fq;
#pragma unroll
        for (int ai = 0; ai < 2; ++ai)
#pragma unroll
            for (int m = 0; m < 4; ++m) { const size_t off = (size_t)(u.pm * BM + ai * HALF + wr * 64 + m * 16 + fr) * ldc + col0;
                f32x4 b[2][2];
#pragma unroll
                for (int bj = 0; bj < 2; ++bj)
#pragma unroll
                    for (int n = 0; n < 2; ++n) b[bj][n] = *(const f32x4*)(base + off + bj * HALF + n * 16);
#pragma unroll
                for (int bj = 0; bj < 2; ++bj)
#pragma unroll
                    for (int n = 0; n < 2; ++n) *(f32x4*)(out + off + bj * HALF + n * 16) = b[bj][n] + acc[ai][bj][m][n];
                if (m & 1) asm volatile("" ::: "memory"); }
    }
};
struct EpiSwiglu {
    static constexpr bool PERM = true, AFTER_DRAIN = false;
    bf16_t* H; const float* rs; int ldh;
    __device__ __forceinline__ void operator()(const f32x4 (&acc)[2][2][4][2], const Unit& u, int wr, int wc, int fr, int fq) const {
        const int col0 = (u.pn & 3) * 128 + 16 * wc + 4 * fq;
#pragma unroll
        for (int ai = 0; ai < 2; ++ai)
#pragma unroll
            for (int m = 0; m < 4; ++m) { const int row = u.pm * BM + ai * HALF + wr * 64 + m * 16 + fr; const float r = rs[row];
#pragma unroll
                for (int bj = 0; bj < 2; ++bj) { const f32x4 g = acc[ai][bj][m][0] * r, up = acc[ai][bj][m][1] * r; float h[4];
#pragma unroll
                    for (int i = 0; i < 4; ++i) h[i] = g[i] * __builtin_amdgcn_rcpf(1.0f + __builtin_amdgcn_exp2f(-1.4426950408889634f * g[i])) * up[i];
                    u32x2 w; w.x = cvt_pk_bf16(h[0], h[1]); w.y = cvt_pk_bf16(h[2], h[3]);
                    *(u32x2*)(H + (size_t)row * ldh + col0 + 64 * bj) = w; } }
    }
};
struct EpiGate {
    static constexpr bool PERM = true, AFTER_DRAIN = false;
    bf16_t* O; const float* gate; int ldo;
    __device__ __forceinline__ void operator()(const f32x4 (&acc)[2][2][4][2], const Unit& u, int wr, int wc, int fr, int fq) const {
        const int col0 = (u.pn & 3) * BM + wc * 32 + 8 * fq;
#pragma unroll
        for (int ai = 0; ai < 2; ++ai)
#pragma unroll
            for (int m = 0; m < 4; ++m) { const int row = u.pm * BM + ai * HALF + wr * 64 + m * 16 + fr; const float gt = gate[row];
#pragma unroll
                for (int bj = 0; bj < 2; ++bj) { const f32x4 v0 = acc[ai][bj][m][0] * gt, v1 = acc[ai][bj][m][1] * gt;
                    u32x4 w; w.x = cvt_pk_bf16(v0[0], v0[1]); w.y = cvt_pk_bf16(v0[2], v0[3]); w.z = cvt_pk_bf16(v1[0], v1[1]); w.w = cvt_pk_bf16(v1[2], v1[3]);
                    *(u32x4*)(O + (size_t)row * ldo + col0 + bj * HALF) = w; } }
    }
};
struct MoeOrder {
    int nunits, G, c; const PG8_LAS int* tile_e;
    __device__ __forceinline__ bool next(int i, Unit& u) const { const int L = i * G + c; if (L >= nunits) return false; const int rt = L >> 2; u.pm = rt; u.pn = tile_e[rt] * 4 + (L & 3); return true; }
    __device__ __forceinline__ void a_ready(const Unit&) const {}
    __device__ __forceinline__ void done(const Unit&) const {}
};
template <class Epi, class Sched, bool ALIGN_EPI = false, bool SP2 = false>
__device__ __forceinline__ void gemm_phase(PG8_LAS unsigned char* lds, const Gemm g, const Sched& S, const Epi& E) {
    int tid_ = threadIdx.x; asm volatile("" : "+v"(tid_));
    const int tid = tid_, wid = __builtin_amdgcn_readfirstlane(tid >> 6), lane = tid & 63, wr = wid >> 2, wc = wid & 3, fr = lane & 15, fq = lane >> 4;
    const int K = g.K, nt = K / BK;
    unsigned voffA[2], voffB[2];
#pragma unroll
    for (int i = 0; i < 2; ++i) { int R, C; stage_rc(tid * 16 + i * 8192, R, C); const int Rb = Epi::PERM ? ((R & ~31) + perm32(R & 31)) : R;
        voffA[i] = (unsigned)(R * K + C) * 2u; voffB[i] = (unsigned)(Rb * K + C) * 2u; }
    const size_t kstep = (size_t)(BK * 2);
    const size_t hstep = (size_t)HALF * K * 2;
    const size_t tstep = 2 * hstep;
    const unsigned ldsw = (unsigned)wid * 1024u;
    const int aoff = lds_byte(wr * 64 + fr, fq * 8), boff = lds_byte(wc * 32 + fr, fq * 8);
#define PG8_SA(b, h) (((b) * 2 + (h)) * HTB)
#define PG8_SB(b, h) ((4 + (b) * 2 + (h)) * HTB)
#define PG8_STAGE(bufoff, gbase, voff) do { _Pragma("unroll") for (int _i = 0; _i < 2; ++_i) \
        __builtin_amdgcn_global_load_lds((const unsigned*)((const char*)(gbase) + (voff)[_i]), (PG8_LAS unsigned*)(lds + (bufoff) + ldsw + _i * 8192), 16, 0, 0); } while (0)
#define PG8_LDA(dst, b, h) do { _Pragma("unroll") for (int m = 0; m < 4; ++m) _Pragma("unroll") for (int k = 0; k < 2; ++k) dst[m][k] = *(const PG8_LAS bf16x8*)(lds + PG8_SA(b, h) + aoff + m * 2048 + k * 1024); } while (0)
#define PG8_LDB(dst, b, h) do { _Pragma("unroll") for (int n = 0; n < 2; ++n) _Pragma("unroll") for (int k = 0; k < 2; ++k) dst[n][k] = *(const PG8_LAS bf16x8*)(lds + PG8_SB(b, h) + boff + n * 2048 + k * 1024); } while (0)
#define PG8_MMA(ai, bj, At, Bt) do { __builtin_amdgcn_s_setprio(1); _Pragma("unroll") for (int m = 0; m < 4; ++m) _Pragma("unroll") for (int n = 0; n < 2; ++n) _Pragma("unroll") for (int k = 0; k < 2; ++k) \
        acc[ai][bj][m][n] = __builtin_amdgcn_mfma_f32_16x16x32_bf16(Bt[n][k], At[m][k], acc[ai][bj][m][n], 0, 0, 0); __builtin_amdgcn_s_setprio(0); } while (0)
#define PG8_WAIT_V(n) asm volatile("s_waitcnt vmcnt(" #n ")" ::: "memory")
#define PG8_WAIT_L(n) asm volatile("s_waitcnt lgkmcnt(" #n ")" ::: "memory")
#define PG8_BAR __builtin_amdgcn_s_barrier()
#define PG8_SCHED __builtin_amdgcn_sched_barrier(0)
    Unit cur, nxt; int ui = 0;
    if (!S.next(0, cur)) return;
    f32x4 acc[2][2][4][2];
#pragma unroll
    for (int a = 0; a < 2; ++a)
#pragma unroll
        for (int b = 0; b < 2; ++b)
#pragma unroll
            for (int m = 0; m < 4; ++m)
#pragma unroll
                for (int n = 0; n < 2; ++n) acc[a][b][m][n] = (f32x4){0.f, 0.f, 0.f, 0.f};
    bf16x8 At[4][2], B0[2][2], B1[2][2];
    const char* cA = (const char*)g.A + (size_t)cur.pm * tstep; const char* cB = (const char*)g.Bt + (size_t)cur.pn * tstep;
    S.a_ready(cur);
    if constexpr (SP2) {
        PG8_STAGE(PG8_SB(0, 0), cB, voffB); PG8_STAGE(PG8_SB(0, 1), cB + hstep, voffB); PG8_STAGE(PG8_SA(0, 0), cA, voffA); PG8_STAGE(PG8_SA(0, 1), cA + hstep, voffA);
        if (wr == 1) PG8_BAR;
        PG8_WAIT_V(2); PG8_BAR;
        PG8_STAGE(PG8_SB(1, 0), cB + kstep, voffB); PG8_STAGE(PG8_SA(1, 0), cA + kstep, voffA); PG8_STAGE(PG8_SB(1, 1), cB + hstep + kstep, voffB);
        PG8_WAIT_V(6); PG8_BAR;
    } else {
        PG8_STAGE(PG8_SB(0, 0), cB, voffB); PG8_STAGE(PG8_SA(0, 0), cA, voffA); PG8_STAGE(PG8_SB(0, 1), cB + hstep, voffB); PG8_STAGE(PG8_SA(0, 1), cA + hstep, voffA);
        if (wr == 1) PG8_BAR;
        PG8_WAIT_V(4); PG8_BAR;
        PG8_STAGE(PG8_SB(1, 0), cB + kstep, voffB); PG8_STAGE(PG8_SA(1, 0), cA + kstep, voffA); PG8_STAGE(PG8_SB(1, 1), cB + hstep + kstep, voffB);
        PG8_WAIT_V(6); PG8_BAR;
    }
    for (;;) {
        const bool has_next = S.next(ui + 1, nxt);
        const char* nA = has_next ? (const char*)g.A + (size_t)nxt.pm * tstep : cA; const char* nB = has_next ? (const char*)g.Bt + (size_t)nxt.pn * tstep : cB;
        for (int t = 0; t < nt; t += 2) {
            const bool last = (t == nt - 2);
            const char* a1 = cA + (size_t)(t + 1) * kstep;
            const char* a2 = last ? nA : cA + (size_t)(t + 2) * kstep; const char* b2 = last ? nB : cB + (size_t)(t + 2) * kstep;
            const char* a3 = a2 + kstep; const char* b3 = b2 + kstep;
            if (last && has_next) S.a_ready(nxt);
            if constexpr (SP2) {
            PG8_LDB(B0, 0, 0); PG8_LDB(B1, 0, 1); PG8_SCHED; PG8_LDA(At, 0, 0); PG8_STAGE(PG8_SA(1, 1), a1 + hstep, voffA);
            PG8_WAIT_V(8); PG8_WAIT_L(0); PG8_BAR; PG8_MMA(0, 0, At, B0); PG8_MMA(0, 1, At, B1); PG8_BAR; PG8_SCHED;
            PG8_LDA(At, 0, 1); PG8_STAGE(PG8_SB(0, 0), b2, voffB); PG8_STAGE(PG8_SB(0, 1), b2 + hstep, voffB); PG8_STAGE(PG8_SA(0, 0), a2, voffA);
            PG8_WAIT_V(8); PG8_WAIT_L(0); PG8_BAR; PG8_MMA(1, 0, At, B0); PG8_MMA(1, 1, At, B1); PG8_BAR; PG8_SCHED;
            PG8_LDB(B0, 1, 0); PG8_LDB(B1, 1, 1); PG8_SCHED; PG8_LDA(At, 1, 0); PG8_STAGE(PG8_SA(0, 1), a2 + hstep, voffA);
            PG8_WAIT_V(8); PG8_WAIT_L(0); PG8_BAR; PG8_MMA(0, 0, At, B0); PG8_MMA(0, 1, At, B1); PG8_BAR; PG8_SCHED;
            PG8_LDA(At, 1, 1); PG8_STAGE(PG8_SB(1, 0), b3, voffB); PG8_STAGE(PG8_SB(1, 1), b3 + hstep, voffB); PG8_STAGE(PG8_SA(1, 0), a3, voffA);
            PG8_WAIT_V(8); PG8_WAIT_L(0); PG8_BAR; PG8_MMA(1, 0, At, B0); PG8_MMA(1, 1, At, B1); PG8_BAR; PG8_SCHED;
            } else {
            PG8_LDB(B0, 0, 0); PG8_SCHED; PG8_LDA(At, 0, 0); PG8_STAGE(PG8_SA(1, 1), a1 + hstep, voffA);
            PG8_WAIT_L(8); PG8_BAR; PG8_WAIT_L(0); PG8_MMA(0, 0, At, B0); PG8_BAR; PG8_SCHED;
            PG8_LDB(B1, 0, 1); PG8_STAGE(PG8_SB(0, 0), b2, voffB);
            PG8_BAR; PG8_WAIT_L(0); PG8_MMA(0, 1, At, B1); PG8_BAR;
            PG8_LDA(At, 0, 1); PG8_STAGE(PG8_SA(0, 0), a2, voffA);
            PG8_BAR; PG8_WAIT_L(0); PG8_MMA(1, 0, At, B0); PG8_BAR; PG8_SCHED;
            PG8_STAGE(PG8_SB(0, 1), b2 + hstep, voffB);
            PG8_WAIT_V(6); PG8_BAR; PG8_MMA(1, 1, At, B1); PG8_BAR;
            PG8_LDB(B0, 1, 0); PG8_SCHED; PG8_LDA(At, 1, 0); PG8_STAGE(PG8_SA(0, 1), a2 + hstep, voffA);
            PG8_WAIT_L(8); PG8_BAR; PG8_WAIT_L(0); PG8_MMA(0, 0, At, B0); PG8_BAR; PG8_SCHED;
            PG8_LDB(B1, 1, 1); PG8_STAGE(PG8_SB(1, 0), b3, voffB);
            PG8_BAR; PG8_WAIT_L(0); PG8_MMA(0, 1, At, B1); PG8_BAR;
            PG8_LDA(At, 1, 1); PG8_STAGE(PG8_SA(1, 0), a3, voffA);
            PG8_BAR; PG8_WAIT_L(0); PG8_MMA(1, 0, At, B0); PG8_BAR; PG8_SCHED;
            PG8_STAGE(PG8_SB(1, 1), b3 + hstep, voffB);
            PG8_WAIT_V(6); PG8_BAR; PG8_MMA(1, 1, At, B1); PG8_BAR;
            }
        }
        if constexpr (ALIGN_EPI) { if (wr == 0) PG8_BAR; }
        if constexpr (!Epi::AFTER_DRAIN) { E(acc, cur, wr, wc, fr, fq); S.done(cur); }
        if (!has_next) break;
#pragma unroll
        for (int a = 0; a < 2; ++a)
#pragma unroll
            for (int b = 0; b < 2; ++b)
#pragma unroll
                for (int m = 0; m < 4; ++m)
#pragma unroll
                    for (int n = 0; n < 2; ++n) acc[a][b][m][n] = (f32x4){0.f, 0.f, 0.f, 0.f};
        cur = nxt; cA = nA; cB = nB; ++ui;
        if constexpr (ALIGN_EPI) { if (wr == 1) PG8_BAR; }
    }
    PG8_WAIT_V(0);
    if constexpr (!ALIGN_EPI) { if (wr == 0) PG8_BAR; }
    PG8_BAR;
    if constexpr (Epi::AFTER_DRAIN) { E.fused(acc, cur, wr, wc, fr, fq, lds, wid, lane); S.done(cur); }
#undef PG8_SA
#undef PG8_SB
#undef PG8_STAGE
#undef PG8_LDA
#undef PG8_LDB
#undef PG8_MMA
#undef PG8_WAIT_V
#undef PG8_WAIT_L
#undef PG8_BAR
#undef PG8_SCHED
}
}
#define GAS __attribute__((address_space(1)))
#define LAS __attribute__((address_space(3)))
typedef unsigned short bf16;
typedef unsigned v4u __attribute__((ext_vector_type(4)));
typedef float f32x4 __attribute__((ext_vector_type(4)));
typedef short bf16x8 __attribute__((ext_vector_type(8)));
typedef GAS unsigned gu32;
typedef GAS unsigned long long gu64;
#define RLX_AGENT __ATOMIC_RELAXED, __HIP_MEMORY_SCOPE_AGENT
#define LDS_WAIT() asm volatile("s_waitcnt lgkmcnt(0)" ::: "memory")
#define VM_WAIT() asm volatile("s_waitcnt vmcnt(0)" ::: "memory")
__device__ __forceinline__ unsigned long long rt() { return __builtin_amdgcn_s_memrealtime(); }
__device__ __forceinline__ unsigned f2bf(float f) { unsigned u = __builtin_bit_cast(unsigned, f); return (u + 0x7fffu + ((u >> 16) & 1u)) >> 16; }
__device__ __forceinline__ unsigned pk2(float lo, float hi) { return f2bf(lo) | (f2bf(hi) << 16); }

#define XB_TMO      128
#define XB_XCNT(j)  (256  + 64 * (j))
#define XB_XSUB(j)  (1280 + 64 * (j))
#define XB_XGEN(j)  (2304 + 64 * (j))
#define XB_TOP      3328
#define XB_TOPGEN   3392
#define XCD_BAR_WORDS 3456
#define XB_SPIN_CAP (1u << 18)

__device__ __forceinline__ unsigned xb_ld(unsigned* p)              { return __hip_atomic_load(p, __ATOMIC_RELAXED, __HIP_MEMORY_SCOPE_AGENT); }
__device__ __forceinline__ unsigned xb_add(unsigned* p, unsigned v) { return __hip_atomic_fetch_add(p, v, __ATOMIC_RELAXED, __HIP_MEMORY_SCOPE_AGENT); }
__device__ __forceinline__ unsigned xb_xcc_id() { return (unsigned)__builtin_amdgcn_s_getreg((3 << 11) | 20) & 0xFu; }
#define XB_SPIN(cond, bar) do { unsigned _sp = 0; while (cond) { __builtin_amdgcn_s_sleep(1); \
    if ((++_sp & 255u) == 0u) { if (xb_ld(&(bar)[XB_TMO])) break; if (_sp > XB_SPIN_CAP) { atomicAdd(&(bar)[XB_TMO], 1u); break; } } } } while (0)

struct XcdBarrier {
    unsigned* bar; unsigned x;
    volatile LAS unsigned* st;
};

__device__ __forceinline__ XcdBarrier xcd_barrier_post(unsigned* bar, volatile LAS unsigned* st) {
    XcdBarrier b; b.bar = bar; b.x = xb_xcc_id(); b.st = st;
    if (threadIdx.x == 0) (void)xb_add(&bar[XB_XCNT(b.x)], 1u);
    return b;
}
__device__ __forceinline__ void xcd_barrier_complete(unsigned* bar, unsigned x, unsigned& nloc, unsigned& nx) {
    const unsigned G = gridDim.x * gridDim.y * gridDim.z;
    unsigned sum, cnt, mine, sp = 0u;
    for (;;) {
        sum = 0u; cnt = 0u; mine = 0u;
#pragma unroll
        for (unsigned j = 0; j < 16; ++j) { const unsigned c = xb_ld(&bar[XB_XCNT(j)]); sum += c; cnt += (c > 0u) ? 1u : 0u; mine = (j == x) ? c : mine; }
        if (sum == G) break;
        __builtin_amdgcn_s_sleep(1);
        if ((++sp & 255u) == 0u) { if (xb_ld(&bar[XB_TMO])) break; if (sp > XB_SPIN_CAP) { atomicAdd(&bar[XB_TMO], 1u); break; } }
    }
    nloc = mine > 0u ? mine : 1u; nx = cnt > 0u ? cnt : 1u;
}

__device__ __forceinline__ void xcd_barrier(const XcdBarrier& b) {
    asm volatile("s_waitcnt vmcnt(0)" ::: "memory");
    __syncthreads();
    if (threadIdx.x == 0) {
        unsigned* bar = b.bar;
        __builtin_amdgcn_s_waitcnt(0);
        unsigned nloc = b.st[0], nx = b.st[1];
        if (nloc == 0u) { xcd_barrier_complete(bar, b.x, nloc, nx); b.st[0] = nloc; b.st[1] = nx; }
        const unsigned old = xb_add(&bar[XB_XSUB(b.x)], 1u);
        const unsigned gen = old / nloc;
        if (old + 1u == (gen + 1u) * nloc) {
            __builtin_amdgcn_fence(__ATOMIC_RELEASE, "agent");
            asm volatile("s_waitcnt vmcnt(0)" ::: "memory");
            const unsigned og = xb_add(&bar[XB_TOP], 1u);
            const unsigned tg = og / nx;
            if (og + 1u == (tg + 1u) * nx) xb_add(&bar[XB_TOPGEN], 1u);
            else XB_SPIN(xb_ld(&bar[XB_TOPGEN]) == tg, bar);
            __builtin_amdgcn_fence(__ATOMIC_ACQUIRE, "agent");
            xb_add(&bar[XB_XGEN(b.x)], 1u);
            asm volatile("s_waitcnt vmcnt(0)" ::: "memory");
        } else {
            XB_SPIN(xb_ld(&bar[XB_XGEN(b.x)]) == gen, bar);
            __builtin_amdgcn_fence(__ATOMIC_ACQUIRE, "agent");
            asm volatile("s_waitcnt vmcnt(0)" ::: "memory");
        }
    }
    __syncthreads();
}

constexpr int NB = 4, SEQ = 8192, DM = 1024, MTOK = NB * SEQ, DEPTH = 2;
constexpr int DIN = 2560, NH = 8, HD = 64, DLRU = 256, DCONF = 256, NE = 32, DE = 512;
constexpr int COL_Q = 0, COL_K = 512, COL_V = 1024, COL_XR = 1536, COL_XG = 1792, COL_XC = 2048;
constexpr int NRT = 36, NRTP = 48;
constexpr int MAXSLOT = 73728;
constexpr float EPSN = 1e-6f;
constexpr float LOG2E = 1.4426950408889634f;
constexpr float QSCALE = 0.125f * LOG2E;
constexpr float EXIT_THR2 = 120.0f * LOG2E;

constexpr size_t MiB = 1u << 20;
constexpr size_t WS_CTL = 0, CTL_ZERO_BYTES = 1 * MiB;
constexpr size_t WS_WIN = 1 * MiB;
constexpr size_t WS_WOUT = 6 * MiB;
constexpr size_t WS_W1 = 8 * MiB;
constexpr size_t WS_W2 = 72 * MiB;
constexpr size_t WS_PW = 104 * MiB;
constexpr size_t WS_LRUW = WS_PW + 128 * 1024;
constexpr size_t WS_WR = WS_PW + 256 * 1024;
constexpr size_t WS_RS1 = 105 * MiB;
constexpr size_t WS_RS2 = WS_RS1 + 128 * 1024;
constexpr size_t WS_TOKE = WS_RS2 + 128 * 1024;
constexpr size_t WS_TOKR = WS_TOKE + 256 * 1024;
constexpr size_t WS_TOKG = WS_TOKR + 256 * 1024;
constexpr size_t WS_RSS = WS_TOKG + 256 * 1024;
constexpr size_t WS_GTS = WS_RSS + 288 * 1024;
constexpr size_t WS_SUMM = 107 * MiB;
constexpr size_t WS_XBY = 109 * MiB;
constexpr size_t WS_PROJ = 173 * MiB;
constexpr size_t WS_HP = 333 * MiB;
constexpr size_t WS_END = 405 * MiB;
constexpr int CW_TMO = 0, CW_BAR = 4096, CW_CNT = 8192;

constexpr int SCR_BYTES = 143360;
constexpr int LDSCTL_OFF = SCR_BYTES;
constexpr int LDS_BYTES = 147456;
constexpr int NWAVES = 8, NTHR = 512;

typedef float f32x16 __attribute__((ext_vector_type(16)));
typedef short s16x4 __attribute__((ext_vector_type(4)));
typedef unsigned u32x2 __attribute__((ext_vector_type(2)));
typedef float f32x2 __attribute__((ext_vector_type(2)));
typedef __bf16 bf16x2_t __attribute__((ext_vector_type(2)));

__device__ __forceinline__ unsigned cvtpk(float lo, float hi) { f32x2 v = {lo, hi}; bf16x2_t b = __builtin_convertvector(v, bf16x2_t); return __builtin_bit_cast(unsigned, b); }
__device__ __forceinline__ float bflo(unsigned w) { return __uint_as_float(w << 16); }
__device__ __forceinline__ float bfhi(unsigned w) { return __uint_as_float(w & 0xffff0000u); }
__device__ __forceinline__ float fexp2(float x) { return __builtin_amdgcn_exp2f(x); }
__device__ __forceinline__ float flog2(float x) { return __builtin_amdgcn_logf(x); }
__device__ __forceinline__ float frcp(float x) { return __builtin_amdgcn_rcpf(x); }
__device__ __forceinline__ float sigmoidf_(float x) { return frcp(1.0f + fexp2(-LOG2E * x)); }
__device__ __forceinline__ float wave_sum(float v) {
#pragma unroll
    for (int o = 1; o < 64; o <<= 1) v += __shfl_xor(v, o);
    return v;
}
#define WG_SYNC() __syncthreads()
__device__ __forceinline__ int opq(int x) { asm volatile("" : "+v"(x)); return x; }

struct Frame {
    LAS unsigned char* lds;
    gu32* ctl;
    int tid, lane, wave, vcu, G;
    const float* const* in;
    float* out; unsigned char* ws;
};

__device__ __forceinline__ int dest_row(int n, int mode) {
    if (mode == 1) { const int t = n & ~255, c = n & 255; return t + 128 * ((c >> 5) & 1) + 32 * (c >> 6) + (c & 31); }
    if (mode == 2) return 8 * (n >> 2) + (n & 3);
    if (mode == 3) return 8 * (n >> 2) + 4 + (n & 3);
    return n;
}
__device__ __forceinline__ void transpose_item(const float* W, int ldn, int k0, int n0, const float* gain, bf16* WT, int ldk, int mode, LAS float* scr, int lane) {
#pragma unroll 8
    for (int i = 0; i < 32; ++i) { const int kk = 2 * i + (lane >> 5); float v = W[(size_t)(k0 + kk) * ldn + n0 + (lane & 31)]; if (gain) v *= gain[k0 + kk]; scr[kk * 33 + (lane & 31)] = v; }
    LDS_WAIT(); asm volatile("" ::: "memory");
    const int c = lane & 7;
#pragma unroll
    for (int j = 0; j < 4; ++j) { const int n = (lane >> 3) + 8 * j; const LAS float* s = scr + (8 * c) * 33 + n;
        v4u o; o.x = cvtpk(s[0 * 33], s[1 * 33]); o.y = cvtpk(s[2 * 33], s[3 * 33]); o.z = cvtpk(s[4 * 33], s[5 * 33]); o.w = cvtpk(s[6 * 33], s[7 * 33]);
        *(GAS v4u*)(WT + (size_t)dest_row(n0 + n, mode) * ldk + k0 + 8 * c) = o; }
    LDS_WAIT(); asm volatile("" ::: "memory");
}
__device__ __forceinline__ void convert_weights(Frame& F, int l) {
    LAS float* scr = (LAS float*)(F.lds + F.wave * 16384);
    const int gw = F.vcu * NWAVES + F.wave, NGW = F.G * NWAVES;
    const float* g1 = F.in[1] + l * DM; const float* w_in = F.in[2] + (size_t)l * DM * DIN;
    const float* gout = F.in[18] + l * DM; const float* w_out = F.in[19] + (size_t)l * DM * DM;
    const float* g2 = F.in[20] + l * DM;
    const float* wg = F.in[23] + (size_t)l * NE * DM * DE; const float* wu = F.in[24] + (size_t)l * NE * DM * DE; const float* wd = F.in[25] + (size_t)l * NE * DE * DM;
    const float* pw = F.in[16] + (size_t)l * DCONF * DCONF;
    const float* wa = F.in[7] + (size_t)l * 4 * 64 * 64; const float* wx = F.in[9] + (size_t)l * 4 * 64 * 64;
    bf16* Win = (bf16*)(F.ws + WS_WIN); bf16* Wout = (bf16*)(F.ws + WS_WOUT); bf16* W1 = (bf16*)(F.ws + WS_W1); bf16* W2 = (bf16*)(F.ws + WS_W2);
    bf16* PW = (bf16*)(F.ws + WS_PW); bf16* LW = (bf16*)(F.ws + WS_LRUW); float* WR = (float*)(F.ws + WS_WR);
    constexpr int I_IN = (DM / 64) * (DIN / 32), I_OUT = (DM / 64) * (DM / 32), I_GU = NE * (DM / 64) * (DE / 32), I_D = NE * (DE / 64) * (DM / 32);
    constexpr int I_PW = (DCONF / 64) * (DCONF / 32), I_LW = 8 * 1 * 2;
    constexpr int NITEMS = I_IN + I_OUT + 2 * I_GU + I_D + I_PW + I_LW;
    for (int it = gw; it < NITEMS; it += NGW) {
        int r = it;
        if (r < I_GU) { const int e = r / 256, q = r % 256, kb = q / 16, nb = q % 16; transpose_item(wg + (size_t)e * DM * DE, DE, 64 * kb, 32 * nb, g2, W1 + (size_t)e * 1024 * 1024, DM, 2, scr, F.lane); continue; } r -= I_GU;
        if (r < I_GU) { const int e = r / 256, q = r % 256, kb = q / 16, nb = q % 16; transpose_item(wu + (size_t)e * DM * DE, DE, 64 * kb, 32 * nb, g2, W1 + (size_t)e * 1024 * 1024, DM, 3, scr, F.lane); continue; } r -= I_GU;
        if (r < I_D) { const int e = r / 256, q = r % 256, kb = q / 32, nb = q % 32; transpose_item(wd + (size_t)e * DE * DM, DM, 64 * kb, 32 * nb, nullptr, W2 + (size_t)e * 1024 * 512, DE, 0, scr, F.lane); continue; } r -= I_D;
        if (r < I_IN) { const int kb = r / (DIN / 32), nb = r % (DIN / 32); transpose_item(w_in, DIN, 64 * kb, 32 * nb, g1, Win, DM, 1, scr, F.lane); continue; } r -= I_IN;
        if (r < I_OUT) { const int kb = r / 32, nb = r % 32; transpose_item(w_out, DM, 64 * kb, 32 * nb, gout, Wout, DM, 0, scr, F.lane); continue; } r -= I_OUT;
        if (r < I_PW) { const int kb = r / 8, nb = r % 8; transpose_item(pw, DCONF, 64 * kb, 32 * nb, nullptr, PW, DCONF, 0, scr, F.lane); continue; } r -= I_PW;
        { const int mat = r >> 1, nb = r & 1; const float* src = (mat < 4 ? wa : wx) + (size_t)(mat & 3) * 64 * 64; transpose_item(src, 64, 0, 32 * nb, nullptr, LW + (size_t)mat * 64 * 64, 64, 0, scr, F.lane); }
    }
    const float* rc = F.in[21] + (size_t)l * DM * 4; const float* rf = F.in[22] + (size_t)l * DM * NE;
    for (int idx = (F.vcu * NTHR + F.tid); idx < NRTP * DM; idx += F.G * NTHR) { const int n = idx / DM, k = idx % DM;
        float v = 0.f; if (n < 4) v = rc[k * 4 + n] * g2[k]; else if (n < NRT) v = rf[k * NE + (n - 4)] * g2[k]; WR[idx] = v; }
}
__device__ __forceinline__ void x_to_bf16_rows(Frame& F, const float* x, bf16* XB, float* RS1) {
    const int gw = F.vcu * NWAVES + F.wave, NGW = F.G * NWAVES;
    for (int m = gw; m < MTOK; m += NGW) {
        const GAS f32x4* xr = (const GAS f32x4*)(x + (size_t)m * DM) + F.lane; f32x4 v[4]; float s = 0.f;
#pragma unroll
        for (int j = 0; j < 4; ++j) { v[j] = xr[64 * j]; s += (v[j].x * v[j].x + v[j].y * v[j].y) + (v[j].z * v[j].z + v[j].w * v[j].w); }
        s = wave_sum(s);
        GAS u32x2* o8 = (GAS u32x2*)(XB + (size_t)m * DM) + F.lane;
#pragma unroll
        for (int j = 0; j < 4; ++j) { u32x2 w; w.x = cvtpk(v[j].x, v[j].y); w.y = cvtpk(v[j].z, v[j].w); o8[64 * j] = w; }
        if (F.lane == 0) RS1[m] = __builtin_amdgcn_rsqf(s * (1.0f / DM) + EPSN);
    }
}

namespace att {
constexpr int SLOTB = 8192, L_K = 0, L_V = 2 * SLOTB, L_OST = 4 * SLOTB, L_FLAG = L_OST + NWAVES * 4096;
__device__ __forceinline__ int crow(int r, int hi) { return (r & 3) + 8 * (r >> 2) + 4 * hi; }
typedef const LAS unsigned char* lptr;
__device__ __forceinline__ void unit(Frame& F, int b, int h, int qb, const bf16* PROJ, bf16* Y) {
    const int lane = (opq((int)threadIdx.x) & 63), r32 = lane & 31, hi = lane >> 5, wid = F.wave;
    LAS unsigned char* shm = F.lds;
    const long rowbase = (long)b * SEQ; const int q0 = qb * 256;
    const bf16* Qw = PROJ + (rowbase + q0 + wid * 32) * DIN + COL_Q + h * HD;
    const bf16* Kh = PROJ + rowbase * DIN + COL_K + h * HD; const bf16* Vh = PROJ + rowbase * DIN + COL_V + h * HD;
    bf16x8 qr[4];
#pragma unroll
    for (int d0 = 0; d0 < 4; ++d0) qr[d0] = *(const GAS bf16x8*)(Qw + (long)r32 * DIN + d0 * 16 + hi * 8);
    f32x16 o[2]; o[0] = f32x16{}; o[1] = f32x16{};
    float R = 0.f;
    const int first_tile = 4 * qb + (wid >> 1), T_top = 4 * qb + 3;
    const int qpos = q0 + wid * 32 + r32;
    bool wave_done = false;
    const bf16* ksrc = Kh + (long)lane * DIN + wid * 8;
    const bf16* vsrc = Vh + (long)(16 * (wid & 3) + (lane >> 2)) * DIN + (wid >> 2) * 32 + (lane & 3) * 8;
    LAS unsigned char* kdst = shm + L_K + wid * 1024 + lane * 16; LAS unsigned char* vdst = shm + L_V + wid * 1024 + lane * 16;
    const int vb0 = (int)(uintptr_t)(shm + L_V) + ((lane >> 4) & 1) * 32 + (lane & 3) * 8 + (4 * hi + ((lane & 15) >> 2)) * 64;
    volatile LAS int* flag = (volatile LAS int*)(shm + L_FLAG);
    v4u kreg = *(const GAS v4u*)(ksrc + (long)T_top * 64 * DIN), vreg = *(const GAS v4u*)(vsrc + (long)T_top * 64 * DIN);
    *(LAS v4u*)kdst = kreg; *(LAS v4u*)vdst = vreg;
    LDS_WAIT(); WG_SYNC();
    int s = 0;
    for (int t = T_top;; --t, s ^= 1) {
        if (t > 0) { kreg = *(const GAS v4u*)(ksrc + (long)(t - 1) * 64 * DIN); vreg = *(const GAS v4u*)(vsrc + (long)(t - 1) * 64 * DIN); }
        if (t <= first_tile && !wave_done) {
            f32x16 p0 = f32x16{}, p1 = f32x16{};
            { lptr kb = shm + L_K + s * SLOTB + hi * 1024 + r32 * 16;
#pragma unroll
              for (int d0 = 0; d0 < 4; ++d0) { const bf16x8 b0 = *(const LAS bf16x8*)(kb + d0 * 2048), b1 = *(const LAS bf16x8*)(kb + d0 * 2048 + 512);
                  p0 = __builtin_amdgcn_mfma_f32_32x32x16_bf16(b0, qr[d0], p0, 0, 0, 0); p1 = __builtin_amdgcn_mfma_f32_32x32x16_bf16(b1, qr[d0], p1, 0, 0, 0); } }
            const bool diag = (t == first_tile); const int kbase = t * 64 + 4 * hi;
            f32x16 L0, L1;
#pragma unroll
            for (int r = 0; r < 16; ++r) {
                const int kk = kbase + (r & 3) + 8 * (r >> 2);
                { const float x = p0[r]; const float e = fexp2(-__builtin_fabsf(x)); const float sp = __builtin_fmaxf(x, 0.f) + flog2(1.0f + e); float lk = -sp; if (diag && !(kk < qpos)) lk = 0.f; L0[r] = lk; p0[r] = x - sp; }
                { const float x = p1[r]; const float e = fexp2(-__builtin_fabsf(x)); const float sp = __builtin_fmaxf(x, 0.f) + flog2(1.0f + e); float lk = -sp; if (diag && !(kk + 32 < qpos)) lk = 0.f; L1[r] = lk; p1[r] = x - sp; }
            }
            float Ghi[2][4], T[2][4];
#pragma unroll
            for (int bq = 0; bq < 4; ++bq) {
                const float g0 = (L0[4 * bq] + L0[4 * bq + 1]) + (L0[4 * bq + 2] + L0[4 * bq + 3]), g1 = (L1[4 * bq] + L1[4 * bq + 1]) + (L1[4 * bq + 2] + L1[4 * bq + 3]);
                auto r0 = __builtin_amdgcn_permlane32_swap(__float_as_uint(g0), __float_as_uint(g0), false, false);
                auto r1 = __builtin_amdgcn_permlane32_swap(__float_as_uint(g1), __float_as_uint(g1), false, false);
                Ghi[0][bq] = __uint_as_float(r0[1]); T[0][bq] = __uint_as_float(r0[0]) + __uint_as_float(r0[1]);
                Ghi[1][bq] = __uint_as_float(r1[1]); T[1][bq] = __uint_as_float(r1[0]) + __uint_as_float(r1[1]);
            }
            const float hm = hi ? 0.f : 1.f;
            float cum = R;
#pragma unroll
            for (int a = 1; a >= 0; --a)
#pragma unroll
                for (int bq = 3; bq >= 0; --bq) {
                    const float E = cum + hm * Ghi[a][bq];
                    if (a == 1) { const float s3 = E, s2 = s3 + L1[4 * bq + 3], s1 = s2 + L1[4 * bq + 2], s0 = s1 + L1[4 * bq + 1];
                        p1[4 * bq + 3] = fexp2(p1[4 * bq + 3] + s3); p1[4 * bq + 2] = fexp2(p1[4 * bq + 2] + s2); p1[4 * bq + 1] = fexp2(p1[4 * bq + 1] + s1); p1[4 * bq] = fexp2(p1[4 * bq] + s0); }
                    else { const float s3 = E, s2 = s3 + L0[4 * bq + 3], s1 = s2 + L0[4 * bq + 2], s0 = s1 + L0[4 * bq + 1];
                        p0[4 * bq + 3] = fexp2(p0[4 * bq + 3] + s3); p0[4 * bq + 2] = fexp2(p0[4 * bq + 2] + s2); p0[4 * bq + 1] = fexp2(p0[4 * bq + 1] + s1); p0[4 * bq] = fexp2(p0[4 * bq] + s0); }
                    cum += T[a][bq];
                }
            R = cum;
            if (diag) {
#pragma unroll
                for (int r = 0; r < 16; ++r) { const int kk = kbase + (r & 3) + 8 * (r >> 2); if (!(kk < qpos)) p0[r] = 0.f; if (!(kk + 32 < qpos)) p1[r] = 0.f; }
            }
            v4u pw0, pw1, pw2, pw3;
            pw0.x = cvtpk(p0[0], p0[1]); pw0.y = cvtpk(p0[2], p0[3]); pw0.z = cvtpk(p0[4], p0[5]); pw0.w = cvtpk(p0[6], p0[7]);
            pw1.x = cvtpk(p0[8], p0[9]); pw1.y = cvtpk(p0[10], p0[11]); pw1.z = cvtpk(p0[12], p0[13]); pw1.w = cvtpk(p0[14], p0[15]);
            pw2.x = cvtpk(p1[0], p1[1]); pw2.y = cvtpk(p1[2], p1[3]); pw2.z = cvtpk(p1[4], p1[5]); pw2.w = cvtpk(p1[6], p1[7]);
            pw3.x = cvtpk(p1[8], p1[9]); pw3.y = cvtpk(p1[10], p1[11]); pw3.z = cvtpk(p1[12], p1[13]); pw3.w = cvtpk(p1[14], p1[15]);
            const int vb = vb0 + s * SLOTB;
#pragma unroll
            for (int d0 = 0; d0 < 2; ++d0) { s16x4 lo[4], hh[4];
#pragma unroll
                for (int ks = 0; ks < 4; ++ks) {
                    asm volatile("ds_read_b64_tr_b16 %0,%1 offset:%c2" : "=&v"(lo[ks]) : "v"(vb), "i"(d0 * 4096 + ks * 1024) : "memory");
                    asm volatile("ds_read_b64_tr_b16 %0,%1 offset:%c2" : "=&v"(hh[ks]) : "v"(vb), "i"(d0 * 4096 + ks * 1024 + 512) : "memory"); }
                asm volatile("s_waitcnt lgkmcnt(0)" ::: "memory"); __builtin_amdgcn_sched_barrier(0);
#define ATT_PK(k) (bf16x8){lo[k][0], lo[k][1], lo[k][2], lo[k][3], hh[k][0], hh[k][1], hh[k][2], hh[k][3]}
                o[d0] = __builtin_amdgcn_mfma_f32_32x32x16_bf16(__builtin_bit_cast(bf16x8, pw0), ATT_PK(0), o[d0], 0, 0, 0);
                o[d0] = __builtin_amdgcn_mfma_f32_32x32x16_bf16(__builtin_bit_cast(bf16x8, pw1), ATT_PK(1), o[d0], 0, 0, 0);
                o[d0] = __builtin_amdgcn_mfma_f32_32x32x16_bf16(__builtin_bit_cast(bf16x8, pw2), ATT_PK(2), o[d0], 0, 0, 0);
                o[d0] = __builtin_amdgcn_mfma_f32_32x32x16_bf16(__builtin_bit_cast(bf16x8, pw3), ATT_PK(3), o[d0], 0, 0, 0);
#undef ATT_PK
            }
            wave_done = __all(R < -EXIT_THR2);
        }
        if (lane == 0) flag[s * 8 + wid] = wave_done ? 1 : 0;
        if (t > 0) { *(LAS v4u*)(kdst + (s ^ 1) * SLOTB) = kreg; *(LAS v4u*)(vdst + (s ^ 1) * SLOTB) = vreg; }
        LDS_WAIT(); WG_SYNC();
        if (t == 0) break;
        int alld = 1;
#pragma unroll
        for (int w = 0; w < 8; ++w) alld &= flag[s * 8 + w];
        if (alld) break;
    }
    { LAS bf16* stg = (LAS bf16*)(shm + L_OST) + wid * 2048;
#pragma unroll
      for (int r = 0; r < 16; ++r) { const int orow = crow(r, hi);
#pragma unroll
          for (int d0 = 0; d0 < 2; ++d0) stg[orow * 64 + d0 * 32 + r32] = (bf16)(cvtpk(o[d0][r], 0.f) & 0xffffu); }
      LDS_WAIT(); asm volatile("" ::: "memory");
      bf16* Ow = Y + (rowbase + q0 + wid * 32) * DM + h * HD;
#pragma unroll
      for (int i = 0; i < 4; ++i) { const int row = i * 8 + (lane >> 3), ch = lane & 7; const v4u v = *(const LAS v4u*)(stg + row * 64 + ch * 8); *(GAS v4u*)(Ow + (long)row * DM + ch * 8) = v; } }
    LDS_WAIT(); WG_SYNC();
}
}

namespace conf {
constexpr int TM = 64, HALO = 30, UROWS = TM + HALO;
constexpr int L_U = 0  , L_Z = 49152  , L_S = 0  , ZS = 260, SS = 264;
__device__ __forceinline__ void unit(Frame& F, int ut, int l, const bf16* PROJ, bf16* Y) {
    const int tid = opq((int)threadIdx.x), lane = tid & 63, wid = F.wave;
    const int row0 = ut * TM; const int t0 = row0 % SEQ;
    LAS bf16* U = (LAS bf16*)(F.lds + L_U); LAS float* Z = (LAS float*)(F.lds + L_Z); LAS bf16* S = (LAS bf16*)(F.lds + L_S);
    const float* dw_w = F.in[12] + (size_t)l * 31 * DCONF; const float* dw_b = F.in[13] + l * DCONF; const float* ln_g = F.in[14] + l * DCONF; const float* ln_b = F.in[15] + l * DCONF;
    const float* pw_b = F.in[17] + l * DCONF; const bf16* PW = (const bf16*)(F.ws + WS_PW);
    for (int task = tid; task < UROWS * 32; task += NTHR) { const int ur = task >> 5, c8 = task & 31; const int t = t0 - HALO + ur; v4u o = {0u, 0u, 0u, 0u};
        if (t >= 0) { const bf16* pr = PROJ + (size_t)(row0 - HALO + ur) * DIN + COL_XC + c8 * 8; const v4u a = *(const GAS v4u*)pr, g = *(const GAS v4u*)(pr + 256);
            unsigned av[4] = {a.x, a.y, a.z, a.w}, gv[4] = {g.x, g.y, g.z, g.w}, ov[4];
#pragma unroll
            for (int j = 0; j < 4; ++j) ov[j] = cvtpk(bflo(av[j]) * sigmoidf_(bflo(gv[j])), bfhi(av[j]) * sigmoidf_(bfhi(gv[j])));
            o.x = ov[0]; o.y = ov[1]; o.z = ov[2]; o.w = ov[3]; }
        *(LAS v4u*)(U + ur * 256 + c8 * 8) = o; }
    LDS_WAIT(); WG_SYNC();
    { const int c = tid & 255, hf = tid >> 8; float w[31];
#pragma unroll
      for (int j = 0; j < 31; ++j) w[j] = dw_w[j * DCONF + c];
      const float bias = dw_b[c]; float acc[32];
#pragma unroll
      for (int i = 0; i < 32; ++i) acc[i] = bias;
      const LAS bf16* up = U + (hf * 32) * 256 + c;
#pragma unroll
      for (int rho = 0; rho < 62; ++rho) { const float x = __uint_as_float((unsigned)up[rho * 256] << 16);
#pragma unroll
          for (int i = 0; i < 32; ++i) { const int j = rho - i; if (j >= 0 && j <= 30) acc[i] += w[j] * x; } }
#pragma unroll
      for (int i = 0; i < 32; ++i) Z[(hf * 32 + i) * ZS + c] = acc[i]; }
    LDS_WAIT(); WG_SYNC();
    { const f32x4 g = *(const GAS f32x4*)(ln_g + 4 * lane), bb = *(const GAS f32x4*)(ln_b + 4 * lane);
      for (int i = 0; i < 8; ++i) { const int tk = wid * 8 + i; f32x4 v = *(const LAS f32x4*)(Z + tk * ZS + 4 * lane);
          const float mean = wave_sum((v.x + v.y) + (v.z + v.w)) * (1.0f / 256.0f); v = v - mean;
          const float var = wave_sum((v.x * v.x + v.y * v.y) + (v.z * v.z + v.w * v.w)) * (1.0f / 256.0f); const float rstd = __builtin_amdgcn_rsqf(var + EPSN);
          f32x4 y = v * rstd * g + bb; y.x *= sigmoidf_(y.x); y.y *= sigmoidf_(y.y); y.z *= sigmoidf_(y.z); y.w *= sigmoidf_(y.w);
          u32x2 w2; w2.x = cvtpk(y.x, y.y); w2.y = cvtpk(y.z, y.w); *(LAS u32x2*)(S + tk * SS + 4 * lane) = w2; } }
    LDS_WAIT(); WG_SYNC();
    { const int fr = lane & 15, fq = lane >> 4; f32x4 acc[4][2];
#pragma unroll
      for (int m = 0; m < 4; ++m) { acc[m][0] = (f32x4){0.f, 0.f, 0.f, 0.f}; acc[m][1] = (f32x4){0.f, 0.f, 0.f, 0.f}; }
#pragma unroll 2
      for (int ks = 0; ks < 8; ++ks) { bf16x8 bfr[2], afr[4];
#pragma unroll
          for (int n = 0; n < 2; ++n) bfr[n] = *(const GAS bf16x8*)(PW + (size_t)(32 * wid + 16 * n + fr) * DCONF + 32 * ks + 8 * fq);
#pragma unroll
          for (int m = 0; m < 4; ++m) afr[m] = *(const LAS bf16x8*)(S + (16 * m + fr) * SS + 32 * ks + 8 * fq);
#pragma unroll
          for (int m = 0; m < 4; ++m)
#pragma unroll
              for (int n = 0; n < 2; ++n) acc[m][n] = __builtin_amdgcn_mfma_f32_16x16x32_bf16(afr[m], bfr[n], acc[m][n], 0, 0, 0); }
#pragma unroll
      for (int m = 0; m < 4; ++m)
#pragma unroll
          for (int n = 0; n < 2; ++n)
#pragma unroll
              for (int i = 0; i < 4; ++i) Z[(16 * m + 4 * fq + i) * ZS + 32 * wid + 16 * n + fr] = acc[m][n][i]; }
    LDS_WAIT(); WG_SYNC();
    { const f32x4 pb = *(const GAS f32x4*)(pw_b + 4 * lane);
      for (int i = 0; i < 8; ++i) { const int tk = wid * 8 + i; f32x4 v = *(const LAS f32x4*)(Z + tk * ZS + 4 * lane) + pb;
          const float ss = wave_sum((v.x * v.x + v.y * v.y) + (v.z * v.z + v.w * v.w)); const float rs = __builtin_amdgcn_rsqf(ss * (1.0f / 256.0f) + EPSN); v = v * rs;
          u32x2 w2; w2.x = cvtpk(v.x, v.y); w2.y = cvtpk(v.z, v.w); *(GAS u32x2*)(Y + (size_t)(row0 + tk) * DM + 768 + 4 * lane) = w2; } }
    LDS_WAIT(); WG_SYNC();
}
}

namespace lru {
constexpr int TM = 64, XS_ = 260, XBS = 264;
constexpr int L_XC = 0  , L_A = 66560  , L_XB = 66560  ;
__device__ __forceinline__ void unit(Frame& F, int ut, int l, const bf16* PROJ, float* HL, float* PL, float* SUMM) {
    const int tid = opq((int)threadIdx.x), lane = tid & 63, wid = F.wave;
    const int row0 = ut * TM; const int t0 = row0 % SEQ;
    LAS float* XC = (LAS float*)(F.lds + L_XC); LAS float* A = (LAS float*)(F.lds + L_A); LAS bf16* XB = (LAS bf16*)(F.lds + L_XB);
    const float* cw = F.in[5] + (size_t)l * 4 * DLRU; const float* cb = F.in[6] + l * DLRU; const float* ba = F.in[8] + l * DLRU; const float* bx = F.in[10] + l * DLRU; const float* lam = F.in[11] + l * DLRU;
    const bf16* LW = (const bf16*)(F.ws + WS_LRUW);
    for (int task = tid; task < TM * 32; task += NTHR) { const int tk = task >> 5, c8 = task & 31; float acc[8];
        { const f32x4 b0 = *(const GAS f32x4*)(cb + c8 * 8), b1 = *(const GAS f32x4*)(cb + c8 * 8 + 4); acc[0] = b0.x; acc[1] = b0.y; acc[2] = b0.z; acc[3] = b0.w; acc[4] = b1.x; acc[5] = b1.y; acc[6] = b1.z; acc[7] = b1.w; }
#pragma unroll
        for (int j = 0; j < 4; ++j) { const int t = t0 + tk - 3 + j; if (t >= 0) { const v4u a = *(const GAS v4u*)(PROJ + (size_t)(row0 + tk - 3 + j) * DIN + COL_XR + c8 * 8);
                const f32x4 w0 = *(const GAS f32x4*)(cw + j * DLRU + c8 * 8), w1 = *(const GAS f32x4*)(cw + j * DLRU + c8 * 8 + 4);
                acc[0] += w0.x * bflo(a.x); acc[1] += w0.y * bfhi(a.x); acc[2] += w0.z * bflo(a.y); acc[3] += w0.w * bfhi(a.y);
                acc[4] += w1.x * bflo(a.z); acc[5] += w1.y * bfhi(a.z); acc[6] += w1.z * bflo(a.w); acc[7] += w1.w * bfhi(a.w); } }
        *(LAS f32x4*)(XC + tk * XS_ + c8 * 8) = (f32x4){acc[0], acc[1], acc[2], acc[3]}; *(LAS f32x4*)(XC + tk * XS_ + c8 * 8 + 4) = (f32x4){acc[4], acc[5], acc[6], acc[7]};
        v4u o; o.x = cvtpk(acc[0], acc[1]); o.y = cvtpk(acc[2], acc[3]); o.z = cvtpk(acc[4], acc[5]); o.w = cvtpk(acc[6], acc[7]); *(LAS v4u*)(XB + tk * XBS + c8 * 8) = o; }
    LDS_WAIT(); WG_SYNC();
    const int nb = wid >> 1, mh = wid & 1, fr = lane & 15, fq = lane >> 4;
    f32x4 ar[2][4], ai[2][4];
#pragma unroll
    for (int m = 0; m < 2; ++m)
#pragma unroll
        for (int n = 0; n < 4; ++n) { ar[m][n] = (f32x4){0.f, 0.f, 0.f, 0.f}; ai[m][n] = (f32x4){0.f, 0.f, 0.f, 0.f}; }
#pragma unroll
    for (int ks = 0; ks < 2; ++ks) { bf16x8 af[2];
#pragma unroll
        for (int m = 0; m < 2; ++m) af[m] = *(const LAS bf16x8*)(XB + (32 * mh + 16 * m + fr) * XBS + 64 * nb + 32 * ks + 8 * fq);
#pragma unroll
        for (int n = 0; n < 4; ++n) { const bf16x8 bA = *(const GAS bf16x8*)(LW + (size_t)nb * 4096 + (16 * n + fr) * 64 + 32 * ks + 8 * fq), bX = *(const GAS bf16x8*)(LW + (size_t)(4 + nb) * 4096 + (16 * n + fr) * 64 + 32 * ks + 8 * fq);
#pragma unroll
            for (int m = 0; m < 2; ++m) { ar[m][n] = __builtin_amdgcn_mfma_f32_16x16x32_bf16(af[m], bA, ar[m][n], 0, 0, 0); ai[m][n] = __builtin_amdgcn_mfma_f32_16x16x32_bf16(af[m], bX, ai[m][n], 0, 0, 0); } } }
    LDS_WAIT(); WG_SYNC();
#pragma unroll
    for (int n = 0; n < 4; ++n) { const int ch = 64 * nb + 16 * n + fr; const float lsl8 = -8.0f * log1pf(__expf(-lam[ch])), bav = ba[ch], bxv = bx[ch];
#pragma unroll
        for (int m = 0; m < 2; ++m)
#pragma unroll
            for (int i = 0; i < 4; ++i) { const int tk = 32 * mh + 16 * m + 4 * fq + i; const float gr = ar[m][n][i] + bav, gi = ai[m][n][i] + bxv; const float xcv = XC[tk * XS_ + ch];
                const float la = lsl8 * sigmoidf_(gr); const float a = fexp2(LOG2E * la); const float mult = __builtin_sqrtf(__builtin_fmaxf(1.0f - a * a, 0.f));
                A[tk * XS_ + ch] = a; XC[tk * XS_ + ch] = mult * sigmoidf_(gi) * xcv; } }
    LDS_WAIT(); WG_SYNC();
    if (tid < 256) { const int c = tid; float h = 0.f, p = 1.f; float* hl = HL + (size_t)row0 * DLRU + c; float* pl = PL + (size_t)row0 * DLRU + c;
#pragma unroll 8
        for (int tk = 0; tk < TM; ++tk) { const float a = A[tk * XS_ + c], u = XC[tk * XS_ + c]; p *= a; h = a * h + u; hl[(size_t)tk * DLRU] = h; pl[(size_t)tk * DLRU] = p; }
        SUMM[(size_t)ut * 512 + c] = p; SUMM[(size_t)ut * 512 + 256 + c] = h; }
    LDS_WAIT(); WG_SYNC();
}
}

__device__ __forceinline__ void fixup_unit(Frame& F, int ut, const bf16* PROJ, const float* HL, const float* PL, const float* SUMM, bf16* Y) {
    const int tid = opq((int)threadIdx.x), lane = tid & 63, wid = F.wave; const int row0 = ut * 64; const int cb = (row0 % SEQ) / 64, ub0 = ut - cb;
    LAS float* CAR = (LAS float*)F.lds;
    if (tid < 256) { float car = 0.f;
#pragma unroll 8
        for (int j = 0; j < cb; ++j) { const float p = SUMM[(size_t)(ub0 + j) * 512 + tid], h = SUMM[(size_t)(ub0 + j) * 512 + 256 + tid]; car = p * car + h; }
        CAR[tid] = car; }
    LDS_WAIT(); WG_SYNC();
    const f32x4 car = *(const LAS f32x4*)(CAR + 4 * lane);
    for (int i = 0; i < 8; ++i) { const size_t row = (size_t)row0 + wid * 8 + i;
        const f32x4 hl = *(const GAS f32x4*)(HL + row * DLRU + 4 * lane), pl = *(const GAS f32x4*)(PL + row * DLRU + 4 * lane);
        const u32x2 xg = *(const GAS u32x2*)(PROJ + row * DIN + COL_XG + 4 * lane); const v4u ya = *(const GAS v4u*)(Y + row * DM + 8 * lane);
        f32x4 h = hl + pl * car; const float xv[4] = {bflo(xg.x), bfhi(xg.x), bflo(xg.y), bfhi(xg.y)}; float y[4];
#pragma unroll
        for (int j = 0; j < 4; ++j) { const float x = xv[j]; const float u2 = 1.5957691216057308f * (x + 0.044715f * x * x * x); y[j] = h[j] * x * sigmoidf_(u2); }
        const float ssb = wave_sum((y[0] * y[0] + y[1] * y[1]) + (y[2] * y[2] + y[3] * y[3])); const float rsb = __builtin_amdgcn_rsqf(ssb * (1.0f / 256.0f) + EPSN);
        u32x2 w2; w2.x = cvtpk(y[0] * rsb, y[1] * rsb); w2.y = cvtpk(y[2] * rsb, y[3] * rsb); *(GAS u32x2*)(Y + row * DM + 512 + 4 * lane) = w2;
        float a[8] = {bflo(ya.x), bfhi(ya.x), bflo(ya.y), bfhi(ya.y), bflo(ya.z), bfhi(ya.z), bflo(ya.w), bfhi(ya.w)}; float ssa = 0.f;
#pragma unroll
        for (int j = 0; j < 8; ++j) ssa += a[j] * a[j];
        ssa = wave_sum(ssa); const float rsa = __builtin_amdgcn_rsqf(ssa * (1.0f / 512.0f) + EPSN);
        v4u oa; oa.x = cvtpk(a[0] * rsa, a[1] * rsa); oa.y = cvtpk(a[2] * rsa, a[3] * rsa); oa.z = cvtpk(a[4] * rsa, a[5] * rsa); oa.w = cvtpk(a[6] * rsa, a[7] * rsa);
        *(GAS v4u*)(Y + row * DM + 8 * lane) = oa; }
    LDS_WAIT(); WG_SYNC();
}

__device__ __forceinline__ void router_unit(Frame& F, int ut, int l, const float* X, float* RS2, int* TOKE, int* TOKR, float* TOKG) {
    const int tid = opq((int)threadIdx.x), lane = tid & 63, wid = F.wave, fr = lane & 15, fq = lane >> 4;
    const float* WR = (const float*)(F.ws + WS_WR);
    LAS float* LG = (LAS float*)F.lds + wid * (16 * NRTP + 16);
    LAS int* CNT = (LAS int*)(F.lds + 32768); LAS int* BASE = CNT + 32;
    if (tid < 32) CNT[tid] = 0;
    const int r0 = ut * 128 + wid * 16;
    f32x4 acc[3]; acc[0] = (f32x4){0.f, 0.f, 0.f, 0.f}; acc[1] = acc[0]; acc[2] = acc[0]; float ss = 0.f;
    const float* xp = X + (size_t)(r0 + fr) * DM + 4 * fq; const float* wp = WR + (size_t)fr * DM + 4 * fq;
#pragma unroll 4
    for (int s = 0; s < DM / 16; ++s) { const f32x4 a = *(const GAS f32x4*)(xp + 16 * s); ss += (a.x * a.x + a.y * a.y) + (a.z * a.z + a.w * a.w);
#pragma unroll
        for (int n = 0; n < 3; ++n) { const f32x4 b = *(const GAS f32x4*)(wp + (size_t)16 * n * DM + 16 * s);
            acc[n] = __builtin_amdgcn_mfma_f32_16x16x4f32(a.x, b.x, acc[n], 0, 0, 0); acc[n] = __builtin_amdgcn_mfma_f32_16x16x4f32(a.y, b.y, acc[n], 0, 0, 0);
            acc[n] = __builtin_amdgcn_mfma_f32_16x16x4f32(a.z, b.z, acc[n], 0, 0, 0); acc[n] = __builtin_amdgcn_mfma_f32_16x16x4f32(a.w, b.w, acc[n], 0, 0, 0); } }
    ss += __shfl_xor(ss, 16); ss += __shfl_xor(ss, 32);
    const float rs = __builtin_amdgcn_rsqf(ss * (1.0f / DM) + EPSN);
    if (fq == 0) LG[16 * NRTP + fr] = rs;
#pragma unroll
    for (int n = 0; n < 3; ++n)
#pragma unroll
        for (int i = 0; i < 4; ++i) LG[(4 * fq + i) * NRTP + 16 * n + fr] = acc[n][i];
    LDS_WAIT(); WG_SYNC();
    int e0 = 0, e1 = 0, lr0 = 0, lr1 = 0; float g0 = 0.f, g1 = 0.f, rsv = 0.f;
    if (lane < 16) { const LAS float* lg = LG + lane * NRTP; rsv = LG[16 * NRTP + lane];
        float c[4]; int grp = 0; float cm;
#pragma unroll
        for (int j = 0; j < 4; ++j) c[j] = lg[j] * rsv;
        cm = c[0];
#pragma unroll
        for (int j = 1; j < 4; ++j) if (c[j] > cm) { cm = c[j]; grp = j; }
        float den = 0.f;
#pragma unroll
        for (int j = 0; j < 4; ++j) den += __expf(c[j] - cm);
        const float wgrp = 1.0f / den;
        float v0 = -INFINITY, v1 = -INFINITY; int i0 = 0, i1 = 0;
#pragma unroll
        for (int j = 0; j < 8; ++j) { const float v = lg[4 + grp * 8 + j] * rsv; if (v > v0) { v1 = v0; i1 = i0; v0 = v; i0 = j; } else if (v > v1) { v1 = v; i1 = j; } }
        const float ex = __expf(v1 - v0); g0 = wgrp / (1.0f + ex); g1 = wgrp * ex / (1.0f + ex);
        e0 = grp * 8 + i0; e1 = grp * 8 + i1;
        lr0 = atomicAdd((int*)(CNT + e0), 1); lr1 = atomicAdd((int*)(CNT + e1), 1); }
    LDS_WAIT(); WG_SYNC();
    if (tid < 32) { const int c = CNT[tid]; int bse = 0; if (c > 0) bse = (int)__hip_atomic_fetch_add((unsigned*)(F.ctl + CW_CNT + 64 * l + tid), (unsigned)c, __ATOMIC_RELAXED, __HIP_MEMORY_SCOPE_AGENT); BASE[tid] = bse; }
    LDS_WAIT(); WG_SYNC();
    if (lane < 16) { const int tok = r0 + lane; RS2[tok] = rsv; TOKE[2 * tok] = e0; TOKE[2 * tok + 1] = e1; TOKR[2 * tok] = BASE[e0] + lr0; TOKR[2 * tok + 1] = BASE[e1] + lr1; TOKG[2 * tok] = g0; TOKG[2 * tok + 1] = g1; }
    LDS_WAIT(); WG_SYNC();
}
__device__ __forceinline__ int moe_tables(Frame& F, int l, LAS int* PST, LAS int* TE) {
    if (F.tid == 0) { int acc = 0; for (int e = 0; e < NE; ++e) { const int c = (int)__hip_atomic_load(F.ctl + CW_CNT + 64 * l + e, __ATOMIC_RELAXED, __HIP_MEMORY_SCOPE_AGENT); PST[e] = acc; acc += (c + 255) & ~255; } PST[NE] = acc; }
    LDS_WAIT(); WG_SYNC();
    const int ntile = PST[NE] >> 8;
    for (int rt = F.tid; rt < ntile; rt += NTHR) { int e = 0;
        for (int j = 1; j < NE; ++j) if ((PST[j] >> 8) <= rt) e = j;
        TE[rt] = e; }
    LDS_WAIT(); WG_SYNC();
    return ntile;
}
__device__ __forceinline__ void gather_phase(Frame& F, int l, const float* X, const float* RS2, const int* TOKE, const int* TOKR, const float* TOKG, bf16* XS, float* RSS, float* GTS) {
    LAS int* PST = (LAS int*)F.lds; LAS int* TE = PST + 64;
    (void)moe_tables(F, l, PST, TE);
    const int gw = F.vcu * NWAVES + F.wave, NGW = F.G * NWAVES;
    for (int m = gw; m < MTOK; m += NGW) {
        const GAS f32x4* xr = (const GAS f32x4*)(X + (size_t)m * DM) + F.lane; u32x2 w[4];
#pragma unroll
        for (int j = 0; j < 4; ++j) { const f32x4 v = xr[64 * j]; w[j].x = cvtpk(v.x, v.y); w[j].y = cvtpk(v.z, v.w); }
        const float rs = RS2[m];
#pragma unroll
        for (int k = 0; k < 2; ++k) { const int e = TOKE[2 * m + k], slot = PST[e] + TOKR[2 * m + k];
            GAS u32x2* o8 = (GAS u32x2*)(XS + (size_t)slot * DM) + F.lane;
#pragma unroll
            for (int j = 0; j < 4; ++j) o8[64 * j] = w[j];
            if (F.lane == 0) { RSS[slot] = rs; GTS[slot] = TOKG[2 * m + k]; } }
    }
    for (int e = gw; e < NE; e += NGW) { const int c = (int)__hip_atomic_load(F.ctl + CW_CNT + 64 * l + e, __ATOMIC_RELAXED, __HIP_MEMORY_SCOPE_AGENT);
        for (int slot = PST[e] + c; slot < PST[e + 1]; ++slot) { GAS u32x2* o8 = (GAS u32x2*)(XS + (size_t)slot * DM) + F.lane;
#pragma unroll
            for (int j = 0; j < 4; ++j) o8[64 * j] = (u32x2){0u, 0u};
            if (F.lane == 0) { RSS[slot] = 0.f; GTS[slot] = 0.f; } } }
    LDS_WAIT(); WG_SYNC();
}
__device__ __forceinline__ void combine_phase(Frame& F, int l, float* X, const int* TOKE, const int* TOKR, const bf16* OB, bool next_layer, bf16* XB, float* RS1) {
    LAS int* PST = (LAS int*)F.lds; LAS int* TE = PST + 64;
    (void)moe_tables(F, l, PST, TE);
    const int gw = F.vcu * NWAVES + F.wave, NGW = F.G * NWAVES;
    for (int m = gw; m < MTOK; m += NGW) {
        const int s0 = PST[TOKE[2 * m]] + TOKR[2 * m], s1 = PST[TOKE[2 * m + 1]] + TOKR[2 * m + 1];
        GAS f32x4* xr = (GAS f32x4*)(X + (size_t)m * DM) + F.lane;
        const GAS u32x2* o0 = (const GAS u32x2*)(OB + (size_t)s0 * DM) + F.lane; const GAS u32x2* o1 = (const GAS u32x2*)(OB + (size_t)s1 * DM) + F.lane;
        f32x4 v[4]; float ss = 0.f;
#pragma unroll
        for (int j = 0; j < 4; ++j) { const f32x4 x = xr[64 * j]; const u32x2 a = o0[64 * j], b = o1[64 * j];
            v[j].x = x.x + (bflo(a.x) + bflo(b.x)); v[j].y = x.y + (bfhi(a.x) + bfhi(b.x)); v[j].z = x.z + (bflo(a.y) + bflo(b.y)); v[j].w = x.w + (bfhi(a.y) + bfhi(b.y));
            ss += (v[j].x * v[j].x + v[j].y * v[j].y) + (v[j].z * v[j].z + v[j].w * v[j].w); }
#pragma unroll
        for (int j = 0; j < 4; ++j) xr[64 * j] = v[j];
        if (next_layer) { ss = wave_sum(ss); GAS u32x2* o8 = (GAS u32x2*)(XB + (size_t)m * DM) + F.lane;
#pragma unroll
            for (int j = 0; j < 4; ++j) { u32x2 w; w.x = cvtpk(v[j].x, v[j].y); w.y = cvtpk(v[j].z, v[j].w); o8[64 * j] = w; }
            if (F.lane == 0) RS1[m] = __builtin_amdgcn_rsqf(ss * (1.0f / DM) + EPSN); }
    }
    LDS_WAIT(); WG_SYNC();
}

constexpr int PH_PER_LAYER = 9, N_PHASES = 1 + DEPTH * PH_PER_LAYER;
struct Args { const float* in[26]; float* out; unsigned char* ws; int ph_lo, ph_hi; };
__global__ void __launch_bounds__(NTHR, 2) mk_fwd(Args args) {
    extern __shared__ __attribute__((aligned(16))) unsigned char lds[];
    Frame F;
    F.lds = (LAS unsigned char*)lds;
    F.tid = threadIdx.x; F.lane = F.tid & 63; F.wave = __builtin_amdgcn_readfirstlane(F.tid >> 6);
    F.G = gridDim.x; { const int bx = blockIdx.x; F.vcu = (F.G % 8 == 0) ? (bx % 8) * (F.G / 8) + bx / 8 : bx; }
    F.in = args.in;
    F.out = args.out; F.ws = args.ws; F.ctl = (gu32*)(args.ws + WS_CTL);
    for (int u = F.tid; u < (LDS_BYTES - LDSCTL_OFF) / 4; u += NTHR) ((LAS unsigned*)(F.lds + LDSCTL_OFF))[u] = 0u;
    __syncthreads();
    const bool one_launch = (args.ph_hi - args.ph_lo) > 1;
    XcdBarrier bar; bar.bar = (unsigned*)(F.ctl + CW_BAR); bar.x = 0; bar.st = nullptr;
    if (one_launch) bar = xcd_barrier_post((unsigned*)(F.ctl + CW_BAR), (volatile LAS unsigned*)(F.lds + LDSCTL_OFF + 32));
    const int lo = args.ph_lo, hi = args.ph_hi;
#ifndef PH_MASK
#define PH_MASK 0x1fff
#endif
#define IN(k) (lo <= (k) && (k) < hi)
#define EN(j) (((PH_MASK) >> (j)) & 1)
#define PHASE_BEGIN() do { F.tid = opq((int)threadIdx.x); F.lane = F.tid & 63; F.wave = __builtin_amdgcn_readfirstlane(F.tid >> 6); { int v_ = F.vcu; asm volatile("" : "+s"(v_)); F.vcu = v_; } } while (0)
#define SEAM(k) do { if (IN(k) && IN((k) + 1)) xcd_barrier(bar); } while (0)
#define XBY ((bf16*)(F.ws + WS_XBY))
#define PROJ ((bf16*)(F.ws + WS_PROJ))
#define XSOB ((bf16*)(F.ws + WS_PROJ))
#define HB ((bf16*)(F.ws + WS_HP))
#define HL ((float*)(F.ws + WS_HP))
#define PL ((float*)(F.ws + WS_HP) + (size_t)MTOK * DLRU)
#define SUMM ((float*)(F.ws + WS_SUMM))
#define RS1 ((float*)(F.ws + WS_RS1))
#define RS2 ((float*)(F.ws + WS_RS2))
#define TOKE ((int*)(F.ws + WS_TOKE))
#define TOKR ((int*)(F.ws + WS_TOKR))
#define TOKG ((float*)(F.ws + WS_TOKG))
#define RSS ((float*)(F.ws + WS_RSS))
#define GTS ((float*)(F.ws + WS_GTS))

    if (EN(0) && IN(0)) { PHASE_BEGIN(); convert_weights(F, 0); x_to_bf16_rows(F, F.in[0], XBY, RS1); }
    SEAM(0);
#pragma unroll 1
    for (int l = 0; l < DEPTH; ++l) {
        const int pb = 1 + l * PH_PER_LAYER;
        const float* xin = (l == 0) ? F.in[0] : F.out;
        if (EN(1) && IN(pb + 0)) { PHASE_BEGIN(); pg8::Gemm g{XBY, (const bf16*)(F.ws + WS_WIN), MTOK, DIN, DM}; pg8::StaticOrder S; S.init(MTOK, DIN, F.G, (int)blockIdx.x);
            pg8::EpiProj E{PROJ, RS1, F.in[3] + l * HD, F.in[4] + l * HD, DIN, QSCALE};
            pg8::gemm_phase<pg8::EpiProj, pg8::StaticOrder, true, true>(F.lds, g, S, E); }
        SEAM(pb + 0);
        if (EN(2) && IN(pb + 1)) { PHASE_BEGIN();
            if (EN(10)) for (int a = F.vcu; a < NB * NH * (SEQ / 256); a += F.G) { const int qb = a & 31, bh = a >> 5; att::unit(F, bh >> 3, bh & 7, qb, PROJ, XBY); }
            if (EN(11)) for (int u = F.vcu; u < MTOK / 64; u += F.G) conf::unit(F, u, l, PROJ, XBY);
            if (EN(12)) for (int u = F.vcu; u < MTOK / 64; u += F.G) lru::unit(F, u, l, PROJ, HL, PL, SUMM);
        }
        SEAM(pb + 1);
        if (EN(3) && IN(pb + 2)) { PHASE_BEGIN(); for (int u = F.vcu; u < MTOK / 64; u += F.G) fixup_unit(F, u, PROJ, HL, PL, SUMM, XBY); }
        SEAM(pb + 2);
        if (EN(4) && IN(pb + 3)) { PHASE_BEGIN(); pg8::Gemm g{XBY, (const bf16*)(F.ws + WS_WOUT), MTOK, DM, DM}; pg8::StaticOrder S; S.init(MTOK, DM, F.G, (int)blockIdx.x);
            pg8::EpiResid E{xin, F.out, DM};
            pg8::gemm_phase<pg8::EpiResid, pg8::StaticOrder, true, true>(F.lds, g, S, E); }
        SEAM(pb + 3);
        if (EN(5) && IN(pb + 4)) { PHASE_BEGIN(); for (int u = F.vcu; u < MTOK / 128; u += F.G) router_unit(F, u, l, F.out, RS2, TOKE, TOKR, TOKG); }
        SEAM(pb + 4);
        if (EN(6) && IN(pb + 5)) { PHASE_BEGIN(); gather_phase(F, l, F.out, RS2, TOKE, TOKR, TOKG, XSOB, RSS, GTS); }
        SEAM(pb + 5);
        if (EN(7) && IN(pb + 6)) { PHASE_BEGIN(); LAS int* PST = (LAS int*)(F.lds + SCR_BYTES - 2048); LAS int* TE = PST + 64; const int ntile = moe_tables(F, l, PST, TE);
            pg8::Gemm g{XSOB, (const bf16*)(F.ws + WS_W1), MAXSLOT, NE * 1024, DM}; pg8::MoeOrder S{ntile * 4, F.G, F.vcu, (const PG8_LAS int*)TE};
            pg8::EpiSwiglu E{HB, RSS, DE};
            pg8::gemm_phase<pg8::EpiSwiglu, pg8::MoeOrder, true, true>(F.lds, g, S, E); }
        SEAM(pb + 6);
        if (EN(8) && IN(pb + 7)) { PHASE_BEGIN(); LAS int* PST = (LAS int*)(F.lds + SCR_BYTES - 2048); LAS int* TE = PST + 64; const int ntile = moe_tables(F, l, PST, TE);
            pg8::Gemm g{HB, (const bf16*)(F.ws + WS_W2), MAXSLOT, NE * 1024, DE}; pg8::MoeOrder S{ntile * 4, F.G, F.vcu, (const PG8_LAS int*)TE};
            pg8::EpiGate E{XSOB, GTS, DM};
            pg8::gemm_phase<pg8::EpiGate, pg8::MoeOrder, true, true>(F.lds, g, S, E); }
        SEAM(pb + 7);
        if (EN(9) && IN(pb + 8)) { PHASE_BEGIN(); combine_phase(F, l, F.out, TOKE, TOKR, XSOB, l + 1 < DEPTH, XBY, RS1); if (l + 1 < DEPTH) convert_weights(F, l + 1); }
        if (l + 1 < DEPTH) SEAM(pb + 8);
    }
#undef IN
#undef SEAM
}

extern "C" void kernel_launch(void* const* d_in, const int* in_sizes, int n_in, void* d_out, int out_size, void* d_ws, size_t ws_size, hipStream_t stream) {
    static int grid = 0;
    if (grid == 0) {
        if (n_in != 26 || in_sizes[0] != MTOK * DM || out_size != MTOK * DM || ws_size < WS_END) { fprintf(stderr, "kernel_launch: unexpected shapes (n_in %d, in0 %d, out %d, ws %zu < %zu); nothing launched\n", n_in, n_in > 0 ? in_sizes[0] : -1, out_size, ws_size, (size_t)WS_END); grid = -1; return; }
        int dev = 0, cus = 0, per_cu = 0;
        if (hipGetDevice(&dev) != hipSuccess || hipDeviceGetAttribute(&cus, hipDeviceAttributeMultiprocessorCount, dev) != hipSuccess) { grid = -1; return; }
        if (hipFuncSetAttribute((const void*)mk_fwd, hipFuncAttributeMaxDynamicSharedMemorySize, LDS_BYTES) != hipSuccess) { fprintf(stderr, "kernel_launch: hipFuncSetAttribute failed\n"); grid = -1; return; }
        if (hipOccupancyMaxActiveBlocksPerMultiprocessor(&per_cu, (const void*)mk_fwd, NTHR, LDS_BYTES) != hipSuccess || per_cu < 1) { fprintf(stderr, "kernel_launch: occupancy query reports %d blocks per CU; nothing launched\n", per_cu); (void)hipGetLastError(); grid = -1; return; }
        grid = cus;
    }
    if (grid < 0) return;
    if (hipMemsetAsync((char*)d_ws + WS_CTL, 0, CTL_ZERO_BYTES, stream) != hipSuccess) { fprintf(stderr, "kernel_launch: memset failed\n"); return; }
    Args a{};
    for (int i = 0; i < 26; ++i) a.in[i] = (const float*)d_in[i];
    a.out = (float*)d_out; a.ws = (unsigned char*)d_ws;
#if defined(MK_PER_PHASE) && MK_PER_PHASE
    for (int p = 0; p < N_PHASES; ++p) { a.ph_lo = p; a.ph_hi = p + 1; hipLaunchKernelGGL(mk_fwd, dim3(grid), dim3(NTHR), LDS_BYTES, stream, a); }
#else
    a.ph_lo = 0; a.ph_hi = N_PHASES; hipLaunchKernelGGL(mk_fwd, dim3(grid), dim3(NTHR), LDS_BYTES, stream, a);
#endif
    const hipError_t le = hipPeekAtLastError();
    if (le != hipSuccess) fprintf(stderr, "kernel_launch: launch failed: %s\n", hipGetErrorName(le));
}
```

```cpp
#include <hip/hip_runtime.h>
#include <cstdio>
#include <cstdint>
namespace pg8 {
#define PG8_LAS __attribute__((address_space(3)))
typedef unsigned short bf16_t;
typedef short bf16x8 __attribute__((ext_vector_type(8)));
typedef float f32x4 __attribute__((ext_vector_type(4)));
typedef unsigned u32x4 __attribute__((ext_vector_type(4)));
constexpr int BM = 256, BK = 64, HALF = 128, HTB = HALF * BK * 2  , STAGE_BYTES = 8 * HTB, NXCD = 8, WGM = 8;

__host__ __device__ __forceinline__ int lds_byte(int r, int c) { const int st = (r >> 4) * 2 + (c >> 5), rr = r & 15, cc = c & 31, ob = rr * 64 + cc * 2; return st * 1024 + (ob ^ (((ob >> 9) & 1) << 5)); }
__host__ __device__ __forceinline__ void stage_rc(int b, int& R, int& C) { const int st = b / 1024, sb = b % 1024, swz = sb ^ (((sb >> 9) & 1) << 5); R = (st >> 1) * 16 + swz / 64; C = (st & 1) * 32 + (swz % 64) / 2; }
__host__ __device__ __forceinline__ int perm32(int rho) { const int n = rho >> 4, i = rho & 15; return 8 * (i >> 2) + 4 * n + (i & 3); }

struct Unit { int pm, pn; };
struct Gemm { const bf16_t* A; const bf16_t* Bt; int M, N, K; };

struct StaticOrder {
    int nM, nN, nwg, G, c;
    __host__ __device__ void init(int M, int N, int G_, int c_) { nM = M / BM; nN = N / BM; nwg = nM * nN; G = G_; c = c_; }
    __host__ __device__ bool next(int i, Unit& u) const {
        const long L = (long)i * G + c; if (L >= nwg) return false;
        int wgid = (int)L; { const int q = nwg / NXCD, r = nwg % NXCD, xcd = wgid % NXCD, off = wgid / NXCD; wgid = (xcd < r ? xcd * (q + 1) : r * (q + 1) + (xcd - r) * q) + off; }
        const int nig = WGM * nN, gid = wgid / nig, fm = gid * WGM, gsz = (nM - fm) < WGM ? (nM - fm) : WGM;
        u.pm = fm + ((wgid % nig) % gsz); u.pn = (wgid % nig) / gsz; return true;
    }
    __device__ __forceinline__ void a_ready(const Unit&) const {}
    __device__ __forceinline__ void done(const Unit&) const {}
};
__device__ __forceinline__ unsigned cvt_pk_bf16(float lo, float hi) { unsigned r; asm volatile("v_cvt_pk_bf16_f32 %0, %1, %2" : "=v"(r) : "v"(lo), "v"(hi)); return r; }
typedef float f32x2 __attribute__((ext_vector_type(2)));
typedef float f32x2 __attribute__((ext_vector_type(2)));
typedef unsigned u32x2 __attribute__((ext_vector_type(2)));
struct EpiProj {
    static constexpr bool PERM = true, AFTER_DRAIN = false;
    bf16_t* P; const float* rs; const float* gq; const float* gk; int ldp; float qscale;
    __device__ __forceinline__ void operator()(const f32x4 (&acc)[2][2][4][2], const Unit& u, int wr, int wc, int fr, int fq) const {
        const int pn = u.pn; const bool headnorm = pn < 4;
        f32x4 g[2][2];
        if (headnorm) { const float* gp = (pn < 2) ? gq : gk; const float s = (pn < 2) ? qscale : 1.0f;
#pragma unroll
            for (int bj = 0; bj < 2; ++bj)
#pragma unroll
                for (int n = 0; n < 2; ++n) g[bj][n] = *(const f32x4*)(gp + 32 * bj + 8 * fq + 4 * n) * s; }
#pragma unroll
        for (int ai = 0; ai < 2; ++ai)
#pragma unroll
            for (int m = 0; m < 4; ++m) {
                asm volatile("" ::: "memory");
                const int row = u.pm * BM + ai * HALF + wr * 64 + m * 16 + fr; const float r = rs[row];
                f32x4 v[2][2];
#pragma unroll
                for (int bj = 0; bj < 2; ++bj)
#pragma unroll
                    for (int n = 0; n < 2; ++n) v[bj][n] = acc[ai][bj][m][n] * r;
                if (headnorm) { float ss = 0.f;
#pragma unroll
                    for (int bj = 0; bj < 2; ++bj)
#pragma unroll
                        for (int n = 0; n < 2; ++n) { const f32x4 x = v[bj][n]; ss += (x[0] * x[0] + x[1] * x[1]) + (x[2] * x[2] + x[3] * x[3]); }
                    ss += __shfl_xor(ss, 16); ss += __shfl_xor(ss, 32);
                    const float sc = __builtin_amdgcn_rsqf(ss * (1.0f / 64.0f) + 1e-6f);
#pragma unroll
                    for (int bj = 0; bj < 2; ++bj)
#pragma unroll
                        for (int n = 0; n < 2; ++n) v[bj][n] = v[bj][n] * g[bj][n] * sc; }
                bf16_t* rowp = P + (size_t)row * ldp + pn * BM + 64 * wc + 8 * fq;
#pragma unroll
                for (int bj = 0; bj < 2; ++bj) { u32x4 w; w.x = cvt_pk_bf16(v[bj][0][0], v[bj][0][1]); w.y = cvt_pk_bf16(v[bj][0][2], v[bj][0][3]); w.z = cvt_pk_bf16(v[bj][1][0], v[bj][1][1]); w.w = cvt_pk_bf16(v[bj][1][2], v[bj][1][3]);
                    *(u32x4*)(rowp + 32 * bj) = w; }
            }
    }
};
struct EpiResid {
    static constexpr bool PERM = false, AFTER_DRAIN = false;
    const float* base; float* out; int ldc;
    __device__ __forceinline__ void operator()(const f32x4 (&acc)[2][2][4][2], const Unit& u, int wr, int wc, int fr, int fq) const {
        const int col0 = u.pn * BM + wc * 32 + 4 * fq;
#pragma unroll
        for (int ai = 0; ai < 2; ++ai)
#pragma unroll
            for (int m = 0; m < 4; ++m) { const size_t off = (size_t)(u.pm * BM + ai * HALF + wr * 64 + m * 16 + fr) * ldc + col0;
                f32x4 b[2][2];
#pragma unroll
                for (int bj = 0; bj < 2; ++bj)
#pragma unroll
                    for (int n = 0; n < 2; ++n) b[bj][n] = *(const f32x4*)(base + off + bj * HALF + n * 16);
#pragma unroll
                for (int bj = 0; bj < 2; ++bj)
#pragma unroll
                    for (int n = 0; n < 2; ++n) *(f32x4*)(out + off + bj * HALF + n * 16) = b[bj][n] + acc[ai][bj][m][n];
                if (m & 1) asm volatile("" ::: "memory"); }
    }
};
struct EpiSwiglu {
    static constexpr bool PERM = true, AFTER_DRAIN = false;
    bf16_t* H; const float* rs; int ldh;
    __device__ __forceinline__ void operator()(const f32x4 (&acc)[2][2][4][2], const Unit& u, int wr, int wc, int fr, int fq) const {
        const int col0 = (u.pn & 3) * 128 + 16 * wc + 4 * fq;
#pragma unroll
        for (int ai = 0; ai < 2; ++ai)
#pragma unroll
            for (int m = 0; m < 4; ++m) { const int row = u.pm * BM + ai * HALF + wr * 64 + m * 16 + fr; const float r = rs[row];
#pragma unroll
                for (int bj = 0; bj < 2; ++bj) { const f32x4 g = acc[ai][bj][m][0] * r, up = acc[ai][bj][m][1] * r; float h[4];
#pragma unroll
                    for (int i = 0; i < 4; ++i) h[i] = g[i] * __builtin_amdgcn_rcpf(1.0f + __builtin_amdgcn_exp2f(-1.4426950408889634f * g[i])) * up[i];
                    u32x2 w; w.x = cvt_pk_bf16(h[0], h[1]); w.y = cvt_pk_bf16(h[2], h[3]);
                    *(u32x2*)(H + (size_t)row * ldh + col0 + 64 * bj) = w; } }
    }
};
struct EpiGate {
    static constexpr bool PERM = true, AFTER_DRAIN = false;
    bf16_t* O; const float* gate; int ldo;
    __device__ __forceinline__ void operator()(const f32x4 (&acc)[2][2][4][2], const Unit& u, int wr, int wc, int fr, int fq) const {
        const int col0 = (u.pn & 3) * BM + wc * 32 + 8 * fq;
#pragma unroll
        for (int ai = 0; ai < 2; ++ai)
#pragma unroll
            for (int m = 0; m < 4; ++m) { const int row = u.pm * BM + ai * HALF + wr * 64 + m * 16 + fr; const float gt = gate[row];
#pragma unroll
                for (int bj = 0; bj < 2; ++bj) { const f32x4 v0 = acc[ai][bj][m][0] * gt, v1 = acc[ai][bj][m][1] * gt;
                    u32x4 w; w.x = cvt_pk_bf16(v0[0], v0[1]); w.y = cvt_pk_bf16(v0[2], v0[3]); w.z = cvt_pk_bf16(v1[0], v1[1]); w.w = cvt_pk_bf16(v1[2], v1[3]);
                    *(u32x4*)(O + (size_t)row * ldo + col0 + bj * HALF) = w; } }
    }
};
struct MoeOrder {
    int nunits, G, c; const PG8_LAS int* tile_e;
    __device__ __forceinline__ bool next(int i, Unit& u) const { const int L = i * G + c; if (L >= nunits) return false; const int rt = L >> 2; u.pm = rt; u.pn = tile_e[rt] * 4 + (L & 3); return true; }
    __device__ __forceinline__ void a_ready(const Unit&) const {}
    __device__ __forceinline__ void done(const Unit&) const {}
};
template <class Epi, class Sched, bool ALIGN_EPI = false, bool SP2 = false>
__device__ __forceinline__ void gemm_phase(PG8_LAS unsigned char* lds, const Gemm g, const Sched& S, const Epi& E) {
    int tid_ = threadIdx.x; asm volatile("" : "+v"(tid_));
    const int tid = tid_, wid = __builtin_amdgcn_readfirstlane(tid >> 6), lane = tid & 63, wr = wid >> 2, wc = wid & 3, fr = lane & 15, fq = lane >> 4;
    const int K = g.K, nt = K / BK;
    unsigned voffA[2], voffB[2];
#pragma unroll
    for (int i = 0; i < 2; ++i) { int R, C; stage_rc(tid * 16 + i * 8192, R, C); const int Rb = Epi::PERM ? ((R & ~31) + perm32(R & 31)) : R;
        voffA[i] = (unsigned)(R * K + C) * 2u; voffB[i] = (unsigned)(Rb * K + C) * 2u; }
    const size_t kstep = (size_t)(BK * 2);
    const size_t hstep = (size_t)HALF * K * 2;
    const size_t tstep = 2 * hstep;
    const unsigned ldsw = (unsigned)wid * 1024u;
    const int aoff = lds_byte(wr * 64 + fr, fq * 8), boff = lds_byte(wc * 32 + fr, fq * 8);
#define PG8_SA(b, h) (((b) * 2 + (h)) * HTB)
#define PG8_SB(b, h) ((4 + (b) * 2 + (h)) * HTB)
#define PG8_STAGE(bufoff, gbase, voff) do { _Pragma("unroll") for (int _i = 0; _i < 2; ++_i) \
        __builtin_amdgcn_global_load_lds((const unsigned*)((const char*)(gbase) + (voff)[_i]), (PG8_LAS unsigned*)(lds + (bufoff) + ldsw + _i * 8192), 16, 0, 0); } while (0)
#define PG8_LDA(dst, b, h) do { _Pragma("unroll") for (int m = 0; m < 4; ++m) _Pragma("unroll") for (int k = 0; k < 2; ++k) dst[m][k] = *(const PG8_LAS bf16x8*)(lds + PG8_SA(b, h) + aoff + m * 2048 + k * 1024); } while (0)
#define PG8_LDB(dst, b, h) do { _Pragma("unroll") for (int n = 0; n < 2; ++n) _Pragma("unroll") for (int k = 0; k < 2; ++k) dst[n][k] = *(const PG8_LAS bf16x8*)(lds + PG8_SB(b, h) + boff + n * 2048 + k * 1024); } while (0)
#define PG8_MMA(ai, bj, At, Bt) do { __builtin_amdgcn_s_setprio(1); _Pragma("unroll") for (int m = 0; m < 4; ++m) _Pragma("unroll") for (int n = 0; n < 2; ++n) _Pragma("unroll") for (int k = 0; k < 2; ++k) \
        acc[ai][bj][m][n] = __builtin_amdgcn_mfma_f32_16x16x32_bf16(Bt[n][k], At[m][k], acc[ai][bj][m][n], 0, 0, 0); __builtin_amdgcn_s_setprio(0); } while (0)
#define PG8_WAIT_V(n) asm volatile("s_waitcnt vmcnt(" #n ")" ::: "memory")
#define PG8_WAIT_L(n) asm volatile("s_waitcnt lgkmcnt(" #n ")" ::: "memory")
#define PG8_BAR __builtin_amdgcn_s_barrier()
#define PG8_SCHED __builtin_amdgcn_sched_barrier(0)
    Unit cur, nxt; int ui = 0;
    if (!S.next(0, cur)) return;
    f32x4 acc[2][2][4][2];
#pragma unroll
    for (int a = 0; a < 2; ++a)
#pragma unroll
        for (int b = 0; b < 2; ++b)
#pragma unroll
            for (int m = 0; m < 4; ++m)
#pragma unroll
                for (int n = 0; n < 2; ++n) acc[a][b][m][n] = (f32x4){0.f, 0.f, 0.f, 0.f};
    bf16x8 At[4][2], B0[2][2], B1[2][2];
    const char* cA = (const char*)g.A + (size_t)cur.pm * tstep; const char* cB = (const char*)g.Bt + (size_t)cur.pn * tstep;
    S.a_ready(cur);
    if constexpr (SP2) {
        PG8_STAGE(PG8_SB(0, 0), cB, voffB); PG8_STAGE(PG8_SB(0, 1), cB + hstep, voffB); PG8_STAGE(PG8_SA(0, 0), cA, voffA); PG8_STAGE(PG8_SA(0, 1), cA + hstep, voffA);
        if (wr == 1) PG8_BAR;
        PG8_WAIT_V(2); PG8_BAR;
        PG8_STAGE(PG8_SB(1, 0), cB + kstep, voffB); PG8_STAGE(PG8_SA(1, 0), cA + kstep, voffA); PG8_STAGE(PG8_SB(1, 1), cB + hstep + kstep, voffB);
        PG8_WAIT_V(6); PG8_BAR;
    } else {
        PG8_STAGE(PG8_SB(0, 0), cB, voffB); PG8_STAGE(PG8_SA(0, 0), cA, voffA); PG8_STAGE(PG8_SB(0, 1), cB + hstep, voffB); PG8_STAGE(PG8_SA(0, 1), cA + hstep, voffA);
        if (wr == 1) PG8_BAR;
        PG8_WAIT_V(4); PG8_BAR;
        PG8_STAGE(PG8_SB(1, 0), cB + kstep, voffB); PG8_STAGE(PG8_SA(1, 0), cA + kstep, voffA); PG8_STAGE(PG8_SB(1, 1), cB + hstep + kstep, voffB);
        PG8_WAIT_V(6); PG8_BAR;
    }
    for (;;) {
        const bool has_next = S.next(ui + 1, nxt);
        const char* nA = has_next ? (const char*)g.A + (size_t)nxt.pm * tstep : cA; const char* nB = has_next ? (const char*)g.Bt + (size_t)nxt.pn * tstep : cB;
        for (int t = 0; t < nt; t += 2) {
            const bool last = (t == nt - 2);
            const char* a1 = cA + (size_t)(t + 1) * kstep;
            const char* a2 = last ? nA : cA + (size_t)(t + 2) * kstep; const char* b2 = last ? nB : cB + (size_t)(t + 2) * kstep;
            const char* a3 = a2 + kstep; const char* b3 = b2 + kstep;
            if (last && has_next) S.a_ready(nxt);
            if constexpr (SP2) {
            PG8_LDB(B0, 0, 0); PG8_LDB(B1, 0, 1); PG8_SCHED; PG8_LDA(At, 0, 0); PG8_STAGE(PG8_SA(1, 1), a1 + hstep, voffA);
            PG8_WAIT_V(8); PG8_WAIT_L(0); PG8_BAR; PG8_MMA(0, 0, At, B0); PG8_MMA(0, 1, At, B1); PG8_BAR; PG8_SCHED;
            PG8_LDA(At, 0, 1); PG8_STAGE(PG8_SB(0, 0), b2, voffB); PG8_STAGE(PG8_SB(0, 1), b2 + hstep, voffB); PG8_STAGE(PG8_SA(0, 0), a2, voffA);
            PG8_WAIT_V(8); PG8_WAIT_L(0); PG8_BAR; PG8_MMA(1, 0, At, B0); PG8_MMA(1, 1, At, B1); PG8_BAR; PG8_SCHED;
            PG8_LDB(B0, 1, 0); PG8_LDB(B1, 1, 1); PG8_SCHED; PG8_LDA(At, 1, 0); PG8_STAGE(PG8_SA(0, 1), a2 + hstep, voffA);
            PG8_WAIT_V(8); PG8_WAIT_L(0); PG8_BAR; PG8_MMA(0, 0, At, B0); PG8_MMA(0, 1, At, B1); PG8_BAR; PG8_SCHED;
            PG8_LDA(At, 1, 1); PG8_STAGE(PG8_SB(1, 0), b3, voffB); PG8_STAGE(PG8_SB(1, 1), b3 + hstep, voffB); PG8_STAGE(PG8_SA(1, 0), a3, voffA);
            PG8_WAIT_V(8); PG8_WAIT_L(0); PG8_BAR; PG8_MMA(1, 0, At, B0); PG8_MMA(1, 1, At, B1); PG8_BAR; PG8_SCHED;
            } else {
            PG8_LDB(B0, 0, 0); PG8_SCHED; PG8_LDA(At, 0, 0); PG8_STAGE(PG8_SA(1, 1), a1 + hstep, voffA);
            PG8_WAIT_L(8); PG8_BAR; PG8_WAIT_L(0); PG8_MMA(0, 0, At, B0); PG8_BAR; PG8_SCHED;
            PG8_LDB(B1, 0, 1); PG8_STAGE(PG8_SB(0, 0), b2, voffB);
            PG8_BAR; PG8_WAIT_L(0); PG8_MMA(0, 1, At, B1); PG8_BAR;
            PG8_LDA(At, 0, 1); PG8_STAGE(PG8_SA(0, 0), a2, voffA);
            PG8_BAR; PG8_WAIT_L(0); PG8_MMA(1, 0, At, B0); PG8_BAR; PG8_SCHED;
            PG8_STAGE(PG8_SB(0, 1), b2 + hstep, voffB);
            PG8_WAIT_V(6); PG8_BAR; PG8_MMA(1, 1, At, B1); PG8_BAR;
            PG8_LDB(B0, 1, 0); PG8_SCHED; PG8_LDA(At, 1, 0); PG8_STAGE(PG8_SA(0, 1), a2 + hstep, voffA);
            PG8_WAIT_L(8); PG8_BAR; PG8_WAIT_L(0); PG8_MMA(0, 0, At, B0); PG8_BAR; PG8_SCHED;
            PG8_LDB(B1, 1, 1); PG8_STAGE(PG8_SB(1, 0), b3, voffB);
            PG8_BAR; PG8_WAIT_L(0); PG8_MMA(0, 1, At, B1); PG8_BAR;
            PG8_LDA(At, 1, 1); PG8_STAGE(PG8_SA(1, 0), a3, voffA);
            PG8_BAR; PG8_WAIT_L(0); PG8_MMA(1, 0, At, B0); PG8_BAR; PG8_SCHED;
            PG8_STAGE(PG8_SB(1, 1), b3 + hstep, voffB);
            PG8_WAIT_V(6); PG8_BAR; PG8_MMA(1, 1, At, B1); PG8_BAR;
            }
        }
        if constexpr (ALIGN_EPI) { if (wr == 0) PG8_BAR; }
        if constexpr (!Epi::AFTER_DRAIN) { E(acc, cur, wr, wc, fr, fq); S.done(cur); }
        if (!has_next) break;
#pragma unroll
        for (int a = 0; a < 2; ++a)
#pragma unroll
            for (int b = 0; b < 2; ++b)
#pragma unroll
                for (int m = 0; m < 4; ++m)
#pragma unroll
                    for (int n = 0; n < 2; ++n) acc[a][b][m][n] = (f32x4){0.f, 0.f, 0.f, 0.f};
        cur = nxt; cA = nA; cB = nB; ++ui;
        if constexpr (ALIGN_EPI) { if (wr == 1) PG8_BAR; }
    }
    PG8_WAIT_V(0);
    if constexpr (!ALIGN_EPI) { if (wr == 0) PG8_BAR; }
    PG8_BAR;
    if constexpr (Epi::AFTER_DRAIN) { E.fused(acc, cur, wr, wc, fr, fq, lds, wid, lane); S.done(cur); }
#undef PG8_SA
#undef PG8_SB
#undef PG8_STAGE
#undef PG8_LDA
#undef PG8_LDB
#undef PG8_MMA
#undef PG8_WAIT_V
#undef PG8_WAIT_L
#undef PG8_BAR
#undef PG8_SCHED
}
}
#define GAS __attribute__((address_space(1)))
#define LAS __attribute__((address_space(3)))
typedef unsigned short bf16;
typedef unsigned v4u __attribute__((ext_vector_type(4)));
typedef float f32x4 __attribute__((ext_vector_type(4)));
typedef short bf16x8 __attribute__((ext_vector_type(8)));
typedef GAS unsigned gu32;
typedef GAS unsigned long long gu64;
#define RLX_AGENT __ATOMIC_RELAXED, __HIP_MEMORY_SCOPE_AGENT
#define LDS_WAIT() asm volatile("s_waitcnt lgkmcnt(0)" ::: "memory")
#define VM_WAIT() asm volatile("s_waitcnt vmcnt(0)" ::: "memory")
__device__ __forceinline__ unsigned long long rt() { return __builtin_amdgcn_s_memrealtime(); }
__device__ __forceinline__ unsigned f2bf(float f) { unsigned u = __builtin_bit_cast(unsigned, f); return (u + 0x7fffu + ((u >> 16) & 1u)) >> 16; }
__device__ __forceinline__ unsigned pk2(float lo, float hi) { return f2bf(lo) | (f2bf(hi) << 16); }

#define XB_TMO      128
#define XB_XCNT(j)  (256  + 64 * (j))
#define XB_XSUB(j)  (1280 + 64 * (j))
#define XB_XGEN(j)  (2304 + 64 * (j))
#define XB_TOP      3328
#define XB_TOPGEN   3392
#define XCD_BAR_WORDS 3456
#define XB_SPIN_CAP (1u << 18)

__device__ __forceinline__ unsigned xb_ld(unsigned* p)              { return __hip_atomic_load(p, __ATOMIC_RELAXED, __HIP_MEMORY_SCOPE_AGENT); }
__device__ __forceinline__ unsigned xb_add(unsigned* p, unsigned v) { return __hip_atomic_fetch_add(p, v, __ATOMIC_RELAXED, __HIP_MEMORY_SCOPE_AGENT); }
__device__ __forceinline__ unsigned xb_xcc_id() { return (unsigned)__builtin_amdgcn_s_getreg((3 << 11) | 20) & 0xFu; }
#define XB_SPIN(cond, bar) do { unsigned _sp = 0; while (cond) { __builtin_amdgcn_s_sleep(1); \
    if ((++_sp & 255u) == 0u) { if (xb_ld(&(bar)[XB_TMO])) break; if (_sp > XB_SPIN_CAP) { atomicAdd(&(bar)[XB_TMO], 1u); break; } } } } while (0)

struct XcdBarrier {
    unsigned* bar; unsigned x;
    volatile LAS unsigned* st;
};

__device__ __forceinline__ XcdBarrier xcd_barrier_post(unsigned* bar, volatile LAS unsigned* st) {
    XcdBarrier b; b.bar = bar; b.x = xb_xcc_id(); b.st = st;
    if (threadIdx.x == 0) (void)xb_add(&bar[XB_XCNT(b.x)], 1u);
    return b;
}
__device__ __forceinline__ void xcd_barrier_complete(unsigned* bar, unsigned x, unsigned& nloc, unsigned& nx) {
    const unsigned G = gridDim.x * gridDim.y * gridDim.z;
    unsigned sum, cnt, mine, sp = 0u;
    for (;;) {
        sum = 0u; cnt = 0u; mine = 0u;
#pragma unroll
        for (unsigned j = 0; j < 16; ++j) { const unsigned c = xb_ld(&bar[XB_XCNT(j)]); sum += c; cnt += (c > 0u) ? 1u : 0u; mine = (j == x) ? c : mine; }
        if (sum == G) break;
        __builtin_amdgcn_s_sleep(1);
        if ((++sp & 255u) == 0u) { if (xb_ld(&bar[XB_TMO])) break; if (sp > XB_SPIN_CAP) { atomicAdd(&bar[XB_TMO], 1u); break; } }
    }
    nloc = mine > 0u ? mine : 1u; nx = cnt > 0u ? cnt : 1u;
}

__device__ __forceinline__ void xcd_barrier(const XcdBarrier& b) {
    asm volatile("s_waitcnt vmcnt(0)" ::: "memory");
    __syncthreads();
    if (threadIdx.x == 0) {
        unsigned* bar = b.bar;
        __builtin_amdgcn_s_waitcnt(0);
        unsigned nloc = b.st[0], nx = b.st[1];
        if (nloc == 0u) { xcd_barrier_complete(bar, b.x, nloc, nx); b.st[0] = nloc; b.st[1] = nx; }
        const unsigned old = xb_add(&bar[XB_XSUB(b.x)], 1u);
        const unsigned gen = old / nloc;
        if (old + 1u == (gen + 1u) * nloc) {
            __builtin_amdgcn_fence(__ATOMIC_RELEASE, "agent");
            asm volatile("s_waitcnt vmcnt(0)" ::: "memory");
            const unsigned og = xb_add(&bar[XB_TOP], 1u);
            const unsigned tg = og / nx;
            if (og + 1u == (tg + 1u) * nx) xb_add(&bar[XB_TOPGEN], 1u);
            else XB_SPIN(xb_ld(&bar[XB_TOPGEN]) == tg, bar);
            __builtin_amdgcn_fence(__ATOMIC_ACQUIRE, "agent");
            xb_add(&bar[XB_XGEN(b.x)], 1u);
            asm volatile("s_waitcnt vmcnt(0)" ::: "memory");
        } else {
            XB_SPIN(xb_ld(&bar[XB_XGEN(b.x)]) == gen, bar);
            __builtin_amdgcn_fence(__ATOMIC_ACQUIRE, "agent");
            asm volatile("s_waitcnt vmcnt(0)" ::: "memory");
        }
    }
    __syncthreads();
}

constexpr int NB = 4, SEQ = 8192, DM = 1024, MTOK = NB * SEQ, DEPTH = 2;
constexpr int DIN = 2560, NH = 8, HD = 64, DLRU = 256, DCONF = 256, NE = 32, DE = 512;
constexpr int COL_Q = 0, COL_K = 512, COL_V = 1024, COL_XR = 1536, COL_XG = 1792, COL_XC = 2048;
constexpr int NRT = 36, NRTP = 48;
constexpr int MAXSLOT = 73728;
constexpr float EPSN = 1e-6f;
constexpr float LOG2E = 1.4426950408889634f;
constexpr float QSCALE = 0.125f * LOG2E;
constexpr float EXIT_THR2 = 120.0f * LOG2E;

constexpr size_t MiB = 1u << 20;
constexpr size_t WS_CTL = 0, CTL_ZERO_BYTES = 1 * MiB;
constexpr size_t WS_WIN = 1 * MiB;
constexpr size_t WS_WOUT = 6 * MiB;
constexpr size_t WS_W1 = 8 * MiB;
constexpr size_t WS_W2 = 72 * MiB;
constexpr size_t WS_PW = 104 * MiB;
constexpr size_t WS_LRUW = WS_PW + 128 * 1024;
constexpr size_t WS_WR = WS_PW + 256 * 1024;
constexpr size_t WS_RS1 = 105 * MiB;
constexpr size_t WS_RS2 = WS_RS1 + 128 * 1024;
constexpr size_t WS_TOKE = WS_RS2 + 128 * 1024;
constexpr size_t WS_TOKR = WS_TOKE + 256 * 1024;
constexpr size_t WS_TOKG = WS_TOKR + 256 * 1024;
constexpr size_t WS_RSS = WS_TOKG + 256 * 1024;
constexpr size_t WS_GTS = WS_RSS + 288 * 1024;
constexpr size_t WS_SUMM = 107 * MiB;
constexpr size_t WS_XBY = 109 * MiB;
constexpr size_t WS_PROJ = 173 * MiB;
constexpr size_t WS_HP = 333 * MiB;
constexpr size_t WS_END = 405 * MiB;
constexpr int CW_TMO = 0, CW_BAR = 4096, CW_CNT = 8192;

constexpr int SCR_BYTES = 143360;
constexpr int LDSCTL_OFF = SCR_BYTES;
constexpr int LDS_BYTES = 147456;
constexpr int NWAVES = 8, NTHR = 512;

typedef float f32x16 __attribute__((ext_vector_type(16)));
typedef short s16x4 __attribute__((ext_vector_type(4)));
typedef unsigned u32x2 __attribute__((ext_vector_type(2)));
typedef float f32x2 __attribute__((ext_vector_type(2)));
typedef __bf16 bf16x2_t __attribute__((ext_vector_type(2)));

__device__ __forceinline__ unsigned cvtpk(float lo, float hi) { f32x2 v = {lo, hi}; bf16x2_t b = __builtin_convertvector(v, bf16x2_t); return __builtin_bit_cast(unsigned, b); }
__device__ __forceinline__ float bflo(unsigned w) { return __uint_as_float(w << 16); }
__device__ __forceinline__ float bfhi(unsigned w) { return __uint_as_float(w & 0xffff0000u); }
__device__ __forceinline__ float fexp2(float x) { return __builtin_amdgcn_exp2f(x); }
__device__ __forceinline__ float flog2(float x) { return __builtin_amdgcn_logf(x); }
__device__ __forceinline__ float frcp(float x) { return __builtin_amdgcn_rcpf(x); }
__device__ __forceinline__ float sigmoidf_(float x) { return frcp(1.0f + fexp2(-LOG2E * x)); }
__device__ __forceinline__ float wave_sum(float v) {
#pragma unroll
    for (int o = 1; o < 64; o <<= 1) v += __shfl_xor(v, o);
    return v;
}
#define WG_SYNC() __syncthreads()
__device__ __forceinline__ int opq(int x) { asm volatile("" : "+v"(x)); return x; }

struct Frame {
    LAS unsigned char* lds;
    gu32* ctl;
    int tid, lane, wave, vcu, G;
    const float* const* in;
    float* out; unsigned char* ws;
};

__device__ __forceinline__ int dest_row(int n, int mode) {
    if (mode == 1) { const int t = n & ~255, c = n & 255; return t + 128 * ((c >> 5) & 1) + 32 * (c >> 6) + (c & 31); }
    if (mode == 2) return 8 * (n >> 2) + (n & 3);
    if (mode == 3) return 8 * (n >> 2) + 4 + (n & 3);
    return n;
}
__device__ __forceinline__ void transpose_item(const float* W, int ldn, int k0, int n0, const float* gain, bf16* WT, int ldk, int mode, LAS float* scr, int lane) {
#pragma unroll 8
    for (int i = 0; i < 32; ++i) { const int kk = 2 * i + (lane >> 5); float v = W[(size_t)(k0 + kk) * ldn + n0 + (lane & 31)]; if (gain) v *= gain[k0 + kk]; scr[kk * 33 + (lane & 31)] = v; }
    LDS_WAIT(); asm volatile("" ::: "memory");
    const int c = lane & 7;
#pragma unroll
    for (int j = 0; j < 4; ++j) { const int n = (lane >> 3) + 8 * j; const LAS float* s = scr + (8 * c) * 33 + n;
        v4u o; o.x = cvtpk(s[0 * 33], s[1 * 33]); o.y = cvtpk(s[2 * 33], s[3 * 33]); o.z = cvtpk(s[4 * 33], s[5 * 33]); o.w = cvtpk(s[6 * 33], s[7 * 33]);
        *(GAS v4u*)(WT + (size_t)dest_row(n0 + n, mode) * ldk + k0 + 8 * c) = o; }
    LDS_WAIT(); asm volatile("" ::: "memory");
}
__device__ __forceinline__ void convert_weights(Frame& F, int l) {
    LAS float* scr = (LAS float*)(F.lds + F.wave * 16384);
    const int gw = F.vcu * NWAVES + F.wave, NGW = F.G * NWAVES;
    const float* g1 = F.in[1] + l * DM; const float* w_in = F.in[2] + (size_t)l * DM * DIN;
    const float* gout = F.in[18] + l * DM; const float* w_out = F.in[19] + (size_t)l * DM * DM;
    const float* g2 = F.in[20] + l * DM;
    const float* wg = F.in[23] + (size_t)l * NE * DM * DE; const float* wu = F.in[24] + (size_t)l * NE * DM * DE; const float* wd = F.in[25] + (size_t)l * NE * DE * DM;
    const float* pw = F.in[16] + (size_t)l * DCONF * DCONF;
    const float* wa = F.in[7] + (size_t)l * 4 * 64 * 64; const float* wx = F.in[9] + (size_t)l * 4 * 64 * 64;
    bf16* Win = (bf16*)(F.ws + WS_WIN); bf16* Wout = (bf16*)(F.ws + WS_WOUT); bf16* W1 = (bf16*)(F.ws + WS_W1); bf16* W2 = (bf16*)(F.ws + WS_W2);
    bf16* PW = (bf16*)(F.ws + WS_PW); bf16* LW = (bf16*)(F.ws + WS_LRUW); float* WR = (float*)(F.ws + WS_WR);
    constexpr int I_IN = (DM / 64) * (DIN / 32), I_OUT = (DM / 64) * (DM / 32), I_GU = NE * (DM / 64) * (DE / 32), I_D = NE * (DE / 64) * (DM / 32);
    constexpr int I_PW = (DCONF / 64) * (DCONF / 32), I_LW = 8 * 1 * 2;
    constexpr int NITEMS = I_IN + I_OUT + 2 * I_GU + I_D + I_PW + I_LW;
    for (int it = gw; it < NITEMS; it += NGW) {
        int r = it;
        if (r < I_GU) { const int e = r / 256, q = r % 256, kb = q / 16, nb = q % 16; transpose_item(wg + (size_t)e * DM * DE, DE, 64 * kb, 32 * nb, g2, W1 + (size_t)e * 1024 * 1024, DM, 2, scr, F.lane); continue; } r -= I_GU;
        if (r < I_GU) { const int e = r / 256, q = r % 256, kb = q / 16, nb = q % 16; transpose_item(wu + (size_t)e * DM * DE, DE, 64 * kb, 32 * nb, g2, W1 + (size_t)e * 1024 * 1024, DM, 3, scr, F.lane); continue; } r -= I_GU;
        if (r < I_D) { const int e = r / 256, q = r % 256, kb = q / 32, nb = q % 32; transpose_item(wd + (size_t)e * DE * DM, DM, 64 * kb, 32 * nb, nullptr, W2 + (size_t)e * 1024 * 512, DE, 0, scr, F.lane); continue; } r -= I_D;
        if (r < I_IN) { const int kb = r / (DIN / 32), nb = r % (DIN / 32); transpose_item(w_in, DIN, 64 * kb, 32 * nb, g1, Win, DM, 1, scr, F.lane); continue; } r -= I_IN;
        if (r < I_OUT) { const int kb = r / 32, nb = r % 32; transpose_item(w_out, DM, 64 * kb, 32 * nb, gout, Wout, DM, 0, scr, F.lane); continue; } r -= I_OUT;
        if (r < I_PW) { const int kb = r / 8, nb = r % 8; transpose_item(pw, DCONF, 64 * kb, 32 * nb, nullptr, PW, DCONF, 0, scr, F.lane); continue; } r -= I_PW;
        { const int mat = r >> 1, nb = r & 1; const float* src = (mat < 4 ? wa : wx) + (size_t)(mat & 3) * 64 * 64; transpose_item(src, 64, 0, 32 * nb, nullptr, LW + (size_t)mat * 64 * 64, 64, 0, scr, F.lane); }
    }
    const float* rc = F.in[21] + (size_t)l * DM * 4; const float* rf = F.in[22] + (size_t)l * DM * NE;
    for (int idx = (F.vcu * NTHR + F.tid); idx < NRTP * DM; idx += F.G * NTHR) { const int n = idx / DM, k = idx % DM;
        float v = 0.f; if (n < 4) v = rc[k * 4 + n] * g2[k]; else if (n < NRT) v = rf[k * NE + (n - 4)] * g2[k]; WR[idx] = v; }
}
__device__ __forceinline__ void x_to_bf16_rows(Frame& F, const float* x, bf16* XB, float* RS1) {
    const int gw = F.vcu * NWAVES + F.wave, NGW = F.G * NWAVES;
    for (int m = gw; m < MTOK; m += NGW) {
        const GAS f32x4* xr = (const GAS f32x4*)(x + (size_t)m * DM) + F.lane; f32x4 v[4]; float s = 0.f;
#pragma unroll
        for (int j = 0; j < 4; ++j) { v[j] = xr[64 * j]; s += (v[j].x * v[j].x + v[j].y * v[j].y) + (v[j].z * v[j].z + v[j].w * v[j].w); }
        s = wave_sum(s);
        GAS u32x2* o8 = (GAS u32x2*)(XB + (size_t)m * DM) + F.lane;
#pragma unroll
        for (int j = 0; j < 4; ++j) { u32x2 w; w.x = cvtpk(v[j].x, v[j].y); w.y = cvtpk(v[j].z, v[j].w); o8[64 * j] = w; }
        if (F.lane == 0) RS1[m] = __builtin_amdgcn_rsqf(s * (1.0f / DM) + EPSN);
    }
}

namespace att {
constexpr int SLOTB = 8192, L_K = 0, L_V = 2 * SLOTB, L_OST = 4 * SLOTB, L_FLAG = L_OST + NWAVES * 4096;
__device__ __forceinline__ int crow(int r, int hi) { return (r & 3) + 8 * (r >> 2) + 4 * hi; }
typedef const LAS unsigned char* lptr;
__device__ __forceinline__ void unit(Frame& F, int b, int h, int qb, const bf16* PROJ, bf16* Y) {
    const int lane = (opq((int)threadIdx.x) & 63), r32 = lane & 31, hi = lane >> 5, wid = F.wave;
    LAS unsigned char* shm = F.lds;
    const long rowbase = (long)b * SEQ; const int q0 = qb * 256;
    const bf16* Qw = PROJ + (rowbase + q0 + wid * 32) * DIN + COL_Q + h * HD;
    const bf16* Kh = PROJ + rowbase * DIN + COL_K + h * HD; const bf16* Vh = PROJ + rowbase * DIN + COL_V + h * HD;
    bf16x8 qr[4];
#pragma unroll
    for (int d0 = 0; d0 < 4; ++d0) qr[d0] = *(const GAS bf16x8*)(Qw + (long)r32 * DIN + d0 * 16 + hi * 8);
    f32x16 o[2]; o[0] = f32x16{}; o[1] = f32x16{};
    float R = 0.f;
    const int first_tile = 4 * qb + (wid >> 1), T_top = 4 * qb + 3;
    const int qpos = q0 + wid * 32 + r32;
    bool wave_done = false;
    const bf16* ksrc = Kh + (long)lane * DIN + wid * 8;
    const bf16* vsrc = Vh + (long)(16 * (wid & 3) + (lane >> 2)) * DIN + (wid >> 2) * 32 + (lane & 3) * 8;
    LAS unsigned char* kdst = shm + L_K + wid * 1024 + lane * 16; LAS unsigned char* vdst = shm + L_V + wid * 1024 + lane * 16;
    const int vb0 = (int)(uintptr_t)(shm + L_V) + ((lane >> 4) & 1) * 32 + (lane & 3) * 8 + (4 * hi + ((lane & 15) >> 2)) * 64;
    volatile LAS int* flag = (volatile LAS int*)(shm + L_FLAG);
    v4u kreg = *(const GAS v4u*)(ksrc + (long)T_top * 64 * DIN), vreg = *(const GAS v4u*)(vsrc + (long)T_top * 64 * DIN);
    *(LAS v4u*)kdst = kreg; *(LAS v4u*)vdst = vreg;
    LDS_WAIT(); WG_SYNC();
    int s = 0;
    for (int t = T_top;; --t, s ^= 1) {
        if (t > 0) { kreg = *(const GAS v4u*)(ksrc + (long)(t - 1) * 64 * DIN); vreg = *(const GAS v4u*)(vsrc + (long)(t - 1) * 64 * DIN); }
        if (t <= first_tile && !wave_done) {
            f32x16 p0 = f32x16{}, p1 = f32x16{};
            { lptr kb = shm + L_K + s * SLOTB + hi * 1024 + r32 * 16;
#pragma unroll
              for (int d0 = 0; d0 < 4; ++d0) { const bf16x8 b0 = *(const LAS bf16x8*)(kb + d0 * 2048), b1 = *(const LAS bf16x8*)(kb + d0 * 2048 + 512);
                  p0 = __builtin_amdgcn_mfma_f32_32x32x16_bf16(b0, qr[d0], p0, 0, 0, 0); p1 = __builtin_amdgcn_mfma_f32_32x32x16_bf16(b1, qr[d0], p1, 0, 0, 0); } }
            const bool diag = (t == first_tile); const int kbase = t * 64 + 4 * hi;
            f32x16 L0, L1;
#pragma unroll
            for (int r = 0; r < 16; ++r) {
                const int kk = kbase + (r & 3) + 8 * (r >> 2);
                { const float x = p0[r]; const float e = fexp2(-__builtin_fabsf(x)); const float sp = __builtin_fmaxf(x, 0.f) + flog2(1.0f + e); float lk = -sp; if (diag && !(kk < qpos)) lk = 0.f; L0[r] = lk; p0[r] = x - sp; }
                { const float x = p1[r]; const float e = fexp2(-__builtin_fabsf(x)); const float sp = __builtin_fmaxf(x, 0.f) + flog2(1.0f + e); float lk = -sp; if (diag && !(kk + 32 < qpos)) lk = 0.f; L1[r] = lk; p1[r] = x - sp; }
            }
            float Ghi[2][4], T[2][4];
#pragma unroll
            for (int bq = 0; bq < 4; ++bq) {
                const float g0 = (L0[4 * bq] + L0[4 * bq + 1]) + (L0[4 * bq + 2] + L0[4 * bq + 3]), g1 = (L1[4 * bq] + L1[4 * bq + 1]) + (L1[4 * bq + 2] + L1[4 * bq + 3]);
                auto r0 = __builtin_amdgcn_permlane32_swap(__float_as_uint(g0), __float_as_uint(g0), false, false);
                auto r1 = __builtin_amdgcn_permlane32_swap(__float_as_uint(g1), __float_as_uint(g1), false, false);
                Ghi[0][bq] = __uint_as_float(r0[1]); T[0][bq] = __uint_as_float(r0[0]) + __uint_as_float(r0[1]);
                Ghi[1][bq] = __uint_as_float(r1[1]); T[1][bq] = __uint_as_float(r1[0]) + __uint_as_float(r1[1]);
            }
            const float hm = hi ? 0.f : 1.f;
            float cum = R;
#pragma unroll
            for (int a = 1; a >= 0; --a)
#pragma unroll
                for (int bq = 3; bq >= 0; --bq) {
                    const float E = cum + hm * Ghi[a][bq];
                    if (a == 1) { const float s3 = E, s2 = s3 + L1[4 * bq + 3], s1 = s2 + L1[4 * bq + 2], s0 = s1 + L1[4 * bq + 1];
                        p1[4 * bq + 3] = fexp2(p1[4 * bq + 3] + s3); p1[4 * bq + 2] = fexp2(p1[4 * bq + 2] + s2); p1[4 * bq + 1] = fexp2(p1[4 * bq + 1] + s1); p1[4 * bq] = fexp2(p1[4 * bq] + s0); }
                    else { const float s3 = E, s2 = s3 + L0[4 * bq + 3], s1 = s2 + L0[4 * bq + 2], s0 = s1 + L0[4 * bq + 1];
                        p0[4 * bq + 3] = fexp2(p0[4 * bq + 3] + s3); p0[4 * bq + 2] = fexp2(p0[4 * bq + 2] + s2); p0[4 * bq + 1] = fexp2(p0[4 * bq + 1] + s1); p0[4 * bq] = fexp2(p0[4 * bq] + s0); }
                    cum += T[a][bq];
                }
            R = cum;
            if (diag) {
#pragma unroll
                for (int r = 0; r < 16; ++r) { const int kk = kbase + (r & 3) + 8 * (r >> 2); if (!(kk < qpos)) p0[r] = 0.f; if (!(kk + 32 < qpos)) p1[r] = 0.f; }
            }
            v4u pw0, pw1, pw2, pw3;
            pw0.x = cvtpk(p0[0], p0[1]); pw0.y = cvtpk(p0[2], p0[3]); pw0.z = cvtpk(p0[4], p0[5]); pw0.w = cvtpk(p0[6], p0[7]);
            pw1.x = cvtpk(p0[8], p0[9]); pw1.y = cvtpk(p0[10], p0[11]); pw1.z = cvtpk(p0[12], p0[13]); pw1.w = cvtpk(p0[14], p0[15]);
            pw2.x = cvtpk(p1[0], p1[1]); pw2.y = cvtpk(p1[2], p1[3]); pw2.z = cvtpk(p1[4], p1[5]); pw2.w = cvtpk(p1[6], p1[7]);
            pw3.x = cvtpk(p1[8], p1[9]); pw3.y = cvtpk(p1[10], p1[11]); pw3.z = cvtpk(p1[12], p1[13]); pw3.w = cvtpk(p1[14], p1[15]);
            const int vb = vb0 + s * SLOTB;
#pragma unroll
            for (int d0 = 0; d0 < 2; ++d0) { s16x4 lo[4], hh[4];
#pragma unroll
                for (int ks = 0; ks < 4; ++ks) {
                    asm volatile("ds_read_b64_tr_b16 %0,%1 offset:%c2" : "=&v"(lo[ks]) : "v"(vb), "i"(d0 * 4096 + ks * 1024) : "memory");
                    asm volatile("ds_read_b64_tr_b16 %0,%1 offset:%c2" : "=&v"(hh[ks]) : "v"(vb), "i"(d0 * 4096 + ks * 1024 + 512) : "memory"); }
                asm volatile("s_waitcnt lgkmcnt(0)" ::: "memory"); __builtin_amdgcn_sched_barrier(0);
#define ATT_PK(k) (bf16x8){lo[k][0], lo[k][1], lo[k][2], lo[k][3], hh[k][0], hh[k][1], hh[k][2], hh[k][3]}
                o[d0] = __builtin_amdgcn_mfma_f32_32x32x16_bf16(__builtin_bit_cast(bf16x8, pw0), ATT_PK(0), o[d0], 0, 0, 0);
                o[d0] = __builtin_amdgcn_mfma_f32_32x32x16_bf16(__builtin_bit_cast(bf16x8, pw1), ATT_PK(1), o[d0], 0, 0, 0);
                o[d0] = __builtin_amdgcn_mfma_f32_32x32x16_bf16(__builtin_bit_cast(bf16x8, pw2), ATT_PK(2), o[d0], 0, 0, 0);
                o[d0] = __builtin_amdgcn_mfma_f32_32x32x16_bf16(__builtin_bit_cast(bf16x8, pw3), ATT_PK(3), o[d0], 0, 0, 0);
#undef ATT_PK
            }
            wave_done = __all(R < -EXIT_THR2);
        }
        if (lane == 0) flag[s * 8 + wid] = wave_done ? 1 : 0;
        if (t > 0) { *(LAS v4u*)(kdst + (s ^ 1) * SLOTB) = kreg; *(LAS v4u*)(vdst + (s ^ 1) * SLOTB) = vreg; }
        LDS_WAIT(); WG_SYNC();
        if (t == 0) break;
        int alld = 1;
#pragma unroll
        for (int w = 0; w < 8; ++w) alld &= flag[s * 8 + w];
        if (alld) break;
    }
    { LAS bf16* stg = (LAS bf16*)(shm + L_OST) + wid * 2048;
#pragma unroll
      for (int r = 0; r < 16; ++r) { const int orow = crow(r, hi);
#pragma unroll
          for (int d0 = 0; d0 < 2; ++d0) stg[orow * 64 + d0 * 32 + r32] = (bf16)(cvtpk(o[d0][r], 0.f) & 0xffffu); }
      LDS_WAIT(); asm volatile("" ::: "memory");
      bf16* Ow = Y + (rowbase + q0 + wid * 32) * DM + h * HD;
#pragma unroll
      for (int i = 0; i < 4; ++i) { const int row = i * 8 + (lane >> 3), ch = lane & 7; const v4u v = *(const LAS v4u*)(stg + row * 64 + ch * 8); *(GAS v4u*)(Ow + (long)row * DM + ch * 8) = v; } }
    LDS_WAIT(); WG_SYNC();
}
}

namespace conf {
constexpr int TM = 64, HALO = 30, UROWS = TM + HALO;
constexpr int L_U = 0  , L_Z = 49152  , L_S = 0  , ZS = 260, SS = 264;
__device__ __forceinline__ void unit(Frame& F, int ut, int l, const bf16* PROJ, bf16* Y) {
    const int tid = opq((int)threadIdx.x), lane = tid & 63, wid = F.wave;
    const int row0 = ut * TM; const int t0 = row0 % SEQ;
    LAS bf16* U = (LAS bf16*)(F.lds + L_U); LAS float* Z = (LAS float*)(F.lds + L_Z); LAS bf16* S = (LAS bf16*)(F.lds + L_S);
    const float* dw_w = F.in[12] + (size_t)l * 31 * DCONF; const float* dw_b = F.in[13] + l * DCONF; const float* ln_g = F.in[14] + l * DCONF; const float* ln_b = F.in[15] + l * DCONF;
    const float* pw_b = F.in[17] + l * DCONF; const bf16* PW = (const bf16*)(F.ws + WS_PW);
    for (int task = tid; task < UROWS * 32; task += NTHR) { const int ur = task >> 5, c8 = task & 31; const int t = t0 - HALO + ur; v4u o = {0u, 0u, 0u, 0u};
        if (t >= 0) { const bf16* pr = PROJ + (size_t)(row0 - HALO + ur) * DIN + COL_XC + c8 * 8; const v4u a = *(const GAS v4u*)pr, g = *(const GAS v4u*)(pr + 256);
            unsigned av[4] = {a.x, a.y, a.z, a.w}, gv[4] = {g.x, g.y, g.z, g.w}, ov[4];
#pragma unroll
            for (int j = 0; j < 4; ++j) ov[j] = cvtpk(bflo(av[j]) * sigmoidf_(bflo(gv[j])), bfhi(av[j]) * sigmoidf_(bfhi(gv[j])));
            o.x = ov[0]; o.y = ov[1]; o.z = ov[2]; o.w = ov[3]; }
        *(LAS v4u*)(U + ur * 256 + c8 * 8) = o; }
    LDS_WAIT(); WG_SYNC();
    { const int c = tid & 255, hf = tid >> 8; float w[31];
#pragma unroll
      for (int j = 0; j < 31; ++j) w[j] = dw_w[j * DCONF + c];
      const float bias = dw_b[c]; float acc[32];
#pragma unroll
      for (int i = 0; i < 32; ++i) acc[i] = bias;
      const LAS bf16* up = U + (hf * 32) * 256 + c;
#pragma unroll
      for (int rho = 0; rho < 62; ++rho) { const float x = __uint_as_float((unsigned)up[rho * 256] << 16);
#pragma unroll
          for (int i = 0; i < 32; ++i) { const int j = rho - i; if (j >= 0 && j <= 30) acc[i] += w[j] * x; } }
#pragma unroll
      for (int i = 0; i < 32; ++i) Z[(hf * 32 + i) * ZS + c] = acc[i]; }
    LDS_WAIT(); WG_SYNC();
    { const f32x4 g = *(const GAS f32x4*)(ln_g + 4 * lane), bb = *(const GAS f32x4*)(ln_b + 4 * lane);
      for (int i = 0; i < 8; ++i) { const int tk = wid * 8 + i; f32x4 v = *(const LAS f32x4*)(Z + tk * ZS + 4 * lane);
          const float mean = wave_sum((v.x + v.y) + (v.z + v.w)) * (1.0f / 256.0f); v = v - mean;
          const float var = wave_sum((v.x * v.x + v.y * v.y) + (v.z * v.z + v.w * v.w)) * (1.0f / 256.0f); const float rstd = __builtin_amdgcn_rsqf(var + EPSN);
          f32x4 y = v * rstd * g + bb; y.x *= sigmoidf_(y.x); y.y *= sigmoidf_(y.y); y.z *= sigmoidf_(y.z); y.w *= sigmoidf_(y.w);
          u32x2 w2; w2.x = cvtpk(y.x, y.y); w2.y = cvtpk(y.z, y.w); *(LAS u32x2*)(S + tk * SS + 4 * lane) = w2; } }
    LDS_WAIT(); WG_SYNC();
    { const int fr = lane & 15, fq = lane >> 4; f32x4 acc[4][2];
#pragma unroll
      for (int m = 0; m < 4; ++m) { acc[m][0] = (f32x4){0.f, 0.f, 0.f, 0.f}; acc[m][1] = (f32x4){0.f, 0.f, 0.f, 0.f}; }
#pragma unroll 2
      for (int ks = 0; ks < 8; ++ks) { bf16x8 bfr[2], afr[4];
#pragma unroll
          for (int n = 0; n < 2; ++n) bfr[n] = *(const GAS bf16x8*)(PW + (size_t)(32 * wid + 16 * n + fr) * DCONF + 32 * ks + 8 * fq);
#pragma unroll
          for (int m = 0; m < 4; ++m) afr[m] = *(const LAS bf16x8*)(S + (16 * m + fr) * SS + 32 * ks + 8 * fq);
#pragma unroll
          for (int m = 0; m < 4; ++m)
#pragma unroll
              for (int n = 0; n < 2; ++n) acc[m][n] = __builtin_amdgcn_mfma_f32_16x16x32_bf16(afr[m], bfr[n], acc[m][n], 0, 0, 0); }
#pragma unroll
      for (int m = 0; m < 4; ++m)
#pragma unroll
          for (int n = 0; n < 2; ++n)
#pragma unroll
              for (int i = 0; i < 4; ++i) Z[(16 * m + 4 * fq + i) * ZS + 32 * wid + 16 * n + fr] = acc[m][n][i]; }
    LDS_WAIT(); WG_SYNC();
    { const f32x4 pb = *(const GAS f32x4*)(pw_b + 4 * lane);
      for (int i = 0; i < 8; ++i) { const int tk = wid * 8 + i; f32x4 v = *(const LAS f32x4*)(Z + tk * ZS + 4 * lane) + pb;
          const float ss = wave_sum((v.x * v.x + v.y * v.y) + (v.z * v.z + v.w * v.w)); const float rs = __builtin_amdgcn_rsqf(ss * (1.0f / 256.0f) + EPSN); v = v * rs;
          u32x2 w2; w2.x = cvtpk(v.x, v.y); w2.y = cvtpk(v.z, v.w); *(GAS u32x2*)(Y + (size_t)(row0 + tk) * DM + 768 + 4 * lane) = w2; } }
    LDS_WAIT(); WG_SYNC();
}
}

namespace lru {
constexpr int TM = 64, XS_ = 260, XBS = 264;
constexpr int L_XC = 0  , L_A = 66560  , L_XB = 66560  ;
__device__ __forceinline__ void unit(Frame& F, int ut, int l, const bf16* PROJ, float* HL, float* PL, float* SUMM) {
    const int tid = opq((int)threadIdx.x), lane = tid & 63, wid = F.wave;
    const int row0 = ut * TM; const int t0 = row0 % SEQ;
    LAS float* XC = (LAS float*)(F.lds + L_XC); LAS float* A = (LAS float*)(F.lds + L_A); LAS bf16* XB = (LAS bf16*)(F.lds + L_XB);
    const float* cw = F.in[5] + (size_t)l * 4 * DLRU; const float* cb = F.in[6] + l * DLRU; const float* ba = F.in[8] + l * DLRU; const float* bx = F.in[10] + l * DLRU; const float* lam = F.in[11] + l * DLRU;
    const bf16* LW = (const bf16*)(F.ws + WS_LRUW);
    for (int task = tid; task < TM * 32; task += NTHR) { const int tk = task >> 5, c8 = task & 31; float acc[8];
        { const f32x4 b0 = *(const GAS f32x4*)(cb + c8 * 8), b1 = *(const GAS f32x4*)(cb + c8 * 8 + 4); acc[0] = b0.x; acc[1] = b0.y; acc[2] = b0.z; acc[3] = b0.w; acc[4] = b1.x; acc[5] = b1.y; acc[6] = b1.z; acc[7] = b1.w; }
#pragma unroll
        for (int j = 0; j < 4; ++j) { const int t = t0 + tk - 3 + j; if (t >= 0) { const v4u a = *(const GAS v4u*)(PROJ + (size_t)(row0 + tk - 3 + j) * DIN + COL_XR + c8 * 8);
                const f32x4 w0 = *(const GAS f32x4*)(cw + j * DLRU + c8 * 8), w1 = *(const GAS f32x4*)(cw + j * DLRU + c8 * 8 + 4);
                acc[0] += w0.x * bflo(a.x); acc[1] += w0.y * bfhi(a.x); acc[2] += w0.z * bflo(a.y); acc[3] += w0.w * bfhi(a.y);
                acc[4] += w1.x * bflo(a.z); acc[5] += w1.y * bfhi(a.z); acc[6] += w1.z * bflo(a.w); acc[7] += w1.w * bfhi(a.w); } }
        *(LAS f32x4*)(XC + tk * XS_ + c8 * 8) = (f32x4){acc[0], acc[1], acc[2], acc[3]}; *(LAS f32x4*)(XC + tk * XS_ + c8 * 8 + 4) = (f32x4){acc[4], acc[5], acc[6], acc[7]};
        v4u o; o.x = cvtpk(acc[0], acc[1]); o.y = cvtpk(acc[2], acc[3]); o.z = cvtpk(acc[4], acc[5]); o.w = cvtpk(acc[6], acc[7]); *(LAS v4u*)(XB + tk * XBS + c8 * 8) = o; }
    LDS_WAIT(); WG_SYNC();
    const int nb = wid >> 1, mh = wid & 1, fr = lane & 15, fq = lane >> 4;
    f32x4 ar[2][4], ai[2][4];
#pragma unroll
    for (int m = 0; m < 2; ++m)
#pragma unroll
        for (int n = 0; n < 4; ++n) { ar[m][n] = (f32x4){0.f, 0.f, 0.f, 0.f}; ai[m][n] = (f32x4){0.f, 0.f, 0.f, 0.f}; }
#pragma unroll
    for (int ks = 0; ks < 2; ++ks) { bf16x8 af[2];
#pragma unroll
        for (int m = 0; m < 2; ++m) af[m] = *(const LAS bf16x8*)(XB + (32 * mh + 16 * m + fr) * XBS + 64 * nb + 32 * ks + 8 * fq);
#pragma unroll
        for (int n = 0; n < 4; ++n) { const bf16x8 bA = *(const GAS bf16x8*)(LW + (size_t)nb * 4096 + (16 * n + fr) * 64 + 32 * ks + 8 * fq), bX = *(const GAS bf16x8*)(LW + (size_t)(4 + nb) * 4096 + (16 * n + fr) * 64 + 32 * ks + 8 * fq);
#pragma unroll
            for (int m = 0; m < 2; ++m) { ar[m][n] = __builtin_amdgcn_mfma_f32_16x16x32_bf16(af[m], bA, ar[m][n], 0, 0, 0); ai[m][n] = __builtin_amdgcn_mfma_f32_16x16x32_bf16(af[m], bX, ai[m][n], 0, 0, 0); } } }
    LDS_WAIT(); WG_SYNC();
#pragma unroll
    for (int n = 0; n < 4; ++n) { const int ch = 64 * nb + 16 * n + fr; const float lsl8 = -8.0f * log1pf(__expf(-lam[ch])), bav = ba[ch], bxv = bx[ch];
#pragma unroll
        for (int m = 0; m < 2; ++m)
#pragma unroll
            for (int i = 0; i < 4; ++i) { const int tk = 32 * mh + 16 * m + 4 * fq + i; const float gr = ar[m][n][i] + bav, gi = ai[m][n][i] + bxv; const float xcv = XC[tk * XS_ + ch];
                const float la = lsl8 * sigmoidf_(gr); const float a = fexp2(LOG2E * la); const float mult = __builtin_sqrtf(__builtin_fmaxf(1.0f - a * a, 0.f));
                A[tk * XS_ + ch] = a; XC[tk * XS_ + ch] = mult * sigmoidf_(gi) * xcv; } }
    LDS_WAIT(); WG_SYNC();
    if (tid < 256) { const int c = tid; float h = 0.f, p = 1.f; float* hl = HL + (size_t)row0 * DLRU + c; float* pl = PL + (size_t)row0 * DLRU + c;
#pragma unroll 8
        for (int tk = 0; tk < TM; ++tk) { const float a = A[tk * XS_ + c], u = XC[tk * XS_ + c]; p *= a; h = a * h + u; hl[(size_t)tk * DLRU] = h; pl[(size_t)tk * DLRU] = p; }
        SUMM[(size_t)ut * 512 + c] = p; SUMM[(size_t)ut * 512 + 256 + c] = h; }
    LDS_WAIT(); WG_SYNC();
}
}

__device__ __forceinline__ void fixup_unit(Frame& F, int ut, const bf16* PROJ, const float* HL, const float* PL, const float* SUMM, bf16* Y) {
    const int tid = opq((int)threadIdx.x), lane = tid & 63, wid = F.wave; const int row0 = ut * 64; const int cb = (row0 % SEQ) / 64, ub0 = ut - cb;
    LAS float* CAR = (LAS float*)F.lds;
    if (tid < 256) { float car = 0.f;
#pragma unroll 8
        for (int j = 0; j < cb; ++j) { const float p = SUMM[(size_t)(ub0 + j) * 512 + tid], h = SUMM[(size_t)(ub0 + j) * 512 + 256 + tid]; car = p * car + h; }
        CAR[tid] = car; }
    LDS_WAIT(); WG_SYNC();
    const f32x4 car = *(const LAS f32x4*)(CAR + 4 * lane);
    for (int i = 0; i < 8; ++i) { const size_t row = (size_t)row0 + wid * 8 + i;
        const f32x4 hl = *(const GAS f32x4*)(HL + row * DLRU + 4 * lane), pl = *(const GAS f32x4*)(PL + row * DLRU + 4 * lane);
        const u32x2 xg = *(const GAS u32x2*)(PROJ + row * DIN + COL_XG + 4 * lane); const v4u ya = *(const GAS v4u*)(Y + row * DM + 8 * lane);
        f32x4 h = hl + pl * car; const float xv[4] = {bflo(xg.x), bfhi(xg.x), bflo(xg.y), bfhi(xg.y)}; float y[4];
#pragma unroll
        for (int j = 0; j < 4; ++j) { const float x = xv[j]; const float u2 = 1.5957691216057308f * (x + 0.044715f * x * x * x); y[j] = h[j] * x * sigmoidf_(u2); }
        const float ssb = wave_sum((y[0] * y[0] + y[1] * y[1]) + (y[2] * y[2] + y[3] * y[3])); const float rsb = __builtin_amdgcn_rsqf(ssb * (1.0f / 256.0f) + EPSN);
        u32x2 w2; w2.x = cvtpk(y[0] * rsb, y[1] * rsb); w2.y = cvtpk(y[2] * rsb, y[3] * rsb); *(GAS u32x2*)(Y + row * DM + 512 + 4 * lane) = w2;
        float a[8] = {bflo(ya.x), bfhi(ya.x), bflo(ya.y), bfhi(ya.y), bflo(ya.z), bfhi(ya.z), bflo(ya.w), bfhi(ya.w)}; float ssa = 0.f;
#pragma unroll
        for (int j = 0; j < 8; ++j) ssa += a[j] * a[j];
        ssa = wave_sum(ssa); const float rsa = __builtin_amdgcn_rsqf(ssa * (1.0f / 512.0f) + EPSN);
        v4u oa; oa.x = cvtpk(a[0] * rsa, a[1] * rsa); oa.y = cvtpk(a[2] * rsa, a[3] * rsa); oa.z = cvtpk(a[4] * rsa, a[5] * rsa); oa.w = cvtpk(a[6] * rsa, a[7] * rsa);
        *(GAS v4u*)(Y + row * DM + 8 * lane) = oa; }
    LDS_WAIT(); WG_SYNC();
}

__device__ __forceinline__ void router_unit(Frame& F, int ut, int l, const float* X, float* RS2, int* TOKE, int* TOKR, float* TOKG) {
    const int tid = opq((int)threadIdx.x), lane = tid & 63, wid = F.wave, fr = lane & 15, fq = lane >> 4;
    const float* WR = (const float*)(F.ws + WS_WR);
    LAS float* LG = (LAS float*)F.lds + wid * (16 * NRTP + 16);
    LAS int* CNT = (LAS int*)(F.lds + 32768); LAS int* BASE = CNT + 32;
    if (tid < 32) CNT[tid] = 0;
    const int r0 = ut * 128 + wid * 16;
    f32x4 acc[3]; acc[0] = (f32x4){0.f, 0.f, 0.f, 0.f}; acc[1] = acc[0]; acc[2] = acc[0]; float ss = 0.f;
    const float* xp = X + (size_t)(r0 + fr) * DM + 4 * fq; const float* wp = WR + (size_t)fr * DM + 4 * fq;
#pragma unroll 4
    for (int s = 0; s < DM / 16; ++s) { const f32x4 a = *(const GAS f32x4*)(xp + 16 * s); ss += (a.x * a.x + a.y * a.y) + (a.z * a.z + a.w * a.w);
#pragma unroll
        for (int n = 0; n < 3; ++n) { const f32x4 b = *(const GAS f32x4*)(wp + (size_t)16 * n * DM + 16 * s);
            acc[n] = __builtin_amdgcn_mfma_f32_16x16x4f32(a.x, b.x, acc[n], 0, 0, 0); acc[n] = __builtin_amdgcn_mfma_f32_16x16x4f32(a.y, b.y, acc[n], 0, 0, 0);
            acc[n] = __builtin_amdgcn_mfma_f32_16x16x4f32(a.z, b.z, acc[n], 0, 0, 0); acc[n] = __builtin_amdgcn_mfma_f32_16x16x4f32(a.w, b.w, acc[n], 0, 0, 0); } }
    ss += __shfl_xor(ss, 16); ss += __shfl_xor(ss, 32);
    const float rs = __builtin_amdgcn_rsqf(ss * (1.0f / DM) + EPSN);
    if (fq == 0) LG[16 * NRTP + fr] = rs;
#pragma unroll
    for (int n = 0; n < 3; ++n)
#pragma unroll
        for (int i = 0; i < 4; ++i) LG[(4 * fq + i) * NRTP + 16 * n + fr] = acc[n][i];
    LDS_WAIT(); WG_SYNC();
    int e0 = 0, e1 = 0, lr0 = 0, lr1 = 0; float g0 = 0.f, g1 = 0.f, rsv = 0.f;
    if (lane < 16) { const LAS float* lg = LG + lane * NRTP; rsv = LG[16 * NRTP + lane];
        float c[4]; int grp = 0; float cm;
#pragma unroll
        for (int j = 0; j < 4; ++j) c[j] = lg[j] * rsv;
        cm = c[0];
#pragma unroll
        for (int j = 1; j < 4; ++j) if (c[j] > cm) { cm = c[j]; grp = j; }
        float den = 0.f;
#pragma unroll
        for (int j = 0; j < 4; ++j) den += __expf(c[j] - cm);
        const float wgrp = 1.0f / den;
        float v0 = -INFINITY, v1 = -INFINITY; int i0 = 0, i1 = 0;
#pragma unroll
        for (int j = 0; j < 8; ++j) { const float v = lg[4 + grp * 8 + j] * rsv; if (v > v0) { v1 = v0; i1 = i0; v0 = v; i0 = j; } else if (v > v1) { v1 = v; i1 = j; } }
        const float ex = __expf(v1 - v0); g0 = wgrp / (1.0f + ex); g1 = wgrp * ex / (1.0f + ex);
        e0 = grp * 8 + i0; e1 = grp * 8 + i1;
        lr0 = atomicAdd((int*)(CNT + e0), 1); lr1 = atomicAdd((int*)(CNT + e1), 1); }
    LDS_WAIT(); WG_SYNC();
    if (tid < 32) { const int c = CNT[tid]; int bse = 0; if (c > 0) bse = (int)__hip_atomic_fetch_add((unsigned*)(F.ctl + CW_CNT + 64 * l + tid), (unsigned)c, __ATOMIC_RELAXED, __HIP_MEMORY_SCOPE_AGENT); BASE[tid] = bse; }
    LDS_WAIT(); WG_SYNC();
    if (lane < 16) { const int tok = r0 + lane; RS2[tok] = rsv; TOKE[2 * tok] = e0; TOKE[2 * tok + 1] = e1; TOKR[2 * tok] = BASE[e0] + lr0; TOKR[2 * tok + 1] = BASE[e1] + lr1; TOKG[2 * tok] = g0; TOKG[2 * tok + 1] = g1; }
    LDS_WAIT(); WG_SYNC();
}
__device__ __forceinline__ int moe_tables(Frame& F, int l, LAS int* PST, LAS int* TE) {
    if (F.tid == 0) { int acc = 0; for (int e = 0; e < NE; ++e) { const int c = (int)__hip_atomic_load(F.ctl + CW_CNT + 64 * l + e, __ATOMIC_RELAXED, __HIP_MEMORY_SCOPE_AGENT); PST[e] = acc; acc += (c + 255) & ~255; } PST[NE] = acc; }
    LDS_WAIT(); WG_SYNC();
    const int ntile = PST[NE] >> 8;
    for (int rt = F.tid; rt < ntile; rt += NTHR) { int e = 0;
        for (int j = 1; j < NE; ++j) if ((PST[j] >> 8) <= rt) e = j;
        TE[rt] = e; }
    LDS_WAIT(); WG_SYNC();
    return ntile;
}
__device__ __forceinline__ void gather_phase(Frame& F, int l, const float* X, const float* RS2, const int* TOKE, const int* TOKR, const float* TOKG, bf16* XS, float* RSS, float* GTS) {
    LAS int* PST = (LAS int*)F.lds; LAS int* TE = PST + 64;
    (void)moe_tables(F, l, PST, TE);
    const int gw = F.vcu * NWAVES + F.wave, NGW = F.G * NWAVES;
    for (int m = gw; m < MTOK; m += NGW) {
        const GAS f32x4* xr = (const GAS f32x4*)(X + (size_t)m * DM) + F.lane; u32x2 w[4];
#pragma unroll
        for (int j = 0; j < 4; ++j) { const f32x4 v = xr[64 * j]; w[j].x = cvtpk(v.x, v.y); w[j].y = cvtpk(v.z, v.w); }
        const float rs = RS2[m];
#pragma unroll
        for (int k = 0; k < 2; ++k) { const int e = TOKE[2 * m + k], slot = PST[e] + TOKR[2 * m + k];
            GAS u32x2* o8 = (GAS u32x2*)(XS + (size_t)slot * DM) + F.lane;
#pragma unroll
            for (int j = 0; j < 4; ++j) o8[64 * j] = w[j];
            if (F.lane == 0) { RSS[slot] = rs; GTS[slot] = TOKG[2 * m + k]; } }
    }
    for (int e = gw; e < NE; e += NGW) { const int c = (int)__hip_atomic_load(F.ctl + CW_CNT + 64 * l + e, __ATOMIC_RELAXED, __HIP_MEMORY_SCOPE_AGENT);
        for (int slot = PST[e] + c; slot < PST[e + 1]; ++slot) { GAS u32x2* o8 = (GAS u32x2*)(XS + (size_t)slot * DM) + F.lane;
#pragma unroll
            for (int j = 0; j < 4; ++j) o8[64 * j] = (u32x2){0u, 0u};
            if (F.lane == 0) { RSS[slot] = 0.f; GTS[slot] = 0.f; } } }
    LDS_WAIT(); WG_SYNC();
}
__device__ __forceinline__ void combine_phase(Frame& F, int l, float* X, const int* TOKE, const int* TOKR, const bf16* OB, bool next_layer, bf16* XB, float* RS1) {
    LAS int* PST = (LAS int*)F.lds; LAS int* TE = PST + 64;
    (void)moe_tables(F, l, PST, TE);
    const int gw = F.vcu * NWAVES + F.wave, NGW = F.G * NWAVES;
    for (int m = gw; m < MTOK; m += NGW) {
        const int s0 = PST[TOKE[2 * m]] + TOKR[2 * m], s1 = PST[TOKE[2 * m + 1]] + TOKR[2 * m + 1];
        GAS f32x4* xr = (GAS f32x4*)(X + (size_t)m * DM) + F.lane;
        const GAS u32x2* o0 = (const GAS u32x2*)(OB + (size_t)s0 * DM) + F.lane; const GAS u32x2* o1 = (const GAS u32x2*)(OB + (size_t)s1 * DM) + F.lane;
        f32x4 v[4]; float ss = 0.f;
#pragma unroll
        for (int j = 0; j < 4; ++j) { const f32x4 x = xr[64 * j]; const u32x2 a = o0[64 * j], b = o1[64 * j];
            v[j].x = x.x + (bflo(a.x) + bflo(b.x)); v[j].y = x.y + (bfhi(a.x) + bfhi(b.x)); v[j].z = x.z + (bflo(a.y) + bflo(b.y)); v[j].w = x.w + (bfhi(a.y) + bfhi(b.y));
            ss += (v[j].x * v[j].x + v[j].y * v[j].y) + (v[j].z * v[j].z + v[j].w * v[j].w); }
#pragma unroll
        for (int j = 0; j < 4; ++j) xr[64 * j] = v[j];
        if (next_layer) { ss = wave_sum(ss); GAS u32x2* o8 = (GAS u32x2*)(XB + (size_t)m * DM) + F.lane;
#pragma unroll
            for (int j = 0; j < 4; ++j) { u32x2 w; w.x = cvtpk(v[j].x, v[j].y); w.y = cvtpk(v[j].z, v[j].w); o8[64 * j] = w; }
            if (F.lane == 0) RS1[m] = __builtin_amdgcn_rsqf(ss * (1.0f / DM) + EPSN); }
    }
    LDS_WAIT(); WG_SYNC();
}

constexpr int PH_PER_LAYER = 9, N_PHASES = 1 + DEPTH * PH_PER_LAYER;
struct Args { const float* in[26]; float* out; unsigned char* ws; int ph_lo, ph_hi; };
__global__ void __launch_bounds__(NTHR, 2) mk_fwd(Args args) {
    extern __shared__ __attribute__((aligned(16))) unsigned char lds[];
    Frame F;
    F.lds = (LAS unsigned char*)lds;
    F.tid = threadIdx.x; F.lane = F.tid & 63; F.wave = __builtin_amdgcn_readfirstlane(F.tid >> 6);
    F.G = gridDim.x; { const int bx = blockIdx.x; F.vcu = (F.G % 8 == 0) ? (bx % 8) * (F.G / 8) + bx / 8 : bx; }
    F.in = args.in;
    F.out = args.out; F.ws = args.ws; F.ctl = (gu32*)(args.ws + WS_CTL);
    for (int u = F.tid; u < (LDS_BYTES - LDSCTL_OFF) / 4; u += NTHR) ((LAS unsigned*)(F.lds + LDSCTL_OFF))[u] = 0u;
    __syncthreads();
    const bool one_launch = (args.ph_hi - args.ph_lo) > 1;
    XcdBarrier bar; bar.bar = (unsigned*)(F.ctl + CW_BAR); bar.x = 0; bar.st = nullptr;
    if (one_launch) bar = xcd_barrier_post((unsigned*)(F.ctl + CW_BAR), (volatile LAS unsigned*)(F.lds + LDSCTL_OFF + 32));
    const int lo = args.ph_lo, hi = args.ph_hi;
#ifndef PH_MASK
#define PH_MASK 0x1fff
#endif
#define IN(k) (lo <= (k) && (k) < hi)
#define EN(j) (((PH_MASK) >> (j)) & 1)
#define PHASE_BEGIN() do { F.tid = opq((int)threadIdx.x); F.lane = F.tid & 63; F.wave = __builtin_amdgcn_readfirstlane(F.tid >> 6); { int v_ = F.vcu; asm volatile("" : "+s"(v_)); F.vcu = v_; } } while (0)
#define SEAM(k) do { if (IN(k) && IN((k) + 1)) xcd_barrier(bar); } while (0)
#define XBY ((bf16*)(F.ws + WS_XBY))
#define PROJ ((bf16*)(F.ws + WS_PROJ))
#define XSOB ((bf16*)(F.ws + WS_PROJ))
#define HB ((bf16*)(F.ws + WS_HP))
#define HL ((float*)(F.ws + WS_HP))
#define PL ((float*)(F.ws + WS_HP) + (size_t)MTOK * DLRU)
#define SUMM ((float*)(F.ws + WS_SUMM))
#define RS1 ((float*)(F.ws + WS_RS1))
#define RS2 ((float*)(F.ws + WS_RS2))
#define TOKE ((int*)(F.ws + WS_TOKE))
#define TOKR ((int*)(F.ws + WS_TOKR))
#define TOKG ((float*)(F.ws + WS_TOKG))
#define RSS ((float*)(F.ws + WS_RSS))
#define GTS ((float*)(F.ws + WS_GTS))

    if (EN(0) && IN(0)) { PHASE_BEGIN(); convert_weights(F, 0); x_to_bf16_rows(F, F.in[0], XBY, RS1); }
    SEAM(0);
#pragma unroll 1
    for (int l = 0; l < DEPTH; ++l) {
        const int pb = 1 + l * PH_PER_LAYER;
        const float* xin = (l == 0) ? F.in[0] : F.out;
        if (EN(1) && IN(pb + 0)) { PHASE_BEGIN(); pg8::Gemm g{XBY, (const bf16*)(F.ws + WS_WIN), MTOK, DIN, DM}; pg8::StaticOrder S; S.init(MTOK, DIN, F.G, (int)blockIdx.x);
            pg8::EpiProj E{PROJ, RS1, F.in[3] + l * HD, F.in[4] + l * HD, DIN, QSCALE};
            pg8::gemm_phase<pg8::EpiProj, pg8::StaticOrder, true, true>(F.lds, g, S, E); }
        SEAM(pb + 0);
        if (EN(2) && IN(pb + 1)) { PHASE_BEGIN();
            if (EN(10)) for (int a = F.vcu; a < NB * NH * (SEQ / 256); a += F.G) { const int qb = a & 31, bh = a >> 5; att::unit(F, bh >> 3, bh & 7, qb, PROJ, XBY); }
            if (EN(11)) for (int u = F.vcu; u < MTOK / 64; u += F.G) conf::unit(F, u, l, PROJ, XBY);
            if (EN(12)) for (int u = F.vcu; u < MTOK / 64; u += F.G) lru::unit(F, u, l, PROJ, HL, PL, SUMM);
        }
        SEAM(pb + 1);
        if (EN(3) && IN(pb + 2)) { PHASE_BEGIN(); for (int u = F.vcu; u < MTOK / 64; u += F.G) fixup_unit(F, u, PROJ, HL, PL, SUMM, XBY); }
        SEAM(pb + 2);
        if (EN(4) && IN(pb + 3)) { PHASE_BEGIN(); pg8::Gemm g{XBY, (const bf16*)(F.ws + WS_WOUT), MTOK, DM, DM}; pg8::StaticOrder S; S.init(MTOK, DM, F.G, (int)blockIdx.x);
            pg8::EpiResid E{xin, F.out, DM};
            pg8::gemm_phase<pg8::EpiResid, pg8::StaticOrder, true, true>(F.lds, g, S, E); }
        SEAM(pb + 3);
        if (EN(5) && IN(pb + 4)) { PHASE_BEGIN(); for (int u = F.vcu; u < MTOK / 128; u += F.G) router_unit(F, u, l, F.out, RS2, TOKE, TOKR, TOKG); }
        SEAM(pb + 4);
        if (EN(6) && IN(pb + 5)) { PHASE_BEGIN(); gather_phase(F, l, F.out, RS2, TOKE, TOKR, TOKG, XSOB, RSS, GTS); }
        SEAM(pb + 5);
        if (EN(7) && IN(pb + 6)) { PHASE_BEGIN(); LAS int* PST = (LAS int*)(F.lds + SCR_BYTES - 2048); LAS int* TE = PST + 64; const int ntile = moe_tables(F, l, PST, TE);
            pg8::Gemm g{XSOB, (const bf16*)(F.ws + WS_W1), MAXSLOT, NE * 1024, DM}; pg8::MoeOrder S{ntile * 4, F.G, F.vcu, (const PG8_LAS int*)TE};
            pg8::EpiSwiglu E{HB, RSS, DE};
            pg8::gemm_phase<pg8::EpiSwiglu, pg8::MoeOrder, true, true>(F.lds, g, S, E); }
        SEAM(pb + 6);
        if (EN(8) && IN(pb + 7)) { PHASE_BEGIN(); LAS int* PST = (LAS int*)(F.lds + SCR_BYTES - 2048); LAS int* TE = PST + 64; const int ntile = moe_tables(F, l, PST, TE);
            pg8::Gemm g{HB, (const bf16*)(F.ws + WS_W2), MAXSLOT, NE * 1024, DE}; pg8::MoeOrder S{ntile * 4, F.G, F.vcu, (const PG8_LAS int*)TE};
            pg8::EpiGate E{XSOB, GTS, DM};
            pg8::gemm_phase<pg8::EpiGate, pg8::MoeOrder, true, true>(F.lds, g, S, E); }
        SEAM(pb + 7);
        if (EN(9) && IN(pb + 8)) { PHASE_BEGIN(); combine_phase(F, l, F.out, TOKE, TOKR, XSOB, l + 1 < DEPTH, XBY, RS1); if (l + 1 < DEPTH) convert_weights(F, l + 1); }
        if (l + 1 < DEPTH) SEAM(pb + 8);
    }
#undef IN
#undef SEAM
}

extern "C" void kernel_launch(void* const* d_in, const int* in_sizes, int n_in, void* d_out, int out_size, void* d_ws, size_t ws_size, hipStream_t stream) {
    static int grid = 0;
    if (grid == 0) {
        if (n_in != 26 || in_sizes[0] != MTOK * DM || out_size != MTOK * DM || ws_size < WS_END) { fprintf(stderr, "kernel_launch: unexpected shapes (n_in %d, in0 %d, out %d, ws %zu < %zu); nothing launched\n", n_in, n_in > 0 ? in_sizes[0] : -1, out_size, ws_size, (size_t)WS_END); grid = -1; return; }
        int dev = 0, cus = 0, per_cu = 0;
        if (hipGetDevice(&dev) != hipSuccess || hipDeviceGetAttribute(&cus, hipDeviceAttributeMultiprocessorCount, dev) != hipSuccess) { grid = -1; return; }
        if (hipFuncSetAttribute((const void*)mk_fwd, hipFuncAttributeMaxDynamicSharedMemorySize, LDS_BYTES) != hipSuccess) { fprintf(stderr, "kernel_launch: hipFuncSetAttribute failed\n"); grid = -1; return; }
        if (hipOccupancyMaxActiveBlocksPerMultiprocessor(&per_cu, (const void*)mk_fwd, NTHR, LDS_BYTES) != hipSuccess || per_cu < 1) { fprintf(stderr, "kernel_launch: occupancy query reports %d blocks per CU; nothing launched\n", per_cu); (void)hipGetLastError(); grid = -1; return; }
        grid = cus;
    }
    if (grid < 0) return;
    if (hipMemsetAsync((char*)d_ws + WS_CTL, 0, CTL_ZERO_BYTES, stream) != hipSuccess) { fprintf(stderr, "kernel_launch: memset failed\n"); return; }
    Args a{};
    for (int i = 0; i < 26; ++i) a.in[i] = (const float*)d_in[i];
    a.out = (float*)d_out; a.ws = (unsigned char*)d_ws;
#if defined(MK_PER_PHASE) && MK_PER_PHASE
    for (int p = 0; p < N_PHASES; ++p) { a.ph_lo = p; a.ph_hi = p + 1; hipLaunchKernelGGL(mk_fwd, dim3(grid), dim3(NTHR), LDS_BYTES, stream, a); }
#else
    a.ph_lo = 0; a.ph_hi = N_PHASES; hipLaunchKernelGGL(mk_fwd, dim3(grid), dim3(NTHR), LDS_BYTES, stream, a);
#endif
    const hipError_t le = hipPeekAtLastError();
    if (le != hipSuccess) fprintf(stderr, "kernel_launch: launch failed: %s\n", hipGetErrorName(le));
}
```

```cpp
#include <hip/hip_runtime.h>
#include <cstdio>
#include <cstdint>
namespace pg8 {
#define PG8_LAS __attribute__((address_space(3)))
typedef unsigned short bf16_t;
typedef short bf16x8 __attribute__((ext_vector_type(8)));
typedef float f32x4 __attribute__((ext_vector_type(4)));
typedef unsigned u32x4 __attribute__((ext_vector_type(4)));
constexpr int BM = 256, BK = 64, HALF = 128, HTB = HALF * BK * 2  , STAGE_BYTES = 8 * HTB, NXCD = 8, WGM = 8;

__host__ __device__ __forceinline__ int lds_byte(int r, int c) { const int st = (r >> 4) * 2 + (c >> 5), rr = r & 15, cc = c & 31, ob = rr * 64 + cc * 2; return st * 1024 + (ob ^ (((ob >> 9) & 1) << 5)); }
__host__ __device__ __forceinline__ void stage_rc(int b, int& R, int& C) { const int st = b / 1024, sb = b % 1024, swz = sb ^ (((sb >> 9) & 1) << 5); R = (st >> 1) * 16 + swz / 64; C = (st & 1) * 32 + (swz % 64) / 2; }
__host__ __device__ __forceinline__ int perm32(int rho) { const int n = rho >> 4, i = rho & 15; return 8 * (i >> 2) + 4 * n + (i & 3); }

struct Unit { int pm, pn; };
struct Gemm { const bf16_t* A; const bf16_t* Bt; int M, N, K; };

struct StaticOrder {
    int nM, nN, nwg, G, c;
    __host__ __device__ void init(int M, int N, int G_, int c_) { nM = M / BM; nN = N / BM; nwg = nM * nN; G = G_; c = c_; }
    __host__ __device__ bool next(int i, Unit& u) const {
        const long L = (long)i * G + c; if (L >= nwg) return false;
        int wgid = (int)L; { const int q = nwg / NXCD, r = nwg % NXCD, xcd = wgid % NXCD, off = wgid / NXCD; wgid = (xcd < r ? xcd * (q + 1) : r * (q + 1) + (xcd - r) * q) + off; }
        const int nig = WGM * nN, gid = wgid / nig, fm = gid * WGM, gsz = (nM - fm) < WGM ? (nM - fm) : WGM;
        u.pm = fm + ((wgid % nig) % gsz); u.pn = (wgid % nig) / gsz; return true;
    }
    __device__ __forceinline__ void a_ready(const Unit&) const {}
    __device__ __forceinline__ void done(const Unit&) const {}
};
__device__ __forceinline__ unsigned cvt_pk_bf16(float lo, float hi) { unsigned r; asm volatile("v_cvt_pk_bf16_f32 %0, %1, %2" : "=v"(r) : "v"(lo), "v"(hi)); return r; }
typedef float f32x2 __attribute__((ext_vector_type(2)));
typedef float f32x2 __attribute__((ext_vector_type(2)));
typedef unsigned u32x2 __attribute__((ext_vector_type(2)));
struct EpiProj {
    static constexpr bool PERM = true, AFTER_DRAIN = false;
    bf16_t* P; const float* rs; const float* gq; const float* gk; int ldp; float qscale;
    __device__ __forceinline__ void operator()(const f32x4 (&acc)[2][2][4][2], const Unit& u, int wr, int wc, int fr, int fq) const {
        const int pn = u.pn; const bool headnorm = pn < 4;
        f32x4 g[2][2];
        if (headnorm) { const float* gp = (pn < 2) ? gq : gk; const float s = (pn < 2) ? qscale : 1.0f;
#pragma unroll
            for (int bj = 0; bj < 2; ++bj)
#pragma unroll
                for (int n = 0; n < 2; ++n) g[bj][n] = *(const f32x4*)(gp + 32 * bj + 8 * fq + 4 * n) * s; }
#pragma unroll
        for (int ai = 0; ai < 2; ++ai)
#pragma unroll
            for (int m = 0; m < 4; ++m) {
                asm volatile("" ::: "memory");
                const int row = u.pm * BM + ai * HALF + wr * 64 + m * 16 + fr; const float r = rs[row];
                f32x4 v[2][2];
#pragma unroll
                for (int bj = 0; bj < 2; ++bj)
#pragma unroll
                    for (int n = 0; n < 2; ++n) v[bj][n] = acc[ai][bj][m][n] * r;
                if (headnorm) { float ss = 0.f;
#pragma unroll
                    for (int bj = 0; bj < 2; ++bj)
#pragma unroll
                        for (int n = 0; n < 2; ++n) { const f32x4 x = v[bj][n]; ss += (x[0] * x[0] + x[1] * x[1]) + (x[2] * x[2] + x[3] * x[3]); }
                    ss += __shfl_xor(ss, 16); ss += __shfl_xor(ss, 32);
                    const float sc = __builtin_amdgcn_rsqf(ss * (1.0f / 64.0f) + 1e-6f);
#pragma unroll
                    for (int bj = 0; bj < 2; ++bj)
#pragma unroll
                        for (int n = 0; n < 2; ++n) v[bj][n] = v[bj][n] * g[bj][n] * sc; }
                bf16_t* rowp = P + (size_t)row * ldp + pn * BM + 64 * wc + 8 * fq;
#pragma unroll
                for (int bj = 0; bj < 2; ++bj) { u32x4 w; w.x = cvt_pk_bf16(v[bj][0][0], v[bj][0][1]); w.y = cvt_pk_bf16(v[bj][0][2], v[bj][0][3]); w.z = cvt_pk_bf16(v[bj][1][0], v[bj][1][1]); w.w = cvt_pk_bf16(v[bj][1][2], v[bj][1][3]);
                    *(u32x4*)(rowp + 32 * bj) = w; }
            }
    }
};
struct EpiResid {
    static constexpr bool PERM = false, AFTER_DRAIN = false;
    const float* base; float* out; int ldc;
    __device__ __forceinline__ void operator()(const f32x4 (&acc)[2][2][4][2], const Unit& u, int wr, int wc, int fr, int fq) const {
        const int col0 = u.pn * BM + wc * 32 + 4 * fq;
#pragma unroll
        for (int ai = 0; ai < 2; ++ai)
#pragma unroll
            for (int m = 0; m < 4; ++m) { const size_t off = (size_t)(u.pm * BM + ai * HALF + wr * 64 + m * 16 + fr) * ldc + col0;
                f32x4 b[2][2];
#pragma unroll
                for (int bj = 0; bj < 2; ++bj)
#pragma unroll
                    for (int n = 0; n < 2; ++n) b[bj][n] = *(const f32x4*)(base + off + bj * HALF + n * 16);
#pragma unroll
                for (int bj = 0; bj < 2; ++bj)
#pragma unroll
                    for (int n = 0; n < 2; ++n) *(f32x4*)(out + off + bj * HALF + n * 16) = b[bj][n] + acc[ai][bj][m][n];
                if (m & 1) asm volatile("" ::: "memory"); }
    }
};
struct EpiSwiglu {
    static constexpr bool PERM = true, AFTER_DRAIN = false;
    bf16_t* H; const float* rs; int ldh;
    __device__ __forceinline__ void operator()(const f32x4 (&acc)[2][2][4][2], const Unit& u, int wr, int wc, int fr, int fq) const {
        const int col0 = (u.pn & 3) * 128 + 16 * wc + 4 * fq;
#pragma unroll
        for (int ai = 0; ai < 2; ++ai)
#pragma unroll
            for (int m = 0; m < 4; ++m) { const int row = u.pm * BM + ai * HALF + wr * 64 + m * 16 + fr; const float r = rs[row];
#pragma unroll
                for (int bj = 0; bj < 2; ++bj) { const f32x4 g = acc[ai][bj][m][0] * r, up = acc[ai][bj][m][1] * r; float h[4];
#pragma unroll
                    for (int i = 0; i < 4; ++i) h[i] = g[i] * __builtin_amdgcn_rcpf(1.0f + __builtin_amdgcn_exp2f(-1.4426950408889634f * g[i])) * up[i];
                    u32x2 w; w.x = cvt_pk_bf16(h[0], h[1]); w.y = cvt_pk_bf16(h[2], h[3]);
                    *(u32x2*)(H + (size_t)row * ldh + col0 + 64 * bj) = w; } }
    }
};
struct EpiGate {
    static constexpr bool PERM = true, AFTER_DRAIN = false;
    bf16_t* O; const float* gate; int ldo;
    __device__ __forceinline__ void operator()(const f32x4 (&acc)[2][2][4][2], const Unit& u, int wr, int wc, int fr, int fq) const {
        const int col0 = (u.pn & 3) * BM + wc * 32 + 8 * fq;
#pragma unroll
        for (int ai = 0; ai < 2; ++ai)
#pragma unroll
            for (int m = 0; m < 4; ++m) { const int row = u.pm * BM + ai * HALF + wr * 64 + m * 16 + fr; const float gt = gate[row];
#pragma unroll
                for (int bj = 0; bj < 2; ++bj) { const f32x4 v0 = acc[ai][bj][m][0] * gt, v1 = acc[ai][bj][m][1] * gt;
                    u32x4 w; w.x = cvt_pk_bf16(v0[0], v0[1]); w.y = cvt_pk_bf16(v0[2], v0[3]); w.z = cvt_pk_bf16(v1[0], v1[1]); w.w = cvt_pk_bf16(v1[2], v1[3]);
                    *(u32x4*)(O + (size_t)row * ldo + col0 + bj * HALF) = w; } }
    }
};
struct MoeOrder {
    int nunits, G, c; const PG8_LAS int* tile_e;
    __device__ __forceinline__ bool next(int i, Unit& u) const { const int L = i * G + c; if (L >= nunits) return false; const int rt = L >> 2; u.pm = rt; u.pn = tile_e[rt] * 4 + (L & 3); return true; }
    __device__ __forceinline__ void a_ready(const Unit&) const {}
    __device__ __forceinline__ void done(const Unit&) const {}
};
template <class Epi, class Sched, bool ALIGN_EPI = false, bool SP2 = false>
__device__ __forceinline__ void gemm_phase(PG8_LAS unsigned char* lds, const Gemm g, const Sched& S, const Epi& E) {
    int tid_ = threadIdx.x; asm volatile("" : "+v"(tid_));
    const int tid = tid_, wid = __builtin_amdgcn_readfirstlane(tid >> 6), lane = tid & 63, wr = wid >> 2, wc = wid & 3, fr = lane & 15, fq = lane >> 4;
    const int K = g.K, nt = K / BK;
    unsigned voffA[2], voffB[2];
#pragma unroll
    for (int i = 0; i < 2; ++i) { int R, C; stage_rc(tid * 16 + i * 8192, R, C); const int Rb = Epi::PERM ? ((R & ~31) + perm32(R & 31)) : R;
        voffA[i] = (unsigned)(R * K + C) * 2u; voffB[i] = (unsigned)(Rb * K + C) * 2u; }
    const size_t kstep = (size_t)(BK * 2);
    const size_t hstep = (size_t)HALF * K * 2;
    const size_t tstep = 2 * hstep;
    const unsigned ldsw = (unsigned)wid * 1024u;
    const int aoff = lds_byte(wr * 64 + fr, fq * 8), boff = lds_byte(wc * 32 + fr, fq * 8);
#define PG8_SA(b, h) (((b) * 2 + (h)) * HTB)
#define PG8_SB(b, h) ((4 + (b) * 2 + (h)) * HTB)
#define PG8_STAGE(bufoff, gbase, voff) do { _Pragma("unroll") for (int _i = 0; _i < 2; ++_i) \
        __builtin_amdgcn_global_load_lds((const unsigned*)((const char*)(gbase) + (voff)[_i]), (PG8_LAS unsigned*)(lds + (bufoff) + ldsw + _i * 8192), 16, 0, 0); } while (0)
#define PG8_LDA(dst, b, h) do { _Pragma("unroll") for (int m = 0; m < 4; ++m) _Pragma("unroll") for (int k = 0; k < 2; ++k) dst[m][k] = *(const PG8_LAS bf16x8*)(lds + PG8_SA(b, h) + aoff + m * 2048 + k * 1024); } while (0)
#define PG8_LDB(dst, b, h) do { _Pragma("unroll") for (int n = 0; n < 2; ++n) _Pragma("unroll") for (int k = 0; k < 2; ++k) dst[n][k] = *(const PG8_LAS bf16x8*)(lds + PG8_SB(b, h) + boff + n * 2048 + k * 1024); } while (0)
#define PG8_MMA(ai, bj, At, Bt) do { __builtin_amdgcn_s_setprio(1); _Pragma("unroll") for (int m = 0; m < 4; ++m) _Pragma("unroll") for (int n = 0; n < 2; ++n) _Pragma("unroll") for (int k = 0; k < 2; ++k) \
        acc[ai][bj][m][n] = __builtin_amdgcn_mfma_f32_16x16x32_bf16(Bt[n][k], At[m][k], acc[ai][bj][m][n], 0, 0, 0); __builtin_amdgcn_s_setprio(0); } while (0)
#define PG8_WAIT_V(n) asm volatile("s_waitcnt vmcnt(" #n ")" ::: "memory")
#define PG8_WAIT_L(n) asm volatile("s_waitcnt lgkmcnt(" #n ")" ::: "memory")
#define PG8_BAR __builtin_amdgcn_s_barrier()
#define PG8_SCHED __builtin_amdgcn_sched_barrier(0)
    Unit cur, nxt; int ui = 0;
    if (!S.next(0, cur)) return;
    f32x4 acc[2][2][4][2];
#pragma unroll
    for (int a = 0; a < 2; ++a)
#pragma unroll
        for (int b = 0; b < 2; ++b)
#pragma unroll
            for (int m = 0; m < 4; ++m)
#pragma unroll
                for (int n = 0; n < 2; ++n) acc[a][b][m][n] = (f32x4){0.f, 0.f, 0.f, 0.f};
    bf16x8 At[4][2], B0[2][2], B1[2][2];
    const char* cA = (const char*)g.A + (size_t)cur.pm * tstep; const char* cB = (const char*)g.Bt + (size_t)cur.pn * tstep;
    S.a_ready(cur);
    if constexpr (SP2) {
        PG8_STAGE(PG8_SB(0, 0), cB, voffB); PG8_STAGE(PG8_SB(0, 1), cB + hstep, voffB); PG8_STAGE(PG8_SA(0, 0), cA, voffA); PG8_STAGE(PG8_SA(0, 1), cA + hstep, voffA);
        if (wr == 1) PG8_BAR;
        PG8_WAIT_V(2); PG8_BAR;
        PG8_STAGE(PG8_SB(1, 0), cB + kstep, voffB); PG8_STAGE(PG8_SA(1, 0), cA + kstep, voffA); PG8_STAGE(PG8_SB(1, 1), cB + hstep + kstep, voffB);
        PG8_WAIT_V(6); PG8_BAR;
    } else {
        PG8_STAGE(PG8_SB(0, 0), cB, voffB); PG8_STAGE(PG8_SA(0, 0), cA, voffA); PG8_STAGE(PG8_SB(0, 1), cB + hstep, voffB); PG8_STAGE(PG8_SA(0, 1), cA + hstep, voffA);
        if (wr == 1) PG8_BAR;
        PG8_WAIT_V(4); PG8_BAR;
        PG8_STAGE(PG8_SB(1, 0), cB + kstep, voffB); PG8_STAGE(PG8_SA(1, 0), cA + kstep, voffA); PG8_STAGE(PG8_SB(1, 1), cB + hstep + kstep, voffB);
        PG8_WAIT_V(6); PG8_BAR;
    }
    for (;;) {
        const bool has_next = S.next(ui + 1, nxt);
        const char* nA = has_next ? (const char*)g.A + (size_t)nxt.pm * tstep : cA; const char* nB = has_next ? (const char*)g.Bt + (size_t)nxt.pn * tstep : cB;
        for (int t = 0; t < nt; t += 2) {
            const bool last = (t == nt - 2);
            const char* a1 = cA + (size_t)(t + 1) * kstep;
            const char* a2 = last ? nA : cA + (size_t)(t + 2) * kstep; const char* b2 = last ? nB : cB + (size_t)(t + 2) * kstep;
            const char* a3 = a2 + kstep; const char* b3 = b2 + kstep;
            if (last && has_next) S.a_ready(nxt);
            if constexpr (SP2) {
            PG8_LDB(B0, 0, 0); PG8_LDB(B1, 0, 1); PG8_SCHED; PG8_LDA(At, 0, 0); PG8_STAGE(PG8_SA(1, 1), a1 + hstep, voffA);
            PG8_WAIT_V(8); PG8_WAIT_L(0); PG8_BAR; PG8_MMA(0, 0, At, B0); PG8_MMA(0, 1, At, B1); PG8_BAR; PG8_SCHED;
            PG8_LDA(At, 0, 1); PG8_STAGE(PG8_SB(0, 0), b2, voffB); PG8_STAGE(PG8_SB(0, 1), b2 + hstep, voffB); PG8_STAGE(PG8_SA(0, 0), a2, voffA);
            PG8_WAIT_V(8); PG8_WAIT_L(0); PG8_BAR; PG8_MMA(1, 0, At, B0); PG8_MMA(1, 1, At, B1); PG8_BAR; PG8_SCHED;
            PG8_LDB(B0, 1, 0); PG8_LDB(B1, 1, 1); PG8_SCHED; PG8_LDA(At, 1, 0); PG8_STAGE(PG8_SA(0, 1), a2 + hstep, voffA);
            PG8_WAIT_V(8); PG8_WAIT_L(0); PG8_BAR; PG8_MMA(0, 0, At, B0); PG8_MMA(0, 1, At, B1); PG8_BAR; PG8_SCHED;
            PG8_LDA(At, 1, 1); PG8_STAGE(PG8_SB(1, 0), b3, voffB); PG8_STAGE(PG8_SB(1, 1), b3 + hstep, voffB); PG8_STAGE(PG8_SA(1, 0), a3, voffA);
            PG8_WAIT_V(8); PG8_WAIT_L(0); PG8_BAR; PG8_MMA(1, 0, At, B0); PG8_MMA(1, 1, At, B1); PG8_BAR; PG8_SCHED;
            } else {
            PG8_LDB(B0, 0, 0); PG8_SCHED; PG8_LDA(At, 0, 0); PG8_STAGE(PG8_SA(1, 1), a1 + hstep, voffA);
            PG8_WAIT_L(8); PG8_BAR; PG8_WAIT_L(0); PG8_MMA(0, 0, At, B0); PG8_BAR; PG8_SCHED;
            PG8_LDB(B1, 0, 1); PG8_STAGE(PG8_SB(0, 0), b2, voffB);
            PG8_BAR; PG8_WAIT_L(0); PG8_MMA(0, 1, At, B1); PG8_BAR;
            PG8_LDA(At, 0, 1); PG8_STAGE(PG8_SA(0, 0), a2, voffA);
            PG8_BAR; PG8_WAIT_L(0); PG8_MMA(1, 0, At, B0); PG8_BAR; PG8_SCHED;
            PG8_STAGE(PG8_SB(0, 1), b2 + hstep, voffB);
            PG8_WAIT_V(6); PG8_BAR; PG8_MMA(1, 1, At, B1); PG8_BAR;
            PG8_LDB(B0, 1, 0); PG8_SCHED; PG8_LDA(At, 1, 0); PG8_STAGE(PG8_SA(0, 1), a2 + hstep, voffA);
            PG8_WAIT_L(8); PG8_BAR; PG8_WAIT_L(0); PG8_MMA(0, 0, At, B0); PG8_BAR; PG8_SCHED;
            PG8_LDB(B1, 1, 1); PG8_STAGE(PG8_SB(1, 0), b3, voffB);
            PG8_BAR; PG8_WAIT_L(0); PG8_MMA(0, 1, At, B1); PG8_BAR;
            PG8_LDA(At, 1, 1); PG8_STAGE(PG8_SA(1, 0), a3, voffA);
            PG8_BAR; PG8_WAIT_L(0); PG8_MMA(1, 0, At, B0); PG8_BAR; PG8_SCHED;
            PG8_STAGE(PG8_SB(1, 1), b3 + hstep, voffB);
            PG8_WAIT_V(6); PG8_BAR; PG8_MMA(1, 1, At, B1); PG8_BAR;
            }
        }
        if constexpr (ALIGN_EPI) { if (wr == 0) PG8_BAR; }
        if constexpr (!Epi::AFTER_DRAIN) { E(acc, cur, wr, wc, fr, fq); S.done(cur); }
        if (!has_next) break;
#pragma unroll
        for (int a = 0; a < 2; ++a)
#pragma unroll
            for (int b = 0; b < 2; ++b)
#pragma unroll
                for (int m = 0; m < 4; ++m)
#pragma unroll
                    for (int n = 0; n < 2; ++n) acc[a][b][m][n] = (f32x4){0.f, 0.f, 0.f, 0.f};
        cur = nxt; cA = nA; cB = nB; ++ui;
        if constexpr (ALIGN_EPI) { if (wr == 1) PG8_BAR; }
    }
    PG8_WAIT_V(0);
    if constexpr (!ALIGN_EPI) { if (wr == 0) PG8_BAR; }
    PG8_BAR;
    if constexpr (Epi::AFTER_DRAIN) { E.fused(acc, cur, wr, wc, fr, fq, lds, wid, lane); S.done(cur); }
#undef PG8_SA
#undef PG8_SB
#undef PG8_STAGE
#undef PG8_LDA
#undef PG8_LDB
#undef PG8_MMA
#undef PG8_WAIT_V
#undef PG8_WAIT_L
#undef PG8_BAR
#undef PG8_SCHED
}
}
#define GAS __attribute__((address_space(1)))
#define LAS __attribute__((address_space(3)))
typedef unsigned short bf16;
typedef unsigned v4u __attribute__((ext_vector_type(4)));
typedef float f32x4 __attribute__((ext_vector_type(4)));
typedef short bf16x8 __attribute__((ext_vector_type(8)));
typedef GAS unsigned gu32;
typedef GAS unsigned long long gu64;
#define RLX_AGENT __ATOMIC_RELAXED, __HIP_MEMORY_SCOPE_AGENT
#define LDS_WAIT() asm volatile("s_waitcnt lgkmcnt(0)" ::: "memory")
#define VM_WAIT() asm volatile("s_waitcnt vmcnt(0)" ::: "memory")
__device__ __forceinline__ unsigned long long rt() { return __builtin_amdgcn_s_memrealtime(); }
__device__ __forceinline__ unsigned f2bf(float f) { unsigned u = __builtin_bit_cast(unsigned, f); return (u + 0x7fffu + ((u >> 16) & 1u)) >> 16; }
__device__ __forceinline__ unsigned pk2(float lo, float hi) { return f2bf(lo) | (f2bf(hi) << 16); }

#define XB_TMO      128
#define XB_XCNT(j)  (256  + 64 * (j))
#define XB_XSUB(j)  (1280 + 64 * (j))
#define XB_XGEN(j)  (2304 + 64 * (j))
#define XB_TOP      3328
#define XB_TOPGEN   3392
#define XCD_BAR_WORDS 3456
#define XB_SPIN_CAP (1u << 18)

__device__ __forceinline__ unsigned xb_ld(unsigned* p)              { return __hip_atomic_load(p, __ATOMIC_RELAXED, __HIP_MEMORY_SCOPE_AGENT); }
__device__ __forceinline__ unsigned xb_add(unsigned* p, unsigned v) { return __hip_atomic_fetch_add(p, v, __ATOMIC_RELAXED, __HIP_MEMORY_SCOPE_AGENT); }
__device__ __forceinline__ unsigned xb_xcc_id() { return (unsigned)__builtin_amdgcn_s_getreg((3 << 11) | 20) & 0xFu; }
#define XB_SPIN(cond, bar) do { unsigned _sp = 0; while (cond) { __builtin_amdgcn_s_sleep(1); \
    if ((++_sp & 255u) == 0u) { if (xb_ld(&(bar)[XB_TMO])) break; if (_sp > XB_SPIN_CAP) { atomicAdd(&(bar)[XB_TMO], 1u); break; } } } } while (0)

struct XcdBarrier {
    unsigned* bar; unsigned x;
    volatile LAS unsigned* st;
};

__device__ __forceinline__ XcdBarrier xcd_barrier_post(unsigned* bar, volatile LAS unsigned* st) {
    XcdBarrier b; b.bar = bar; b.x = xb_xcc_id(); b.st = st;
    if (threadIdx.x == 0) (void)xb_add(&bar[XB_XCNT(b.x)], 1u);
    return b;
}
__device__ __forceinline__ void xcd_barrier_complete(unsigned* bar, unsigned x, unsigned& nloc, unsigned& nx) {
    const unsigned G = gridDim.x * gridDim.y * gridDim.z;
    unsigned sum, cnt, mine, sp = 0u;
    for (;;) {
        sum = 0u; cnt = 0u; mine = 0u;
#pragma unroll
        for (unsigned j = 0; j < 16; ++j) { const unsigned c = xb_ld(&bar[XB_XCNT(j)]); sum += c; cnt += (c > 0u) ? 1u : 0u; mine = (j == x) ? c : mine; }
        if (sum == G) break;
        __builtin_amdgcn_s_sleep(1);
        if ((++sp & 255u) == 0u) { if (xb_ld(&bar[XB_TMO])) break; if (sp > XB_SPIN_CAP) { atomicAdd(&bar[XB_TMO], 1u); break; } }
    }
    nloc = mine > 0u ? mine : 1u; nx = cnt > 0u ? cnt : 1u;
}

__device__ __forceinline__ void xcd_barrier(const XcdBarrier& b) {
    asm volatile("s_waitcnt vmcnt(0)" ::: "memory");
    __syncthreads();
    if (threadIdx.x == 0) {
        unsigned* bar = b.bar;
        __builtin_amdgcn_s_waitcnt(0);
        unsigned nloc = b.st[0], nx = b.st[1];
        if (nloc == 0u) { xcd_barrier_complete(bar, b.x, nloc, nx); b.st[0] = nloc; b.st[1] = nx; }
        const unsigned old = xb_add(&bar[XB_XSUB(b.x)], 1u);
        const unsigned gen = old / nloc;
        if (old + 1u == (gen + 1u) * nloc) {
            __builtin_amdgcn_fence(__ATOMIC_RELEASE, "agent");
            asm volatile("s_waitcnt vmcnt(0)" ::: "memory");
            const unsigned og = xb_add(&bar[XB_TOP], 1u);
            const unsigned tg = og / nx;
            if (og + 1u == (tg + 1u) * nx) xb_add(&bar[XB_TOPGEN], 1u);
            else XB_SPIN(xb_ld(&bar[XB_TOPGEN]) == tg, bar);
            __builtin_amdgcn_fence(__ATOMIC_ACQUIRE, "agent");
            xb_add(&bar[XB_XGEN(b.x)], 1u);
            asm volatile("s_waitcnt vmcnt(0)" ::: "memory");
        } else {
            XB_SPIN(xb_ld(&bar[XB_XGEN(b.x)]) == gen, bar);
            __builtin_amdgcn_fence(__ATOMIC_ACQUIRE, "agent");
            asm volatile("s_waitcnt vmcnt(0)" ::: "memory");
        }
    }
    __syncthreads();
}

constexpr int NB = 4, SEQ = 8192, DM = 1024, MTOK = NB * SEQ, DEPTH = 2;
constexpr int DIN = 2560, NH = 8, HD = 64, DLRU = 256, DCONF = 256, NE = 32, DE = 512;
constexpr int COL_Q = 0, COL_K = 512, COL_V = 1024, COL_XR = 1536, COL_XG = 1792, COL_XC = 2048;
constexpr int NRT = 36, NRTP = 48;
constexpr int MAXSLOT = 73728;
constexpr float EPSN = 1e-6f;
constexpr float LOG2E = 1.4426950408889634f;
constexpr float QSCALE = 0.125f * LOG2E;
constexpr float EXIT_THR2 = 120.0f * LOG2E;

constexpr size_t MiB = 1u << 20;
constexpr size_t WS_CTL = 0, CTL_ZERO_BYTES = 1 * MiB;
constexpr size_t WS_WIN = 1 * MiB;
constexpr size_t WS_WOUT = 6 * MiB;
constexpr size_t WS_W1 = 8 * MiB;
constexpr size_t WS_W2 = 72 * MiB;
constexpr size_t WS_PW = 104 * MiB;
constexpr size_t WS_LRUW = WS_PW + 128 * 1024;
constexpr size_t WS_WR = WS_PW + 256 * 1024;
constexpr size_t WS_RS1 = 105 * MiB;
constexpr size_t WS_RS2 = WS_RS1 + 128 * 1024;
constexpr size_t WS_TOKE = WS_RS2 + 128 * 1024;
constexpr size_t WS_TOKR = WS_TOKE + 256 * 1024;
constexpr size_t WS_TOKG = WS_TOKR + 256 * 1024;
constexpr size_t WS_RSS = WS_TOKG + 256 * 1024;
constexpr size_t WS_GTS = WS_RSS + 288 * 1024;
constexpr size_t WS_SUMM = 107 * MiB;
constexpr size_t WS_XBY = 109 * MiB;
constexpr size_t WS_PROJ = 173 * MiB;
constexpr size_t WS_HP = 333 * MiB;
constexpr size_t WS_END = 405 * MiB;
constexpr int CW_TMO = 0, CW_BAR = 4096, CW_CNT = 8192;

constexpr int SCR_BYTES = 143360;
constexpr int LDSCTL_OFF = SCR_BYTES;
constexpr int LDS_BYTES = 147456;
constexpr int NWAVES = 8, NTHR = 512;

typedef float f32x16 __attribute__((ext_vector_type(16)));
typedef short s16x4 __attribute__((ext_vector_type(4)));
typedef unsigned u32x2 __attribute__((ext_vector_type(2)));
typedef float f32x2 __attribute__((ext_vector_type(2)));
typedef __bf16 bf16x2_t __attribute__((ext_vector_type(2)));

__device__ __forceinline__ unsigned cvtpk(float lo, float hi) { f32x2 v = {lo, hi}; bf16x2_t b = __builtin_convertvector(v, bf16x2_t); return __builtin_bit_cast(unsigned, b); }
__device__ __forceinline__ float bflo(unsigned w) { return __uint_as_float(w << 16); }
__device__ __forceinline__ float bfhi(unsigned w) { return __uint_as_float(w & 0xffff0000u); }
__device__ __forceinline__ float fexp2(float x) { return __builtin_amdgcn_exp2f(x); }
__device__ __forceinline__ float flog2(float x) { return __builtin_amdgcn_logf(x); }
__device__ __forceinline__ float frcp(float x) { return __builtin_amdgcn_rcpf(x); }
__device__ __forceinline__ float sigmoidf_(float x) { return frcp(1.0f + fexp2(-LOG2E * x)); }
__device__ __forceinline__ float wave_sum(float v) {
#pragma unroll
    for (int o = 1; o < 64; o <<= 1) v += __shfl_xor(v, o);
    return v;
}
#define WG_SYNC() __syncthreads()
__device__ __forceinline__ int opq(int x) { asm volatile("" : "+v"(x)); return x; }

struct Frame {
    LAS unsigned char* lds;
    gu32* ctl;
    int tid, lane, wave, vcu, G;
    const float* const* in;
    float* out; unsigned char* ws;
};

__device__ __forceinline__ int dest_row(int n, int mode) {
    if (mode == 1) { const int t = n & ~255, c = n & 255; return t + 128 * ((c >> 5) & 1) + 32 * (c >> 6) + (c & 31); }
    if (mode == 2) return 8 * (n >> 2) + (n & 3);
    if (mode == 3) return 8 * (n >> 2) + 4 + (n & 3);
    return n;
}
__device__ __forceinline__ void transpose_item(const float* W, int ldn, int k0, int n0, const float* gain, bf16* WT, int ldk, int mode, LAS float* scr  , int lane) {
    float v[64]; const float* p = W + (size_t)k0 * ldn + n0 + lane;
#pragma unroll
    for (int i = 0; i < 64; ++i) { v[i] = *(const GAS float*)p; p += ldn; }
    if (gain) {
#pragma unroll
        for (int i = 0; i < 64; ++i) v[i] *= gain[k0 + i]; }
#pragma unroll
    for (int i = 0; i < 64; ++i) scr[i * 65 + lane] = v[i];
    LDS_WAIT(); asm volatile("" ::: "memory");
    const int c = lane & 7;
#pragma unroll
    for (int j = 0; j < 8; ++j) { const int n = (lane >> 3) + 8 * j; const LAS float* s = scr + (8 * c) * 65 + n;
        v4u o; o.x = cvtpk(s[0 * 65], s[1 * 65]); o.y = cvtpk(s[2 * 65], s[3 * 65]); o.z = cvtpk(s[4 * 65], s[5 * 65]); o.w = cvtpk(s[6 * 65], s[7 * 65]);
        *(GAS v4u*)(WT + (size_t)dest_row(n0 + n, mode) * ldk + k0 + 8 * c) = o; }
    LDS_WAIT(); asm volatile("" ::: "memory");
}
__device__ __forceinline__ void convert_weights(Frame& F, int l) {
    LAS float* scr = (LAS float*)(F.lds + F.wave * 16640);
    const int gw = F.vcu * NWAVES + F.wave, NGW = F.G * NWAVES;
    constexpr int I_IN = (DM / 64) * (DIN / 64), I_OUT = (DM / 64) * (DM / 64), I_GU = NE * (DM / 64) * (DE / 64), I_D = NE * (DE / 64) * (DM / 64);
    constexpr int I_PW = (DCONF / 64) * (DCONF / 64), I_LW = 8;
    constexpr int NITEMS = I_IN + I_OUT + 2 * I_GU + I_D + I_PW + I_LW;
    for (int it = gw; it < NITEMS; it += NGW) {
        int r = it;
        if (r < 2 * I_GU) { const int up = r >= I_GU; if (up) r -= I_GU; const int e = r / 128, q = r % 128, kb = q / 8, nb = q % 8; const float* src = F.in[up ? 24 : 23] + (size_t)l * NE * DM * DE + (size_t)e * DM * DE;
            transpose_item(src, DE, 64 * kb, 64 * nb, F.in[20] + l * DM, (bf16*)(F.ws + WS_W1) + (size_t)e * 1024 * 1024, DM, up ? 3 : 2, scr, F.lane); continue; } r -= 2 * I_GU;
        if (r < I_D) { const int e = r / 128, q = r % 128, kb = q / 16, nb = q % 16; transpose_item(F.in[25] + (size_t)l * NE * DE * DM + (size_t)e * DE * DM, DM, 64 * kb, 64 * nb, nullptr, (bf16*)(F.ws + WS_W2) + (size_t)e * 1024 * 512, DE, 0, scr, F.lane); continue; } r -= I_D;
        if (r < I_IN) { const int kb = r / (DIN / 64), nb = r % (DIN / 64); transpose_item(F.in[2] + (size_t)l * DM * DIN, DIN, 64 * kb, 64 * nb, F.in[1] + l * DM, (bf16*)(F.ws + WS_WIN), DM, 1, scr, F.lane); continue; } r -= I_IN;
        if (r < I_OUT) { const int kb = r / 16, nb = r % 16; transpose_item(F.in[19] + (size_t)l * DM * DM, DM, 64 * kb, 64 * nb, F.in[18] + l * DM, (bf16*)(F.ws + WS_WOUT), DM, 0, scr, F.lane); continue; } r -= I_OUT;
        if (r < I_PW) { const int kb = r / 4, nb = r % 4; transpose_item(F.in[16] + (size_t)l * DCONF * DCONF, DCONF, 64 * kb, 64 * nb, nullptr, (bf16*)(F.ws + WS_PW), DCONF, 0, scr, F.lane); continue; } r -= I_PW;
        { const int mat = r; const float* src = F.in[mat < 4 ? 7 : 9] + (size_t)l * 4 * 64 * 64 + (size_t)(mat & 3) * 64 * 64; transpose_item(src, 64, 0, 0, nullptr, (bf16*)(F.ws + WS_LRUW) + (size_t)mat * 64 * 64, 64, 0, scr, F.lane); }
    }
    const float* g2 = F.in[20] + l * DM; const float* rc = F.in[21] + (size_t)l * DM * 4; const float* rf = F.in[22] + (size_t)l * DM * NE; float* WR = (float*)(F.ws + WS_WR);
    for (int idx = (F.vcu * NTHR + F.tid); idx < NRTP * DM; idx += F.G * NTHR) { const int n = idx / DM, k = idx % DM;
        float v = 0.f; if (n < 4) v = rc[k * 4 + n] * g2[k]; else if (n < NRT) v = rf[k * NE + (n - 4)] * g2[k]; WR[idx] = v; }
    LDS_WAIT(); WG_SYNC();
}
__device__ __forceinline__ void x_to_bf16_rows(Frame& F, const float* x, bf16* XB, float* RS1) {
    const int gw = F.vcu * NWAVES + F.wave, NGW = F.G * NWAVES;
    for (int m = 2 * gw; m < MTOK; m += 2 * NGW) {
        f32x4 v[2][4]; float s[2] = {0.f, 0.f};
#pragma unroll
        for (int q = 0; q < 2; ++q) { const GAS f32x4* xr = (const GAS f32x4*)(x + (size_t)(m + q) * DM) + F.lane;
#pragma unroll
            for (int j = 0; j < 4; ++j) v[q][j] = xr[64 * j]; }
#pragma unroll
        for (int q = 0; q < 2; ++q) {
#pragma unroll
            for (int j = 0; j < 4; ++j) s[q] += (v[q][j].x * v[q][j].x + v[q][j].y * v[q][j].y) + (v[q][j].z * v[q][j].z + v[q][j].w * v[q][j].w);
            s[q] = wave_sum(s[q]);
            GAS u32x2* o8 = (GAS u32x2*)(XB + (size_t)(m + q) * DM) + F.lane;
#pragma unroll
            for (int j = 0; j < 4; ++j) { u32x2 w; w.x = cvtpk(v[q][j].x, v[q][j].y); w.y = cvtpk(v[q][j].z, v[q][j].w); o8[64 * j] = w; }
            if (F.lane == 0) RS1[m + q] = __builtin_amdgcn_rsqf(s[q] * (1.0f / DM) + EPSN); }
    }
}

namespace att {
constexpr int SLOTB = 8192, L_K = 0, L_V = 2 * SLOTB, L_OST = 4 * SLOTB, L_FLAG = L_OST + NWAVES * 4096;
__device__ __forceinline__ int crow(int r, int hi) { return (r & 3) + 8 * (r >> 2) + 4 * hi; }
typedef const LAS unsigned char* lptr;
__device__ __forceinline__ void unit(Frame& F, int b, int h, int qb, const bf16* PROJ, bf16* Y) {
    const int lane = (opq((int)threadIdx.x) & 63), r32 = lane & 31, hi = lane >> 5, wid = F.wave;
    LAS unsigned char* shm = F.lds;
    const long rowbase = (long)b * SEQ; const int q0 = qb * 256;
    const bf16* Qw = PROJ + (rowbase + q0 + wid * 32) * DIN + COL_Q + h * HD;
    const bf16* Kh = PROJ + rowbase * DIN + COL_K + h * HD; const bf16* Vh = PROJ + rowbase * DIN + COL_V + h * HD;
    bf16x8 qr[4];
#pragma unroll
    for (int d0 = 0; d0 < 4; ++d0) qr[d0] = *(const GAS bf16x8*)(Qw + (long)r32 * DIN + d0 * 16 + hi * 8);
    f32x16 o[2]; o[0] = f32x16{}; o[1] = f32x16{};
    float R = 0.f;
    const int first_tile = 4 * qb + (wid >> 1), T_top = 4 * qb + 3;
    const int qpos = q0 + wid * 32 + r32;
    bool wave_done = false;
    const bf16* ksrc = Kh + (long)lane * DIN + wid * 8;
    const bf16* vsrc = Vh + (long)(16 * (wid & 3) + (lane >> 2)) * DIN + (wid >> 2) * 32 + (lane & 3) * 8;
    LAS unsigned char* kdst = shm + L_K + wid * 1024 + lane * 16; LAS unsigned char* vdst = shm + L_V + wid * 1024 + lane * 16;
    const int vb0 = (int)(uintptr_t)(shm + L_V) + ((lane >> 4) & 1) * 32 + (lane & 3) * 8 + (4 * hi + ((lane & 15) >> 2)) * 64;
    volatile LAS int* flag = (volatile LAS int*)(shm + L_FLAG);
    v4u kreg = *(const GAS v4u*)(ksrc + (long)T_top * 64 * DIN), vreg = *(const GAS v4u*)(vsrc + (long)T_top * 64 * DIN);
    *(LAS v4u*)kdst = kreg; *(LAS v4u*)vdst = vreg;
    LDS_WAIT(); WG_SYNC();
    int s = 0;
    for (int t = T_top;; --t, s ^= 1) {
        if (t > 0) { kreg = *(const GAS v4u*)(ksrc + (long)(t - 1) * 64 * DIN); vreg = *(const GAS v4u*)(vsrc + (long)(t - 1) * 64 * DIN); }
        if (t <= first_tile && !wave_done) {
            f32x16 p0 = f32x16{}, p1 = f32x16{};
            { lptr kb = shm + L_K + s * SLOTB + hi * 1024 + r32 * 16;
#pragma unroll
              for (int d0 = 0; d0 < 4; ++d0) { const bf16x8 b0 = *(const LAS bf16x8*)(kb + d0 * 2048), b1 = *(const LAS bf16x8*)(kb + d0 * 2048 + 512);
                  p0 = __builtin_amdgcn_mfma_f32_32x32x16_bf16(b0, qr[d0], p0, 0, 0, 0); p1 = __builtin_amdgcn_mfma_f32_32x32x16_bf16(b1, qr[d0], p1, 0, 0, 0); } }
            const bool diag = (t == first_tile); const int kbase = t * 64 + 4 * hi;
            f32x16 L0, L1;
#pragma unroll
            for (int r = 0; r < 16; ++r) {
                const int kk = kbase + (r & 3) + 8 * (r >> 2);
                { const float x = p0[r]; const float e = fexp2(-__builtin_fabsf(x)); const float sp = __builtin_fmaxf(x, 0.f) + flog2(1.0f + e); float lk = -sp; if (diag && !(kk < qpos)) lk = 0.f; L0[r] = lk; p0[r] = x - sp; }
                { const float x = p1[r]; const float e = fexp2(-__builtin_fabsf(x)); const float sp = __builtin_fmaxf(x, 0.f) + flog2(1.0f + e); float lk = -sp; if (diag && !(kk + 32 < qpos)) lk = 0.f; L1[r] = lk; p1[r] = x - sp; }
            }
            float Ghi[2][4], T[2][4];
#pragma unroll
            for (int bq = 0; bq < 4; ++bq) {
                const float g0 = (L0[4 * bq] + L0[4 * bq + 1]) + (L0[4 * bq + 2] + L0[4 * bq + 3]), g1 = (L1[4 * bq] + L1[4 * bq + 1]) + (L1[4 * bq + 2] + L1[4 * bq + 3]);
                auto r0 = __builtin_amdgcn_permlane32_swap(__float_as_uint(g0), __float_as_uint(g0), false, false);
                auto r1 = __builtin_amdgcn_permlane32_swap(__float_as_uint(g1), __float_as_uint(g1), false, false);
                Ghi[0][bq] = __uint_as_float(r0[1]); T[0][bq] = __uint_as_float(r0[0]) + __uint_as_float(r0[1]);
                Ghi[1][bq] = __uint_as_float(r1[1]); T[1][bq] = __uint_as_float(r1[0]) + __uint_as_float(r1[1]);
            }
            const float hm = hi ? 0.f : 1.f;
            float cum = R;
#pragma unroll
            for (int a = 1; a >= 0; --a)
#pragma unroll
                for (int bq = 3; bq >= 0; --bq) {
                    const float E = cum + hm * Ghi[a][bq];
                    if (a == 1) { const float s3 = E, s2 = s3 + L1[4 * bq + 3], s1 = s2 + L1[4 * bq + 2], s0 = s1 + L1[4 * bq + 1];
                        p1[4 * bq + 3] = fexp2(p1[4 * bq + 3] + s3); p1[4 * bq + 2] = fexp2(p1[4 * bq + 2] + s2); p1[4 * bq + 1] = fexp2(p1[4 * bq + 1] + s1); p1[4 * bq] = fexp2(p1[4 * bq] + s0); }
                    else { const float s3 = E, s2 = s3 + L0[4 * bq + 3], s1 = s2 + L0[4 * bq + 2], s0 = s1 + L0[4 * bq + 1];
                        p0[4 * bq + 3] = fexp2(p0[4 * bq + 3] + s3); p0[4 * bq + 2] = fexp2(p0[4 * bq + 2] + s2); p0[4 * bq + 1] = fexp2(p0[4 * bq + 1] + s1); p0[4 * bq] = fexp2(p0[4 * bq] + s0); }
                    cum += T[a][bq];
                }
            R = cum;
            if (diag) {
#pragma unroll
                for (int r = 0; r < 16; ++r) { const int kk = kbase + (r & 3) + 8 * (r >> 2); if (!(kk < qpos)) p0[r] = 0.f; if (!(kk + 32 < qpos)) p1[r] = 0.f; }
            }
            v4u pw0, pw1, pw2, pw3;
            pw0.x = cvtpk(p0[0], p0[1]); pw0.y = cvtpk(p0[2], p0[3]); pw0.z = cvtpk(p0[4], p0[5]); pw0.w = cvtpk(p0[6], p0[7]);
            pw1.x = cvtpk(p0[8], p0[9]); pw1.y = cvtpk(p0[10], p0[11]); pw1.z = cvtpk(p0[12], p0[13]); pw1.w = cvtpk(p0[14], p0[15]);
            pw2.x = cvtpk(p1[0], p1[1]); pw2.y = cvtpk(p1[2], p1[3]); pw2.z = cvtpk(p1[4], p1[5]); pw2.w = cvtpk(p1[6], p1[7]);
            pw3.x = cvtpk(p1[8], p1[9]); pw3.y = cvtpk(p1[10], p1[11]); pw3.z = cvtpk(p1[12], p1[13]); pw3.w = cvtpk(p1[14], p1[15]);
            const int vb = vb0 + s * SLOTB;
#pragma unroll
            for (int d0 = 0; d0 < 2; ++d0) { s16x4 lo[4], hh[4];
#pragma unroll
                for (int ks = 0; ks < 4; ++ks) {
                    asm volatile("ds_read_b64_tr_b16 %0,%1 offset:%c2" : "=&v"(lo[ks]) : "v"(vb), "i"(d0 * 4096 + ks * 1024) : "memory");
                    asm volatile("ds_read_b64_tr_b16 %0,%1 offset:%c2" : "=&v"(hh[ks]) : "v"(vb), "i"(d0 * 4096 + ks * 1024 + 512) : "memory"); }
                asm volatile("s_waitcnt lgkmcnt(0)" ::: "memory"); __builtin_amdgcn_sched_barrier(0);
#define ATT_PK(k) (bf16x8){lo[k][0], lo[k][1], lo[k][2], lo[k][3], hh[k][0], hh[k][1], hh[k][2], hh[k][3]}
                o[d0] = __builtin_amdgcn_mfma_f32_32x32x16_bf16(__builtin_bit_cast(bf16x8, pw0), ATT_PK(0), o[d0], 0, 0, 0);
                o[d0] = __builtin_amdgcn_mfma_f32_32x32x16_bf16(__builtin_bit_cast(bf16x8, pw1), ATT_PK(1), o[d0], 0, 0, 0);
                o[d0] = __builtin_amdgcn_mfma_f32_32x32x16_bf16(__builtin_bit_cast(bf16x8, pw2), ATT_PK(2), o[d0], 0, 0, 0);
                o[d0] = __builtin_amdgcn_mfma_f32_32x32x16_bf16(__builtin_bit_cast(bf16x8, pw3), ATT_PK(3), o[d0], 0, 0, 0);
#undef ATT_PK
            }
            wave_done = __all(R < -EXIT_THR2);
        }
        if (lane == 0) flag[s * 8 + wid] = wave_done ? 1 : 0;
        if (t > 0) { *(LAS v4u*)(kdst + (s ^ 1) * SLOTB) = kreg; *(LAS v4u*)(vdst + (s ^ 1) * SLOTB) = vreg; }
        LDS_WAIT(); WG_SYNC();
        if (t == 0) break;
        int alld = 1;
#pragma unroll
        for (int w = 0; w < 8; ++w) alld &= flag[s * 8 + w];
        if (alld) break;
    }
    { LAS bf16* stg = (LAS bf16*)(shm + L_OST) + wid * 2048;
#pragma unroll
      for (int r = 0; r < 16; ++r) { const int orow = crow(r, hi);
#pragma unroll
          for (int d0 = 0; d0 < 2; ++d0) stg[orow * 64 + d0 * 32 + r32] = (bf16)(cvtpk(o[d0][r], 0.f) & 0xffffu); }
      LDS_WAIT(); asm volatile("" ::: "memory");
      bf16* Ow = Y + (rowbase + q0 + wid * 32) * DM + h * HD;
#pragma unroll
      for (int i = 0; i < 4; ++i) { const int row = i * 8 + (lane >> 3), ch = lane & 7; const v4u v = *(const LAS v4u*)(stg + row * 64 + ch * 8); *(GAS v4u*)(Ow + (long)row * DM + ch * 8) = v; } }
    LDS_WAIT(); WG_SYNC();
}
}

namespace conf {
constexpr int TM = 64, HALO = 30, UROWS = TM + HALO;
constexpr int L_U = 0  , L_Z = 49152  , L_S = 0  , ZS = 260, SS = 264;
__device__ __forceinline__ void unit(Frame& F, int ut, int l, const bf16* PROJ, bf16* Y) {
    const int tid = opq((int)threadIdx.x), lane = tid & 63, wid = F.wave;
    const int row0 = ut * TM; const int t0 = row0 % SEQ;
    LAS bf16* U = (LAS bf16*)(F.lds + L_U); LAS float* Z = (LAS float*)(F.lds + L_Z); LAS bf16* S = (LAS bf16*)(F.lds + L_S);
    const float* dw_w = F.in[12] + (size_t)l * 31 * DCONF; const float* dw_b = F.in[13] + l * DCONF; const float* ln_g = F.in[14] + l * DCONF; const float* ln_b = F.in[15] + l * DCONF;
    const float* pw_b = F.in[17] + l * DCONF; const bf16* PW = (const bf16*)(F.ws + WS_PW);
    for (int task = tid; task < UROWS * 32; task += NTHR) { const int ur = task >> 5, c8 = task & 31; const int t = t0 - HALO + ur; v4u o = {0u, 0u, 0u, 0u};
        if (t >= 0) { const bf16* pr = PROJ + (size_t)(row0 - HALO + ur) * DIN + COL_XC + c8 * 8; const v4u a = *(const GAS v4u*)pr, g = *(const GAS v4u*)(pr + 256);
            unsigned av[4] = {a.x, a.y, a.z, a.w}, gv[4] = {g.x, g.y, g.z, g.w}, ov[4];
#pragma unroll
            for (int j = 0; j < 4; ++j) ov[j] = cvtpk(bflo(av[j]) * sigmoidf_(bflo(gv[j])), bfhi(av[j]) * sigmoidf_(bfhi(gv[j])));
            o.x = ov[0]; o.y = ov[1]; o.z = ov[2]; o.w = ov[3]; }
        *(LAS v4u*)(U + ur * 256 + c8 * 8) = o; }
    LDS_WAIT(); WG_SYNC();
    { const int c = tid & 255, hf = tid >> 8; float w[31];
#pragma unroll
      for (int j = 0; j < 31; ++j) w[j] = dw_w[j * DCONF + c];
      const float bias = dw_b[c]; float acc[32];
#pragma unroll
      for (int i = 0; i < 32; ++i) acc[i] = bias;
      const LAS bf16* up = U + (hf * 32) * 256 + c;
#pragma unroll
      for (int rho = 0; rho < 62; ++rho) { const float x = __uint_as_float((unsigned)up[rho * 256] << 16);
#pragma unroll
          for (int i = 0; i < 32; ++i) { const int j = rho - i; if (j >= 0 && j <= 30) acc[i] += w[j] * x; } }
#pragma unroll
      for (int i = 0; i < 32; ++i) Z[(hf * 32 + i) * ZS + c] = acc[i]; }
    LDS_WAIT(); WG_SYNC();
    { const f32x4 g = *(const GAS f32x4*)(ln_g + 4 * lane), bb = *(const GAS f32x4*)(ln_b + 4 * lane);
      for (int i = 0; i < 8; ++i) { const int tk = wid * 8 + i; f32x4 v = *(const LAS f32x4*)(Z + tk * ZS + 4 * lane);
          const float mean = wave_sum((v.x + v.y) + (v.z + v.w)) * (1.0f / 256.0f); v = v - mean;
          const float var = wave_sum((v.x * v.x + v.y * v.y) + (v.z * v.z + v.w * v.w)) * (1.0f / 256.0f); const float rstd = __builtin_amdgcn_rsqf(var + EPSN);
          f32x4 y = v * rstd * g + bb; y.x *= sigmoidf_(y.x); y.y *= sigmoidf_(y.y); y.z *= sigmoidf_(y.z); y.w *= sigmoidf_(y.w);
          u32x2 w2; w2.x = cvtpk(y.x, y.y); w2.y = cvtpk(y.z, y.w); *(LAS u32x2*)(S + tk * SS + 4 * lane) = w2; } }
    LDS_WAIT(); WG_SYNC();
    { const int fr = lane & 15, fq = lane >> 4; f32x4 acc[4][2];
#pragma unroll
      for (int m = 0; m < 4; ++m) { acc[m][0] = (f32x4){0.f, 0.f, 0.f, 0.f}; acc[m][1] = (f32x4){0.f, 0.f, 0.f, 0.f}; }
#pragma unroll 2
      for (int ks = 0; ks < 8; ++ks) { bf16x8 bfr[2], afr[4];
#pragma unroll
          for (int n = 0; n < 2; ++n) bfr[n] = *(const GAS bf16x8*)(PW + (size_t)(32 * wid + 16 * n + fr) * DCONF + 32 * ks + 8 * fq);
#pragma unroll
          for (int m = 0; m < 4; ++m) afr[m] = *(const LAS bf16x8*)(S + (16 * m + fr) * SS + 32 * ks + 8 * fq);
#pragma unroll
          for (int m = 0; m < 4; ++m)
#pragma unroll
              for (int n = 0; n < 2; ++n) acc[m][n] = __builtin_amdgcn_mfma_f32_16x16x32_bf16(afr[m], bfr[n], acc[m][n], 0, 0, 0); }
#pragma unroll
      for (int m = 0; m < 4; ++m)
#pragma unroll
          for (int n = 0; n < 2; ++n)
#pragma unroll
              for (int i = 0; i < 4; ++i) Z[(16 * m + 4 * fq + i) * ZS + 32 * wid + 16 * n + fr] = acc[m][n][i]; }
    LDS_WAIT(); WG_SYNC();
    { const f32x4 pb = *(const GAS f32x4*)(pw_b + 4 * lane);
      for (int i = 0; i < 8; ++i) { const int tk = wid * 8 + i; f32x4 v = *(const LAS f32x4*)(Z + tk * ZS + 4 * lane) + pb;
          const float ss = wave_sum((v.x * v.x + v.y * v.y) + (v.z * v.z + v.w * v.w)); const float rs = __builtin_amdgcn_rsqf(ss * (1.0f / 256.0f) + EPSN); v = v * rs;
          u32x2 w2; w2.x = cvtpk(v.x, v.y); w2.y = cvtpk(v.z, v.w); *(GAS u32x2*)(Y + (size_t)(row0 + tk) * DM + 768 + 4 * lane) = w2; } }
    LDS_WAIT(); WG_SYNC();
}
}

namespace lru {
constexpr int TM = 64, XS_ = 260, XBS = 264;
constexpr int L_XC = 0  , L_A = 66560  , L_XB = 66560  ;
__device__ __forceinline__ void unit(Frame& F, int ut, int l, const bf16* PROJ, float* HL, float* PL, float* SUMM) {
    const int tid = opq((int)threadIdx.x), lane = tid & 63, wid = F.wave;
    const int row0 = ut * TM; const int t0 = row0 % SEQ;
    LAS float* XC = (LAS float*)(F.lds + L_XC); LAS float* A = (LAS float*)(F.lds + L_A); LAS bf16* XB = (LAS bf16*)(F.lds + L_XB);
    const float* cw = F.in[5] + (size_t)l * 4 * DLRU; const float* cb = F.in[6] + l * DLRU; const float* ba = F.in[8] + l * DLRU; const float* bx = F.in[10] + l * DLRU; const float* lam = F.in[11] + l * DLRU;
    const bf16* LW = (const bf16*)(F.ws + WS_LRUW);
    for (int task = tid; task < TM * 32; task += NTHR) { const int tk = task >> 5, c8 = task & 31; float acc[8];
        { const f32x4 b0 = *(const GAS f32x4*)(cb + c8 * 8), b1 = *(const GAS f32x4*)(cb + c8 * 8 + 4); acc[0] = b0.x; acc[1] = b0.y; acc[2] = b0.z; acc[3] = b0.w; acc[4] = b1.x; acc[5] = b1.y; acc[6] = b1.z; acc[7] = b1.w; }
#pragma unroll
        for (int j = 0; j < 4; ++j) { const int t = t0 + tk - 3 + j; if (t >= 0) { const v4u a = *(const GAS v4u*)(PROJ + (size_t)(row0 + tk - 3 + j) * DIN + COL_XR + c8 * 8);
                const f32x4 w0 = *(const GAS f32x4*)(cw + j * DLRU + c8 * 8), w1 = *(const GAS f32x4*)(cw + j * DLRU + c8 * 8 + 4);
                acc[0] += w0.x * bflo(a.x); acc[1] += w0.y * bfhi(a.x); acc[2] += w0.z * bflo(a.y); acc[3] += w0.w * bfhi(a.y);
                acc[4] += w1.x * bflo(a.z); acc[5] += w1.y * bfhi(a.z); acc[6] += w1.z * bflo(a.w); acc[7] += w1.w * bfhi(a.w); } }
        *(LAS f32x4*)(XC + tk * XS_ + c8 * 8) = (f32x4){acc[0], acc[1], acc[2], acc[3]}; *(LAS f32x4*)(XC + tk * XS_ + c8 * 8 + 4) = (f32x4){acc[4], acc[5], acc[6], acc[7]};
        v4u o; o.x = cvtpk(acc[0], acc[1]); o.y = cvtpk(acc[2], acc[3]); o.z = cvtpk(acc[4], acc[5]); o.w = cvtpk(acc[6], acc[7]); *(LAS v4u*)(XB + tk * XBS + c8 * 8) = o; }
    LDS_WAIT(); WG_SYNC();
    const int nb = wid >> 1, mh = wid & 1, fr = lane & 15, fq = lane >> 4;
    f32x4 ar[2][4], ai[2][4];
#pragma unroll
    for (int m = 0; m < 2; ++m)
#pragma unroll
        for (int n = 0; n < 4; ++n) { ar[m][n] = (f32x4){0.f, 0.f, 0.f, 0.f}; ai[m][n] = (f32x4){0.f, 0.f, 0.f, 0.f}; }
#pragma unroll
    for (int ks = 0; ks < 2; ++ks) { bf16x8 af[2];
#pragma unroll
        for (int m = 0; m < 2; ++m) af[m] = *(const LAS bf16x8*)(XB + (32 * mh + 16 * m + fr) * XBS + 64 * nb + 32 * ks + 8 * fq);
#pragma unroll
        for (int n = 0; n < 4; ++n) { const bf16x8 bA = *(const GAS bf16x8*)(LW + (size_t)nb * 4096 + (16 * n + fr) * 64 + 32 * ks + 8 * fq), bX = *(const GAS bf16x8*)(LW + (size_t)(4 + nb) * 4096 + (16 * n + fr) * 64 + 32 * ks + 8 * fq);
#pragma unroll
            for (int m = 0; m < 2; ++m) { ar[m][n] = __builtin_amdgcn_mfma_f32_16x16x32_bf16(af[m], bA, ar[m][n], 0, 0, 0); ai[m][n] = __builtin_amdgcn_mfma_f32_16x16x32_bf16(af[m], bX, ai[m][n], 0, 0, 0); } } }
    LDS_WAIT(); WG_SYNC();
#pragma unroll
    for (int n = 0; n < 4; ++n) { const int ch = 64 * nb + 16 * n + fr; const float lsl8 = -8.0f * log1pf(__expf(-lam[ch])), bav = ba[ch], bxv = bx[ch];
#pragma unroll
        for (int m = 0; m < 2; ++m)
#pragma unroll
            for (int i = 0; i < 4; ++i) { const int tk = 32 * mh + 16 * m + 4 * fq + i; const float gr = ar[m][n][i] + bav, gi = ai[m][n][i] + bxv; const float xcv = XC[tk * XS_ + ch];
                const float la = lsl8 * sigmoidf_(gr); const float a = fexp2(LOG2E * la); const float mult = __builtin_sqrtf(__builtin_fmaxf(1.0f - a * a, 0.f));
                A[tk * XS_ + ch] = a; XC[tk * XS_ + ch] = mult * sigmoidf_(gi) * xcv; } }
    LDS_WAIT(); WG_SYNC();
    if (tid < 256) { const int c = tid; float h = 0.f, p = 1.f; float* hl = HL + (size_t)row0 * DLRU + c; float* pl = PL + (size_t)row0 * DLRU + c;
#pragma unroll 8
        for (int tk = 0; tk < TM; ++tk) { const float a = A[tk * XS_ + c], u = XC[tk * XS_ + c]; p *= a; h = a * h + u; hl[(size_t)tk * DLRU] = h; pl[(size_t)tk * DLRU] = p; }
        SUMM[(size_t)ut * 512 + c] = p; SUMM[(size_t)ut * 512 + 256 + c] = h; }
    LDS_WAIT(); WG_SYNC();
}
}

__device__ __forceinline__ void fixup_unit(Frame& F, int ut, const bf16* PROJ, const float* HL, const float* PL, const float* SUMM, bf16* Y) {
    const int tid = opq((int)threadIdx.x), lane = tid & 63, wid = F.wave; const int row0 = ut * 64; const int cb = (row0 % SEQ) / 64, ub0 = ut - cb;
    LAS float* CAR = (LAS float*)F.lds;
    if (tid < 256) { float car = 0.f;
#pragma unroll 8
        for (int j = 0; j < cb; ++j) { const float p = SUMM[(size_t)(ub0 + j) * 512 + tid], h = SUMM[(size_t)(ub0 + j) * 512 + 256 + tid]; car = p * car + h; }
        CAR[tid] = car; }
    LDS_WAIT(); WG_SYNC();
    const f32x4 car = *(const LAS f32x4*)(CAR + 4 * lane);
#pragma unroll 4
    for (int i = 0; i < 8; ++i) { const size_t row = (size_t)row0 + wid * 8 + i;
        const f32x4 hl = *(const GAS f32x4*)(HL + row * DLRU + 4 * lane), pl = *(const GAS f32x4*)(PL + row * DLRU + 4 * lane);
        const u32x2 xg = *(const GAS u32x2*)(PROJ + row * DIN + COL_XG + 4 * lane); const v4u ya = *(const GAS v4u*)(Y + row * DM + 8 * lane);
        f32x4 h = hl + pl * car; const float xv[4] = {bflo(xg.x), bfhi(xg.x), bflo(xg.y), bfhi(xg.y)}; float y[4];
#pragma unroll
        for (int j = 0; j < 4; ++j) { const float x = xv[j]; const float u2 = 1.5957691216057308f * (x + 0.044715f * x * x * x); y[j] = h[j] * x * sigmoidf_(u2); }
        const float ssb = wave_sum((y[0] * y[0] + y[1] * y[1]) + (y[2] * y[2] + y[3] * y[3])); const float rsb = __builtin_amdgcn_rsqf(ssb * (1.0f / 256.0f) + EPSN);
        u32x2 w2; w2.x = cvtpk(y[0] * rsb, y[1] * rsb); w2.y = cvtpk(y[2] * rsb, y[3] * rsb); *(GAS u32x2*)(Y + row * DM + 512 + 4 * lane) = w2;
        float a[8] = {bflo(ya.x), bfhi(ya.x), bflo(ya.y), bfhi(ya.y), bflo(ya.z), bfhi(ya.z), bflo(ya.w), bfhi(ya.w)}; float ssa = 0.f;
#pragma unroll
        for (int j = 0; j < 8; ++j) ssa += a[j] * a[j];
        ssa = wave_sum(ssa); const float rsa = __builtin_amdgcn_rsqf(ssa * (1.0f / 512.0f) + EPSN);
        v4u oa; oa.x = cvtpk(a[0] * rsa, a[1] * rsa); oa.y = cvtpk(a[2] * rsa, a[3] * rsa); oa.z = cvtpk(a[4] * rsa, a[5] * rsa); oa.w = cvtpk(a[6] * rsa, a[7] * rsa);
        *(GAS v4u*)(Y + row * DM + 8 * lane) = oa; }
    LDS_WAIT(); WG_SYNC();
}

__device__ __forceinline__ void router_unit(Frame& F, int ut, int l, const float* X, float* RS2, int* TOKE, int* TOKR, float* TOKG) {
    const int tid = opq((int)threadIdx.x), lane = tid & 63, wid = F.wave, fr = lane & 15, fq = lane >> 4;
    const float* WR = (const float*)(F.ws + WS_WR);
    LAS float* LG = (LAS float*)F.lds + wid * (16 * NRTP + 16);
    LAS int* CNT = (LAS int*)(F.lds + 32768); LAS int* BASE = CNT + 32;
    if (tid < 32) CNT[tid] = 0;
    const int r0 = ut * 128 + wid * 16;
    f32x4 acc[3]; acc[0] = (f32x4){0.f, 0.f, 0.f, 0.f}; acc[1] = acc[0]; acc[2] = acc[0]; float ss = 0.f;
    const float* xp = X + (size_t)(r0 + fr) * DM + 4 * fq; const float* wp = WR + (size_t)fr * DM + 4 * fq;
#pragma unroll 4
    for (int s = 0; s < DM / 16; ++s) { const f32x4 a = *(const GAS f32x4*)(xp + 16 * s); ss += (a.x * a.x + a.y * a.y) + (a.z * a.z + a.w * a.w);
#pragma unroll
        for (int n = 0; n < 3; ++n) { const f32x4 b = *(const GAS f32x4*)(wp + (size_t)16 * n * DM + 16 * s);
            acc[n] = __builtin_amdgcn_mfma_f32_16x16x4f32(a.x, b.x, acc[n], 0, 0, 0); acc[n] = __builtin_amdgcn_mfma_f32_16x16x4f32(a.y, b.y, acc[n], 0, 0, 0);
            acc[n] = __builtin_amdgcn_mfma_f32_16x16x4f32(a.z, b.z, acc[n], 0, 0, 0); acc[n] = __builtin_amdgcn_mfma_f32_16x16x4f32(a.w, b.w, acc[n], 0, 0, 0); } }
    ss += __shfl_xor(ss, 16); ss += __shfl_xor(ss, 32);
    const float rs = __builtin_amdgcn_rsqf(ss * (1.0f / DM) + EPSN);
    if (fq == 0) LG[16 * NRTP + fr] = rs;
#pragma unroll
    for (int n = 0; n < 3; ++n)
#pragma unroll
        for (int i = 0; i < 4; ++i) LG[(4 * fq + i) * NRTP + 16 * n + fr] = acc[n][i];
    LDS_WAIT(); WG_SYNC();
    int e0 = 0, e1 = 0, lr0 = 0, lr1 = 0; float g0 = 0.f, g1 = 0.f, rsv = 0.f;
    if (lane < 16) { const LAS float* lg = LG + lane * NRTP; rsv = LG[16 * NRTP + lane];
        float c[4]; int grp = 0; float cm;
#pragma unroll
        for (int j = 0; j < 4; ++j) c[j] = lg[j] * rsv;
        cm = c[0];
#pragma unroll
        for (int j = 1; j < 4; ++j) if (c[j] > cm) { cm = c[j]; grp = j; }
        float den = 0.f;
#pragma unroll
        for (int j = 0; j < 4; ++j) den += __expf(c[j] - cm);
        const float wgrp = 1.0f / den;
        float v0 = -INFINITY, v1 = -INFINITY; int i0 = 0, i1 = 0;
#pragma unroll
        for (int j = 0; j < 8; ++j) { const float v = lg[4 + grp * 8 + j] * rsv; if (v > v0) { v1 = v0; i1 = i0; v0 = v; i0 = j; } else if (v > v1) { v1 = v; i1 = j; } }
        const float ex = __expf(v1 - v0); g0 = wgrp / (1.0f + ex); g1 = wgrp * ex / (1.0f + ex);
        e0 = grp * 8 + i0; e1 = grp * 8 + i1;
        lr0 = atomicAdd((int*)(CNT + e0), 1); lr1 = atomicAdd((int*)(CNT + e1), 1); }
    LDS_WAIT(); WG_SYNC();
    if (tid < 32) { const int c = CNT[tid]; int bse = 0; if (c > 0) bse = (int)__hip_atomic_fetch_add((unsigned*)(F.ctl + CW_CNT + 64 * l + tid), (unsigned)c, __ATOMIC_RELAXED, __HIP_MEMORY_SCOPE_AGENT); BASE[tid] = bse; }
    LDS_WAIT(); WG_SYNC();
    if (lane < 16) { const int tok = r0 + lane; RS2[tok] = rsv; TOKE[2 * tok] = e0; TOKE[2 * tok + 1] = e1; TOKR[2 * tok] = BASE[e0] + lr0; TOKR[2 * tok + 1] = BASE[e1] + lr1; TOKG[2 * tok] = g0; TOKG[2 * tok + 1] = g1; }
    LDS_WAIT(); WG_SYNC();
}
__device__ __forceinline__ int moe_tables(Frame& F, int l, LAS int* PST, LAS int* TE) {
    if (F.tid == 0) { int acc = 0; for (int e = 0; e < NE; ++e) { const int c = (int)__hip_atomic_load(F.ctl + CW_CNT + 64 * l + e, __ATOMIC_RELAXED, __HIP_MEMORY_SCOPE_AGENT); PST[e] = acc; acc += (c + 255) & ~255; } PST[NE] = acc; }
    LDS_WAIT(); WG_SYNC();
    const int ntile = PST[NE] >> 8;
    for (int rt = F.tid; rt < ntile; rt += NTHR) { int e = 0;
        for (int j = 1; j < NE; ++j) if ((PST[j] >> 8) <= rt) e = j;
        TE[rt] = e; }
    LDS_WAIT(); WG_SYNC();
    return ntile;
}
__device__ __forceinline__ void gather_phase(Frame& F, int l, const float* X, const float* RS2, const int* TOKE, const int* TOKR, const float* TOKG, bf16* XS, float* RSS, float* GTS) {
    LAS int* PST = (LAS int*)F.lds; LAS int* TE = PST + 64;
    (void)moe_tables(F, l, PST, TE);
    const int gw = F.vcu * NWAVES + F.wave, NGW = F.G * NWAVES;
    for (int m = 2 * gw; m < MTOK; m += 2 * NGW) {
        f32x4 v[2][4]; int slot[2][2]; float rs[2], gt[2][2];
#pragma unroll
        for (int q = 0; q < 2; ++q) { const GAS f32x4* xr = (const GAS f32x4*)(X + (size_t)(m + q) * DM) + F.lane;
#pragma unroll
            for (int j = 0; j < 4; ++j) v[q][j] = xr[64 * j];
            rs[q] = RS2[m + q];
#pragma unroll
            for (int k = 0; k < 2; ++k) { slot[q][k] = PST[TOKE[2 * (m + q) + k]] + TOKR[2 * (m + q) + k]; gt[q][k] = TOKG[2 * (m + q) + k]; } }
#pragma unroll
        for (int q = 0; q < 2; ++q) { u32x2 w[4];
#pragma unroll
            for (int j = 0; j < 4; ++j) { w[j].x = cvtpk(v[q][j].x, v[q][j].y); w[j].y = cvtpk(v[q][j].z, v[q][j].w); }
#pragma unroll
            for (int k = 0; k < 2; ++k) { GAS u32x2* o8 = (GAS u32x2*)(XS + (size_t)slot[q][k] * DM) + F.lane;
#pragma unroll
                for (int j = 0; j < 4; ++j) o8[64 * j] = w[j];
                if (F.lane == 0) { RSS[slot[q][k]] = rs[q]; GTS[slot[q][k]] = gt[q][k]; } } }
    }
    for (int e = gw; e < NE; e += NGW) { const int c = (int)__hip_atomic_load(F.ctl + CW_CNT + 64 * l + e, __ATOMIC_RELAXED, __HIP_MEMORY_SCOPE_AGENT);
        for (int slot = PST[e] + c; slot < PST[e + 1]; ++slot) { GAS u32x2* o8 = (GAS u32x2*)(XS + (size_t)slot * DM) + F.lane;
#pragma unroll
            for (int j = 0; j < 4; ++j) o8[64 * j] = (u32x2){0u, 0u};
            if (F.lane == 0) { RSS[slot] = 0.f; GTS[slot] = 0.f; } } }
    LDS_WAIT(); WG_SYNC();
}
__device__ __forceinline__ void combine_phase(Frame& F, int l, float* X, const int* TOKE, const int* TOKR, const bf16* OB, bool next_layer, bf16* XB, float* RS1) {
    LAS int* PST = (LAS int*)F.lds; LAS int* TE = PST + 64;
    (void)moe_tables(F, l, PST, TE);
    const int gw = F.vcu * NWAVES + F.wave, NGW = F.G * NWAVES;
    for (int m = 2 * gw; m < MTOK; m += 2 * NGW) {
        f32x4 v[2][4]; u32x2 oa[2][4], ob[2][4];
#pragma unroll
        for (int q = 0; q < 2; ++q) { const int mm = m + q; const int s0 = PST[TOKE[2 * mm]] + TOKR[2 * mm], s1 = PST[TOKE[2 * mm + 1]] + TOKR[2 * mm + 1];
            const GAS f32x4* xr = (const GAS f32x4*)(X + (size_t)mm * DM) + F.lane;
            const GAS u32x2* o0 = (const GAS u32x2*)(OB + (size_t)s0 * DM) + F.lane; const GAS u32x2* o1 = (const GAS u32x2*)(OB + (size_t)s1 * DM) + F.lane;
#pragma unroll
            for (int j = 0; j < 4; ++j) { v[q][j] = xr[64 * j]; oa[q][j] = o0[64 * j]; ob[q][j] = o1[64 * j]; } }
#pragma unroll
        for (int q = 0; q < 2; ++q) { const int mm = m + q; float ss = 0.f; GAS f32x4* xw = (GAS f32x4*)(X + (size_t)mm * DM) + F.lane;
#pragma unroll
            for (int j = 0; j < 4; ++j) { const u32x2 a = oa[q][j], b = ob[q][j]; f32x4& x = v[q][j];
                x.x += bflo(a.x) + bflo(b.x); x.y += bfhi(a.x) + bfhi(b.x); x.z += bflo(a.y) + bflo(b.y); x.w += bfhi(a.y) + bfhi(b.y);
                ss += (x.x * x.x + x.y * x.y) + (x.z * x.z + x.w * x.w); xw[64 * j] = x; }
            if (next_layer) { ss = wave_sum(ss); GAS u32x2* o8 = (GAS u32x2*)(XB + (size_t)mm * DM) + F.lane;
#pragma unroll
                for (int j = 0; j < 4; ++j) { u32x2 w; w.x = cvtpk(v[q][j].x, v[q][j].y); w.y = cvtpk(v[q][j].z, v[q][j].w); o8[64 * j] = w; }
                if (F.lane == 0) RS1[mm] = __builtin_amdgcn_rsqf(ss * (1.0f / DM) + EPSN); } }
    }
    LDS_WAIT(); WG_SYNC();
}

constexpr int PH_PER_LAYER = 9, N_PHASES = 1 + DEPTH * PH_PER_LAYER;
struct Args { const float* in[26]; float* out; unsigned char* ws; int ph_lo, ph_hi; };
__global__ void __launch_bounds__(NTHR, 2) mk_fwd(Args args) {
    extern __shared__ __attribute__((aligned(16))) unsigned char lds[];
    Frame F;
    F.lds = (LAS unsigned char*)lds;
    F.tid = threadIdx.x; F.lane = F.tid & 63; F.wave = __builtin_amdgcn_readfirstlane(F.tid >> 6);
    F.G = gridDim.x; { const int bx = blockIdx.x; F.vcu = (F.G % 8 == 0) ? (bx % 8) * (F.G / 8) + bx / 8 : bx; }
    F.in = args.in;
    F.out = args.out; F.ws = args.ws; F.ctl = (gu32*)(args.ws + WS_CTL);
    for (int u = F.tid; u < (LDS_BYTES - LDSCTL_OFF) / 4; u += NTHR) ((LAS unsigned*)(F.lds + LDSCTL_OFF))[u] = 0u;
    __syncthreads();
    const bool one_launch = (args.ph_hi - args.ph_lo) > 1;
    XcdBarrier bar; bar.bar = (unsigned*)(F.ctl + CW_BAR); bar.x = 0; bar.st = nullptr;
    if (one_launch) bar = xcd_barrier_post((unsigned*)(F.ctl + CW_BAR), (volatile LAS unsigned*)(F.lds + LDSCTL_OFF + 32));
    const int lo = args.ph_lo, hi = args.ph_hi;
#ifndef PH_MASK
#define PH_MASK 0x1fff
#endif
#define IN(k) (lo <= (k) && (k) < hi)
#define EN(j) (((PH_MASK) >> (j)) & 1)
#ifndef DBL_MASK
#define DBL_MASK 0
#endif
#define NREP(j) ((((DBL_MASK) >> (j)) & 1) ? 2 : 1)
#define PHASE_BEGIN() do { F.tid = opq((int)threadIdx.x); F.lane = F.tid & 63; F.wave = __builtin_amdgcn_readfirstlane(F.tid >> 6); { int v_ = F.vcu; asm volatile("" : "+s"(v_)); F.vcu = v_; } } while (0)
#define SEAM(k) do { if (IN(k) && IN((k) + 1)) xcd_barrier(bar); } while (0)
#define XBY ((bf16*)(F.ws + WS_XBY))
#define PROJ ((bf16*)(F.ws + WS_PROJ))
#define XSOB ((bf16*)(F.ws + WS_PROJ))
#define HB ((bf16*)(F.ws + WS_HP))
#define HL ((float*)(F.ws + WS_HP))
#define PL ((float*)(F.ws + WS_HP) + (size_t)MTOK * DLRU)
#define SUMM ((float*)(F.ws + WS_SUMM))
#define RS1 ((float*)(F.ws + WS_RS1))
#define RS2 ((float*)(F.ws + WS_RS2))
#define TOKE ((int*)(F.ws + WS_TOKE))
#define TOKR ((int*)(F.ws + WS_TOKR))
#define TOKG ((float*)(F.ws + WS_TOKG))
#define RSS ((float*)(F.ws + WS_RSS))
#define GTS ((float*)(F.ws + WS_GTS))

    if (EN(0) && IN(0)) { PHASE_BEGIN(); for (int rep = 0; rep < NREP(0); ++rep) { convert_weights(F, 0); x_to_bf16_rows(F, F.in[0], XBY, RS1); } }
    SEAM(0);
#pragma unroll 1
    for (int l = 0; l < DEPTH; ++l) {
        const int pb = 1 + l * PH_PER_LAYER;
        const float* xin = (l == 0) ? F.in[0] : F.out;
        if (EN(1) && IN(pb + 0)) { PHASE_BEGIN(); pg8::Gemm g{XBY, (const bf16*)(F.ws + WS_WIN), MTOK, DIN, DM}; pg8::StaticOrder S; S.init(MTOK, DIN, F.G, (int)blockIdx.x);
            pg8::EpiProj E{PROJ, RS1, F.in[3] + l * HD, F.in[4] + l * HD, DIN, QSCALE};
            for (int rep = 0; rep < NREP(1); ++rep) pg8::gemm_phase<pg8::EpiProj, pg8::StaticOrder, true, true>(F.lds, g, S, E); }
        SEAM(pb + 0);
        if (EN(2) && IN(pb + 1)) { PHASE_BEGIN();
            if (EN(10)) for (int rep = 0; rep < NREP(2); ++rep) for (int a = F.vcu; a < NB * NH * (SEQ / 256); a += F.G) { const int qb = a & 31, bh = a >> 5; att::unit(F, bh >> 3, bh & 7, qb, PROJ, XBY); }
            if (EN(11)) for (int rep = 0; rep < NREP(3); ++rep) for (int u = F.vcu; u < MTOK / 64; u += F.G) conf::unit(F, u, l, PROJ, XBY);
            if (EN(12)) for (int rep = 0; rep < NREP(4); ++rep) for (int u = F.vcu; u < MTOK / 64; u += F.G) lru::unit(F, u, l, PROJ, HL, PL, SUMM);
        }
        SEAM(pb + 1);
        if (EN(3) && IN(pb + 2)) { PHASE_BEGIN(); for (int rep = 0; rep < NREP(5); ++rep) for (int u = F.vcu; u < MTOK / 64; u += F.G) fixup_unit(F, u, PROJ, HL, PL, SUMM, XBY); }
        SEAM(pb + 2);
        if (EN(4) && IN(pb + 3)) { PHASE_BEGIN(); pg8::Gemm g{XBY, (const bf16*)(F.ws + WS_WOUT), MTOK, DM, DM}; pg8::StaticOrder S; S.init(MTOK, DM, F.G, (int)blockIdx.x);
            pg8::EpiResid E{xin, F.out, DM};
            for (int rep = 0; rep < ((l == 0) ? NREP(6) : 1); ++rep) pg8::gemm_phase<pg8::EpiResid, pg8::StaticOrder, true, true>(F.lds, g, S, E); }
        SEAM(pb + 3);
        if (EN(5) && IN(pb + 4)) { PHASE_BEGIN(); for (int u = F.vcu; u < MTOK / 128; u += F.G) router_unit(F, u, l, F.out, RS2, TOKE, TOKR, TOKG); }
        SEAM(pb + 4);
        if (EN(6) && IN(pb + 5)) { PHASE_BEGIN(); for (int rep = 0; rep < NREP(7); ++rep) gather_phase(F, l, F.out, RS2, TOKE, TOKR, TOKG, XSOB, RSS, GTS); }
        SEAM(pb + 5);
        if (EN(7) && IN(pb + 6)) { PHASE_BEGIN(); LAS int* PST = (LAS int*)(F.lds + SCR_BYTES - 2048); LAS int* TE = PST + 64; const int ntile = moe_tables(F, l, PST, TE);
            pg8::Gemm g{XSOB, (const bf16*)(F.ws + WS_W1), MAXSLOT, NE * 1024, DM}; pg8::MoeOrder S{ntile * 4, F.G, F.vcu, (const PG8_LAS int*)TE};
            pg8::EpiSwiglu E{HB, RSS, DE};
            for (int rep = 0; rep < NREP(8); ++rep) pg8::gemm_phase<pg8::EpiSwiglu, pg8::MoeOrder, true, true>(F.lds, g, S, E); }
        SEAM(pb + 6);
        if (EN(8) && IN(pb + 7)) { PHASE_BEGIN(); LAS int* PST = (LAS int*)(F.lds + SCR_BYTES - 2048); LAS int* TE = PST + 64; const int ntile = moe_tables(F, l, PST, TE);
            pg8::Gemm g{HB, (const bf16*)(F.ws + WS_W2), MAXSLOT, NE * 1024, DE}; pg8::MoeOrder S{ntile * 4, F.G, F.vcu, (const PG8_LAS int*)TE};
            pg8::EpiGate E{XSOB, GTS, DM};
            for (int rep = 0; rep < NREP(9); ++rep) pg8::gemm_phase<pg8::EpiGate, pg8::MoeOrder, true, true>(F.lds, g, S, E); }
        SEAM(pb + 7);
        if (EN(9) && IN(pb + 8)) { PHASE_BEGIN(); combine_phase(F, l, F.out, TOKE, TOKR, XSOB, l + 1 < DEPTH, XBY, RS1); if (l + 1 < DEPTH) convert_weights(F, l + 1); }
        if (l + 1 < DEPTH) SEAM(pb + 8);
    }
#undef IN
#undef SEAM
}

extern "C" void kernel_launch(void* const* d_in, const int* in_sizes, int n_in, void* d_out, int out_size, void* d_ws, size_t ws_size, hipStream_t stream) {
    static int grid = 0;
    if (grid == 0) {
        if (n_in != 26 || in_sizes[0] != MTOK * DM || out_size != MTOK * DM || ws_size < WS_END) { fprintf(stderr, "kernel_launch: unexpected shapes (n_in %d, in0 %d, out %d, ws %zu < %zu); nothing launched\n", n_in, n_in > 0 ? in_sizes[0] : -1, out_size, ws_size, (size_t)WS_END); grid = -1; return; }
        int dev = 0, cus = 0, per_cu = 0;
        if (hipGetDevice(&dev) != hipSuccess || hipDeviceGetAttribute(&cus, hipDeviceAttributeMultiprocessorCount, dev) != hipSuccess) { grid = -1; return; }
        if (hipFuncSetAttribute((const void*)mk_fwd, hipFuncAttributeMaxDynamicSharedMemorySize, LDS_BYTES) != hipSuccess) { fprintf(stderr, "kernel_launch: hipFuncSetAttribute failed\n"); grid = -1; return; }
        if (hipOccupancyMaxActiveBlocksPerMultiprocessor(&per_cu, (const void*)mk_fwd, NTHR, LDS_BYTES) != hipSuccess || per_cu < 1) { fprintf(stderr, "kernel_launch: occupancy query reports %d blocks per CU; nothing launched\n", per_cu); (void)hipGetLastError(); grid = -1; return; }
        grid = cus;
    }
    if (grid < 0) return;
    if (hipMemsetAsync((char*)d_ws + WS_CTL, 0, CTL_ZERO_BYTES, stream) != hipSuccess) { fprintf(stderr, "kernel_launch: memset failed\n"); return; }
    Args a{};
    for (int i = 0; i < 26; ++i) a.in[i] = (const float*)d_in[i];
    a.out = (float*)d_out; a.ws = (unsigned char*)d_ws;
#if defined(MK_PER_PHASE) && MK_PER_PHASE
    for (int p = 0; p < N_PHASES; ++p) { a.ph_lo = p; a.ph_hi = p + 1; hipLaunchKernelGGL(mk_fwd, dim3(grid), dim3(NTHR), LDS_BYTES, stream, a); }
#else
    a.ph_lo = 0; a.ph_hi = N_PHASES; hipLaunchKernelGGL(mk_fwd, dim3(grid), dim3(NTHR), LDS_BYTES, stream, a);
#endif
    const hipError_t le = hipPeekAtLastError();
    if (le != hipSuccess) fprintf(stderr, "kernel_launch: launch failed: %s\n", hipGetErrorName(le));
}
```

```cpp
#include <hip/hip_runtime.h>
#include <cstdio>
#include <cstdint>
namespace pg8 {
#define PG8_LAS __attribute__((address_space(3)))
typedef unsigned short bf16_t;
typedef short bf16x8 __attribute__((ext_vector_type(8)));
typedef float f32x4 __attribute__((ext_vector_type(4)));
typedef unsigned u32x4 __attribute__((ext_vector_type(4)));
constexpr int BM = 256, BK = 64, HALF = 128, HTB = HALF * BK * 2  , STAGE_BYTES = 8 * HTB, NXCD = 8, WGM = 8;

__host__ __device__ __forceinline__ int lds_byte(int r, int c) { const int st = (r >> 4) * 2 + (c >> 5), rr = r & 15, cc = c & 31, ob = rr * 64 + cc * 2; return st * 1024 + (ob ^ (((ob >> 9) & 1) << 5)); }
__host__ __device__ __forceinline__ void stage_rc(int b, int& R, int& C) { const int st = b / 1024, sb = b % 1024, swz = sb ^ (((sb >> 9) & 1) << 5); R = (st >> 1) * 16 + swz / 64; C = (st & 1) * 32 + (swz % 64) / 2; }
__host__ __device__ __forceinline__ int perm32(int rho) { const int n = rho >> 4, i = rho & 15; return 8 * (i >> 2) + 4 * n + (i & 3); }

struct Unit { int pm, pn; };
struct Gemm { const bf16_t* A; const bf16_t* Bt; int M, N, K; };

struct StaticOrder {
    int nM, nN, nwg, G, c;
    __host__ __device__ void init(int M, int N, int G_, int c_) { nM = M / BM; nN = N / BM; nwg = nM * nN; G = G_; c = c_; }
    __host__ __device__ bool next(int i, Unit& u) const {
        const long L = (long)i * G + c; if (L >= nwg) return false;
        int wgid = (int)L; { const int q = nwg / NXCD, r = nwg % NXCD, xcd = wgid % NXCD, off = wgid / NXCD; wgid = (xcd < r ? xcd * (q + 1) : r * (q + 1) + (xcd - r) * q) + off; }
        const int nig = WGM * nN, gid = wgid / nig, fm = gid * WGM, gsz = (nM - fm) < WGM ? (nM - fm) : WGM;
        u.pm = fm + ((wgid % nig) % gsz); u.pn = (wgid % nig) / gsz; return true;
    }
    __device__ __forceinline__ void a_ready(const Unit&) const {}
    __device__ __forceinline__ void done(const Unit&) const {}
};
__device__ __forceinline__ unsigned cvt_pk_bf16(float lo, float hi) { unsigned r; asm volatile("v_cvt_pk_bf16_f32 %0, %1, %2" : "=v"(r) : "v"(lo), "v"(hi)); return r; }
typedef float f32x2 __attribute__((ext_vector_type(2)));
typedef float f32x2 __attribute__((ext_vector_type(2)));
typedef unsigned u32x2 __attribute__((ext_vector_type(2)));
struct EpiProj {
    static constexpr bool PERM = true, AFTER_DRAIN = false;
    bf16_t* P; const float* rs; const float* gq; const float* gk; int ldp; float qscale;
    __device__ __forceinline__ void operator()(const f32x4 (&acc)[2][2][4][2], const Unit& u, int wr, int wc, int fr, int fq) const {
        const int pn = u.pn; const bool headnorm = pn < 4;
        f32x4 g[2][2];
        if (headnorm) { const float* gp = (pn < 2) ? gq : gk; const float s = (pn < 2) ? qscale : 1.0f;
#pragma unroll
            for (int bj = 0; bj < 2; ++bj)
#pragma unroll
                for (int n = 0; n < 2; ++n) g[bj][n] = *(const f32x4*)(gp + 32 * bj + 8 * fq + 4 * n) * s; }
#pragma unroll
        for (int ai = 0; ai < 2; ++ai)
#pragma unroll
            for (int m = 0; m < 4; ++m) {
                asm volatile("" ::: "memory");
                const int row = u.pm * BM + ai * HALF + wr * 64 + m * 16 + fr; const float r = rs[row];
                f32x4 v[2][2];
#pragma unroll
                for (int bj = 0; bj < 2; ++bj)
#pragma unroll
                    for (int n = 0; n < 2; ++n) v[bj][n] = acc[ai][bj][m][n] * r;
                if (headnorm) { float ss = 0.f;
#pragma unroll
                    for (int bj = 0; bj < 2; ++bj)
#pragma unroll
                        for (int n = 0; n < 2; ++n) { const f32x4 x = v[bj][n]; ss += (x[0] * x[0] + x[1] * x[1]) + (x[2] * x[2] + x[3] * x[3]); }
                    ss += __shfl_xor(ss, 16); ss += __shfl_xor(ss, 32);
                    const float sc = __builtin_amdgcn_rsqf(ss * (1.0f / 64.0f) + 1e-6f);
#pragma unroll
                    for (int bj = 0; bj < 2; ++bj)
#pragma unroll
                        for (int n = 0; n < 2; ++n) v[bj][n] = v[bj][n] * g[bj][n] * sc; }
                bf16_t* rowp = P + (size_t)row * ldp + pn * BM + 64 * wc + 8 * fq;
#pragma unroll
                for (int bj = 0; bj < 2; ++bj) { u32x4 w; w.x = cvt_pk_bf16(v[bj][0][0], v[bj][0][1]); w.y = cvt_pk_bf16(v[bj][0][2], v[bj][0][3]); w.z = cvt_pk_bf16(v[bj][1][0], v[bj][1][1]); w.w = cvt_pk_bf16(v[bj][1][2], v[bj][1][3]);
                    *(u32x4*)(rowp + 32 * bj) = w; }
            }
    }
};
struct EpiResid {
    static constexpr bool PERM = false, AFTER_DRAIN = false;
    const float* base; float* out; int ldc;
    __device__ __forceinline__ void operator()(const f32x4 (&acc)[2][2][4][2], const Unit& u, int wr, int wc, int fr, int fq) const {
        const int col0 = u.pn * BM + wc * 32 + 4 * fq;
#pragma unroll
        for (int ai = 0; ai < 2; ++ai)
#pragma unroll
            for (int m = 0; m < 4; ++m) { const size_t off = (size_t)(u.pm * BM + ai * HALF + wr * 64 + m * 16 + fr) * ldc + col0;
                f32x4 b[2][2];
#pragma unroll
                for (int bj = 0; bj < 2; ++bj)
#pragma unroll
                    for (int n = 0; n < 2; ++n) b[bj][n] = *(const f32x4*)(base + off + bj * HALF + n * 16);
#pragma unroll
                for (int bj = 0; bj < 2; ++bj)
#pragma unroll
                    for (int n = 0; n < 2; ++n) *(f32x4*)(out + off + bj * HALF + n * 16) = b[bj][n] + acc[ai][bj][m][n];
                if (m & 1) asm volatile("" ::: "memory"); }
    }
};
struct EpiSwiglu {
    static constexpr bool PERM = true, AFTER_DRAIN = false;
    bf16_t* H; const float* rs; int ldh;
    __device__ __forceinline__ void operator()(const f32x4 (&acc)[2][2][4][2], const Unit& u, int wr, int wc, int fr, int fq) const {
        const int col0 = (u.pn & 3) * 128 + 16 * wc + 4 * fq;
#pragma unroll
        for (int ai = 0; ai < 2; ++ai)
#pragma unroll
            for (int m = 0; m < 4; ++m) { const int row = u.pm * BM + ai * HALF + wr * 64 + m * 16 + fr; const float r = rs[row];
#pragma unroll
                for (int bj = 0; bj < 2; ++bj) { const f32x4 g = acc[ai][bj][m][0] * r, up = acc[ai][bj][m][1] * r; float h[4];
#pragma unroll
                    for (int i = 0; i < 4; ++i) h[i] = g[i] * __builtin_amdgcn_rcpf(1.0f + __builtin_amdgcn_exp2f(-1.4426950408889634f * g[i])) * up[i];
                    u32x2 w; w.x = cvt_pk_bf16(h[0], h[1]); w.y = cvt_pk_bf16(h[2], h[3]);
                    *(u32x2*)(H + (size_t)row * ldh + col0 + 64 * bj) = w; } }
    }
};
struct EpiGate {
    static constexpr bool PERM = true, AFTER_DRAIN = false;
    bf16_t* O; const float* gate; int ldo;
    __device__ __forceinline__ void operator()(const f32x4 (&acc)[2][2][4][2], const Unit& u, int wr, int wc, int fr, int fq) const {
        const int col0 = (u.pn & 3) * BM + wc * 32 + 8 * fq;
#pragma unroll
        for (int ai = 0; ai < 2; ++ai)
#pragma unroll
            for (int m = 0; m < 4; ++m) { const int row = u.pm * BM + ai * HALF + wr * 64 + m * 16 + fr; const float gt = gate[row];
#pragma unroll
                for (int bj = 0; bj < 2; ++bj) { const f32x4 v0 = acc[ai][bj][m][0] * gt, v1 = acc[ai][bj][m][1] * gt;
                    u32x4 w; w.x = cvt_pk_bf16(v0[0], v0[1]); w.y = cvt_pk_bf16(v0[2], v0[3]); w.z = cvt_pk_bf16(v1[0], v1[1]); w.w = cvt_pk_bf16(v1[2], v1[3]);
                    *(u32x4*)(O + (size_t)row * ldo + col0 + bj * HALF) = w; } }
    }
};
struct MoeOrder {
    int nunits, G, c; const PG8_LAS int* tile_e;
    __device__ __forceinline__ bool next(int i, Unit& u) const { const int L = i * G + c; if (L >= nunits) return false; const int rt = L >> 2; u.pm = rt; u.pn = tile_e[rt] * 4 + (L & 3); return true; }
    __device__ __forceinline__ void a_ready(const Unit&) const {}
    __device__ __forceinline__ void done(const Unit&) const {}
};
template <class Epi, class Sched, bool ALIGN_EPI = false, bool SP2 = false>
__device__ __forceinline__ void gemm_phase(PG8_LAS unsigned char* lds, const Gemm g, const Sched& S, const Epi& E) {
    int tid_ = threadIdx.x; asm volatile("" : "+v"(tid_));
    const int tid = tid_, wid = __builtin_amdgcn_readfirstlane(tid >> 6), lane = tid & 63, wr = wid >> 2, wc = wid & 3, fr = lane & 15, fq = lane >> 4;
    const int K = g.K, nt = K / BK;
    unsigned voffA[2], voffB[2];
#pragma unroll
    for (int i = 0; i < 2; ++i) { int R, C; stage_rc(tid * 16 + i * 8192, R, C); const int Rb = Epi::PERM ? ((R & ~31) + perm32(R & 31)) : R;
        voffA[i] = (unsigned)(R * K + C) * 2u; voffB[i] = (unsigned)(Rb * K + C) * 2u; }
    const size_t kstep = (size_t)(BK * 2);
    const size_t hstep = (size_t)HALF * K * 2;
    const size_t tstep = 2 * hstep;
    const unsigned ldsw = (unsigned)wid * 1024u;
    const int aoff = lds_byte(wr * 64 + fr, fq * 8), boff = lds_byte(wc * 32 + fr, fq * 8);
#define PG8_SA(b, h) (((b) * 2 + (h)) * HTB)
#define PG8_SB(b, h) ((4 + (b) * 2 + (h)) * HTB)
#define PG8_STAGE(bufoff, gbase, voff) do { _Pragma("unroll") for (int _i = 0; _i < 2; ++_i) \
        __builtin_amdgcn_global_load_lds((const unsigned*)((const char*)(gbase) + (voff)[_i]), (PG8_LAS unsigned*)(lds + (bufoff) + ldsw + _i * 8192), 16, 0, 0); } while (0)
#define PG8_LDA(dst, b, h) do { _Pragma("unroll") for (int m = 0; m < 4; ++m) _Pragma("unroll") for (int k = 0; k < 2; ++k) dst[m][k] = *(const PG8_LAS bf16x8*)(lds + PG8_SA(b, h) + aoff + m * 2048 + k * 1024); } while (0)
#define PG8_LDB(dst, b, h) do { _Pragma("unroll") for (int n = 0; n < 2; ++n) _Pragma("unroll") for (int k = 0; k < 2; ++k) dst[n][k] = *(const PG8_LAS bf16x8*)(lds + PG8_SB(b, h) + boff + n * 2048 + k * 1024); } while (0)
#define PG8_MMA(ai, bj, At, Bt) do { __builtin_amdgcn_s_setprio(1); _Pragma("unroll") for (int m = 0; m < 4; ++m) _Pragma("unroll") for (int n = 0; n < 2; ++n) _Pragma("unroll") for (int k = 0; k < 2; ++k) \
        acc[ai][bj][m][n] = __builtin_amdgcn_mfma_f32_16x16x32_bf16(Bt[n][k], At[m][k], acc[ai][bj][m][n], 0, 0, 0); __builtin_amdgcn_s_setprio(0); } while (0)
#define PG8_WAIT_V(n) asm volatile("s_waitcnt vmcnt(" #n ")" ::: "memory")
#define PG8_WAIT_L(n) asm volatile("s_waitcnt lgkmcnt(" #n ")" ::: "memory")
#define PG8_BAR __builtin_amdgcn_s_barrier()
#define PG8_SCHED __builtin_amdgcn_sched_barrier(0)
    Unit cur, nxt; int ui = 0;
    if (!S.next(0, cur)) return;
    f32x4 acc[2][2][4][2];
#pragma unroll
    for (int a = 0; a < 2; ++a)
#pragma unroll
        for (int b = 0; b < 2; ++b)
#pragma unroll
            for (int m = 0; m < 4; ++m)
#pragma unroll
                for (int n = 0; n < 2; ++n) acc[a][b][m][n] = (f32x4){0.f, 0.f, 0.f, 0.f};
    bf16x8 At[4][2], B0[2][2], B1[2][2];
    const char* cA = (const char*)g.A + (size_t)cur.pm * tstep; const char* cB = (const char*)g.Bt + (size_t)cur.pn * tstep;
    S.a_ready(cur);
    if constexpr (SP2) {
        PG8_STAGE(PG8_SB(0, 0), cB, voffB); PG8_STAGE(PG8_SB(0, 1), cB + hstep, voffB); PG8_STAGE(PG8_SA(0, 0), cA, voffA); PG8_STAGE(PG8_SA(0, 1), cA + hstep, voffA);
        if (wr == 1) PG8_BAR;
        PG8_WAIT_V(2); PG8_BAR;
        PG8_STAGE(PG8_SB(1, 0), cB + kstep, voffB); PG8_STAGE(PG8_SA(1, 0), cA + kstep, voffA); PG8_STAGE(PG8_SB(1, 1), cB + hstep + kstep, voffB);
        PG8_WAIT_V(6); PG8_BAR;
    } else {
        PG8_STAGE(PG8_SB(0, 0), cB, voffB); PG8_STAGE(PG8_SA(0, 0), cA, voffA); PG8_STAGE(PG8_SB(0, 1), cB + hstep, voffB); PG8_STAGE(PG8_SA(0, 1), cA + hstep, voffA);
        if (wr == 1) PG8_BAR;
        PG8_WAIT_V(4); PG8_BAR;
        PG8_STAGE(PG8_SB(1, 0), cB + kstep, voffB); PG8_STAGE(PG8_SA(1, 0), cA + kstep, voffA); PG8_STAGE(PG8_SB(1, 1), cB + hstep + kstep, voffB);
        PG8_WAIT_V(6); PG8_BAR;
    }
    for (;;) {
        const bool has_next = S.next(ui + 1, nxt);
        const char* nA = has_next ? (const char*)g.A + (size_t)nxt.pm * tstep : cA; const char* nB = has_next ? (const char*)g.Bt + (size_t)nxt.pn * tstep : cB;
        for (int t = 0; t < nt; t += 2) {
            const bool last = (t == nt - 2);
            const char* a1 = cA + (size_t)(t + 1) * kstep;
            const char* a2 = last ? nA : cA + (size_t)(t + 2) * kstep; const char* b2 = last ? nB : cB + (size_t)(t + 2) * kstep;
            const char* a3 = a2 + kstep; const char* b3 = b2 + kstep;
            if (last && has_next) S.a_ready(nxt);
            if constexpr (SP2) {
            PG8_LDB(B0, 0, 0); PG8_LDB(B1, 0, 1); PG8_SCHED; PG8_LDA(At, 0, 0); PG8_STAGE(PG8_SA(1, 1), a1 + hstep, voffA);
            PG8_WAIT_V(8); PG8_WAIT_L(0); PG8_BAR; PG8_MMA(0, 0, At, B0); PG8_MMA(0, 1, At, B1); PG8_BAR; PG8_SCHED;
            PG8_LDA(At, 0, 1); PG8_STAGE(PG8_SB(0, 0), b2, voffB); PG8_STAGE(PG8_SB(0, 1), b2 + hstep, voffB); PG8_STAGE(PG8_SA(0, 0), a2, voffA);
            PG8_WAIT_V(8); PG8_WAIT_L(0); PG8_BAR; PG8_MMA(1, 0, At, B0); PG8_MMA(1, 1, At, B1); PG8_BAR; PG8_SCHED;
            PG8_LDB(B0, 1, 0); PG8_LDB(B1, 1, 1); PG8_SCHED; PG8_LDA(At, 1, 0); PG8_STAGE(PG8_SA(0, 1), a2 + hstep, voffA);
            PG8_WAIT_V(8); PG8_WAIT_L(0); PG8_BAR; PG8_MMA(0, 0, At, B0); PG8_MMA(0, 1, At, B1); PG8_BAR; PG8_SCHED;
            PG8_LDA(At, 1, 1); PG8_STAGE(PG8_SB(1, 0), b3, voffB); PG8_STAGE(PG8_SB(1, 1), b3 + hstep, voffB); PG8_STAGE(PG8_SA(1, 0), a3, voffA);
            PG8_WAIT_V(8); PG8_WAIT_L(0); PG8_BAR; PG8_MMA(1, 0, At, B0); PG8_MMA(1, 1, At, B1); PG8_BAR; PG8_SCHED;
            } else {
            PG8_LDB(B0, 0, 0); PG8_SCHED; PG8_LDA(At, 0, 0); PG8_STAGE(PG8_SA(1, 1), a1 + hstep, voffA);
            PG8_WAIT_L(8); PG8_BAR; PG8_WAIT_L(0); PG8_MMA(0, 0, At, B0); PG8_BAR; PG8_SCHED;
            PG8_LDB(B1, 0, 1); PG8_STAGE(PG8_SB(0, 0), b2, voffB);
            PG8_BAR; PG8_WAIT_L(0); PG8_MMA(0, 1, At, B1); PG8_BAR;
            PG8_LDA(At, 0, 1); PG8_STAGE(PG8_SA(0, 0), a2, voffA);
            PG8_BAR; PG8_WAIT_L(0); PG8_MMA(1, 0, At, B0); PG8_BAR; PG8_SCHED;
            PG8_STAGE(PG8_SB(0, 1), b2 + hstep, voffB);
            PG8_WAIT_V(6); PG8_BAR; PG8_MMA(1, 1, At, B1); PG8_BAR;
            PG8_LDB(B0, 1, 0); PG8_SCHED; PG8_LDA(At, 1, 0); PG8_STAGE(PG8_SA(0, 1), a2 + hstep, voffA);
            PG8_WAIT_L(8); PG8_BAR; PG8_WAIT_L(0); PG8_MMA(0, 0, At, B0); PG8_BAR; PG8_SCHED;
            PG8_LDB(B1, 1, 1); PG8_STAGE(PG8_SB(1, 0), b3, voffB);
            PG8_BAR; PG8_WAIT_L(0); PG8_MMA(0, 1, At, B1); PG8_BAR;
            PG8_LDA(At, 1, 1); PG8_STAGE(PG8_SA(1, 0), a3, voffA);
            PG8_BAR; PG8_WAIT_L(0); PG8_MMA(1, 0, At, B0); PG8_BAR; PG8_SCHED;
            PG8_STAGE(PG8_SB(1, 1), b3 + hstep, voffB);
            PG8_WAIT_V(6); PG8_BAR; PG8_MMA(1, 1, At, B1); PG8_BAR;
            }
        }
        if constexpr (ALIGN_EPI) { if (wr == 0) PG8_BAR; }
        if constexpr (!Epi::AFTER_DRAIN) { E(acc, cur, wr, wc, fr, fq); S.done(cur); }
        if (!has_next) break;
#pragma unroll
        for (int a = 0; a < 2; ++a)
#pragma unroll
            for (int b = 0; b < 2; ++b)
#pragma unroll
                for (int m = 0; m < 4; ++m)
#pragma unroll
                    for (int n = 0; n < 2; ++n) acc[a][b][m][n] = (f32x4){0.f, 0.f, 0.f, 0.f};
        cur = nxt; cA = nA; cB = nB; ++ui;
        if constexpr (ALIGN_EPI) { if (wr == 1) PG8_BAR; }
    }
    PG8_WAIT_V(0);
    if constexpr (!ALIGN_EPI) { if (wr == 0) PG8_BAR; }
    PG8_BAR;
    if constexpr (Epi::AFTER_DRAIN) { E.fused(acc, cur, wr, wc, fr, fq, lds, wid, lane); S.done(cur); }
#undef PG8_SA
#undef PG8_SB
#undef PG8_STAGE
#undef PG8_LDA
#undef PG8_LDB
#undef PG8_MMA
#undef PG8_WAIT_V
#undef PG8_WAIT_L
#undef PG8_BAR
#undef PG8_SCHED
}
}
#define GAS __attribute__((address_space(1)))
#define LAS __attribute__((address_space(3)))
typedef unsigned short bf16;
typedef unsigned v4u __attribute__((ext_vector_type(4)));
typedef float f32x4 __attribute__((ext_vector_type(4)));
typedef short bf16x8 __attribute__((ext_vector_type(8)));
typedef GAS unsigned gu32;
typedef GAS unsigned long long gu64;
#define RLX_AGENT __ATOMIC_RELAXED, __HIP_MEMORY_SCOPE_AGENT
#define LDS_WAIT() asm volatile("s_waitcnt lgkmcnt(0)" ::: "memory")
#define VM_WAIT() asm volatile("s_waitcnt vmcnt(0)" ::: "memory")
__device__ __forceinline__ unsigned long long rt() { return __builtin_amdgcn_s_memrealtime(); }
__device__ __forceinline__ unsigned f2bf(float f) { unsigned u = __builtin_bit_cast(unsigned, f); return (u + 0x7fffu + ((u >> 16) & 1u)) >> 16; }
__device__ __forceinline__ unsigned pk2(float lo, float hi) { return f2bf(lo) | (f2bf(hi) << 16); }

#define XB_TMO      128
#define XB_XCNT(j)  (256  + 64 * (j))
#define XB_XSUB(j)  (1280 + 64 * (j))
#define XB_XGEN(j)  (2304 + 64 * (j))
#define XB_TOP      3328
#define XB_TOPGEN   3392
#define XCD_BAR_WORDS 3456
#define XB_SPIN_CAP (1u << 18)

__device__ __forceinline__ unsigned xb_ld(unsigned* p)              { return __hip_atomic_load(p, __ATOMIC_RELAXED, __HIP_MEMORY_SCOPE_AGENT); }
__device__ __forceinline__ unsigned xb_add(unsigned* p, unsigned v) { return __hip_atomic_fetch_add(p, v, __ATOMIC_RELAXED, __HIP_MEMORY_SCOPE_AGENT); }
__device__ __forceinline__ unsigned xb_xcc_id() { return (unsigned)__builtin_amdgcn_s_getreg((3 << 11) | 20) & 0xFu; }
#define XB_SPIN(cond, bar) do { unsigned _sp = 0; while (cond) { __builtin_amdgcn_s_sleep(1); \
    if ((++_sp & 255u) == 0u) { if (xb_ld(&(bar)[XB_TMO])) break; if (_sp > XB_SPIN_CAP) { atomicAdd(&(bar)[XB_TMO], 1u); break; } } } } while (0)

struct XcdBarrier {
    unsigned* bar; unsigned x;
    volatile LAS unsigned* st;
};

__device__ __forceinline__ XcdBarrier xcd_barrier_post(unsigned* bar, volatile LAS unsigned* st) {
    XcdBarrier b; b.bar = bar; b.x = xb_xcc_id(); b.st = st;
    if (threadIdx.x == 0) (void)xb_add(&bar[XB_XCNT(b.x)], 1u);
    return b;
}
__device__ __forceinline__ void xcd_barrier_complete(unsigned* bar, unsigned x, unsigned& nloc, unsigned& nx) {
    const unsigned G = gridDim.x * gridDim.y * gridDim.z;
    unsigned sum, cnt, mine, sp = 0u;
    for (;;) {
        sum = 0u; cnt = 0u; mine = 0u;
#pragma unroll
        for (unsigned j = 0; j < 16; ++j) { const unsigned c = xb_ld(&bar[XB_XCNT(j)]); sum += c; cnt += (c > 0u) ? 1u : 0u; mine = (j == x) ? c : mine; }
        if (sum == G) break;
        __builtin_amdgcn_s_sleep(1);
        if ((++sp & 255u) == 0u) { if (xb_ld(&bar[XB_TMO])) break; if (sp > XB_SPIN_CAP) { atomicAdd(&bar[XB_TMO], 1u); break; } }
    }
    nloc = mine > 0u ? mine : 1u; nx = cnt > 0u ? cnt : 1u;
}

__device__ __forceinline__ void xcd_barrier(const XcdBarrier& b) {
    asm volatile("s_waitcnt vmcnt(0)" ::: "memory");
    __syncthreads();
    if (threadIdx.x == 0) {
        unsigned* bar = b.bar;
        __builtin_amdgcn_s_waitcnt(0);
        unsigned nloc = b.st[0], nx = b.st[1];
        if (nloc == 0u) { xcd_barrier_complete(bar, b.x, nloc, nx); b.st[0] = nloc; b.st[1] = nx; }
        const unsigned old = xb_add(&bar[XB_XSUB(b.x)], 1u);
        const unsigned gen = old / nloc;
        if (old + 1u == (gen + 1u) * nloc) {
            __builtin_amdgcn_fence(__ATOMIC_RELEASE, "agent");
            asm volatile("s_waitcnt vmcnt(0)" ::: "memory");
            const unsigned og = xb_add(&bar[XB_TOP], 1u);
            const unsigned tg = og / nx;
            if (og + 1u == (tg + 1u) * nx) xb_add(&bar[XB_TOPGEN], 1u);
            else XB_SPIN(xb_ld(&bar[XB_TOPGEN]) == tg, bar);
            __builtin_amdgcn_fence(__ATOMIC_ACQUIRE, "agent");
            xb_add(&bar[XB_XGEN(b.x)], 1u);
            asm volatile("s_waitcnt vmcnt(0)" ::: "memory");
        } else {
            XB_SPIN(xb_ld(&bar[XB_XGEN(b.x)]) == gen, bar);
            __builtin_amdgcn_fence(__ATOMIC_ACQUIRE, "agent");
            asm volatile("s_waitcnt vmcnt(0)" ::: "memory");
        }
    }
    __syncthreads();
}

constexpr int NB = 4, SEQ = 8192, DM = 1024, MTOK = NB * SEQ, DEPTH = 2;
constexpr int DIN = 2560, NH = 8, HD = 64, DLRU = 256, DCONF = 256, NE = 32, DE = 512;
constexpr int COL_Q = 0, COL_K = 512, COL_V = 1024, COL_XR = 1536, COL_XG = 1792, COL_XC = 2048;
constexpr int NRT = 36, NRTP = 48;
constexpr int MAXSLOT = 73728;
constexpr float EPSN = 1e-6f;
constexpr float LOG2E = 1.4426950408889634f;
constexpr float QSCALE = 0.125f * LOG2E;
constexpr float EXIT_THR2 = 120.0f * LOG2E;

constexpr size_t MiB = 1u << 20;
constexpr size_t WS_CTL = 0, CTL_ZERO_BYTES = 1 * MiB;
constexpr size_t WS_WIN = 1 * MiB;
constexpr size_t WS_WOUT = 6 * MiB;
constexpr size_t WS_W1 = 8 * MiB;
constexpr size_t WS_W2 = 72 * MiB;
constexpr size_t WS_PW = 104 * MiB;
constexpr size_t WS_LRUW = WS_PW + 128 * 1024;
constexpr size_t WS_WR = WS_PW + 256 * 1024;
constexpr size_t WS_RS1 = 105 * MiB;
constexpr size_t WS_RS2 = WS_RS1 + 128 * 1024;
constexpr size_t WS_TOKE = WS_RS2 + 128 * 1024;
constexpr size_t WS_TOKR = WS_TOKE + 256 * 1024;
constexpr size_t WS_TOKG = WS_TOKR + 256 * 1024;
constexpr size_t WS_RSS = WS_TOKG + 256 * 1024;
constexpr size_t WS_GTS = WS_RSS + 288 * 1024;
constexpr size_t WS_SUMM = 107 * MiB;
constexpr size_t WS_XBY = 109 * MiB;
constexpr size_t WS_PROJ = 173 * MiB;
constexpr size_t WS_HP = 333 * MiB;
constexpr size_t WS_END = 405 * MiB;
constexpr int CW_TMO = 0, CW_BAR = 4096, CW_CNT = 8192;

constexpr int SCR_BYTES = 143360;
constexpr int LDSCTL_OFF = SCR_BYTES;
constexpr int LDS_BYTES = 147456;
constexpr int NWAVES = 8, NTHR = 512;

typedef float f32x16 __attribute__((ext_vector_type(16)));
typedef short s16x4 __attribute__((ext_vector_type(4)));
typedef unsigned u32x2 __attribute__((ext_vector_type(2)));
typedef float f32x2 __attribute__((ext_vector_type(2)));
typedef __bf16 bf16x2_t __attribute__((ext_vector_type(2)));

__device__ __forceinline__ unsigned cvtpk(float lo, float hi) { f32x2 v = {lo, hi}; bf16x2_t b = __builtin_convertvector(v, bf16x2_t); return __builtin_bit_cast(unsigned, b); }
__device__ __forceinline__ float bflo(unsigned w) { return __uint_as_float(w << 16); }
__device__ __forceinline__ float bfhi(unsigned w) { return __uint_as_float(w & 0xffff0000u); }
__device__ __forceinline__ float fexp2(float x) { return __builtin_amdgcn_exp2f(x); }
__device__ __forceinline__ float flog2(float x) { return __builtin_amdgcn_logf(x); }
__device__ __forceinline__ float frcp(float x) { return __builtin_amdgcn_rcpf(x); }
__device__ __forceinline__ float sigmoidf_(float x) { return frcp(1.0f + fexp2(-LOG2E * x)); }
__device__ __forceinline__ float wave_sum(float v) {
#pragma unroll
    for (int o = 1; o < 64; o <<= 1) v += __shfl_xor(v, o);
    return v;
}
#define WG_SYNC() __syncthreads()
__device__ __forceinline__ int opq(int x) { asm volatile("" : "+v"(x)); return x; }

struct Frame {
    LAS unsigned char* lds;
    gu32* ctl;
    int tid, lane, wave, vcu, G;
    const float* const* in;
    float* out; unsigned char* ws;
};

__device__ __forceinline__ int dest_row(int n, int mode) {
    if (mode == 1) { const int t = n & ~255, c = n & 255; return t + 128 * ((c >> 5) & 1) + 32 * (c >> 6) + (c & 31); }
    if (mode == 2) return 8 * (n >> 2) + (n & 3);
    if (mode == 3) return 8 * (n >> 2) + 4 + (n & 3);
    return n;
}
__device__ __forceinline__ void transpose_item(const float* W, int ldn, int k0, int n0, const float* gain, bf16* WT, int ldk, int mode, LAS float* scr  , int lane) {
    float v[64]; const float* p = W + (size_t)k0 * ldn + n0 + lane;
#pragma unroll
    for (int i = 0; i < 64; ++i) { v[i] = *(const GAS float*)p; p += ldn; }
    if (gain) {
#pragma unroll
        for (int i = 0; i < 64; ++i) v[i] *= gain[k0 + i]; }
#pragma unroll
    for (int i = 0; i < 64; ++i) scr[i * 65 + lane] = v[i];
    LDS_WAIT(); asm volatile("" ::: "memory");
    const int c = lane & 7;
#pragma unroll
    for (int j = 0; j < 8; ++j) { const int n = (lane >> 3) + 8 * j; const LAS float* s = scr + (8 * c) * 65 + n;
        v4u o; o.x = cvtpk(s[0 * 65], s[1 * 65]); o.y = cvtpk(s[2 * 65], s[3 * 65]); o.z = cvtpk(s[4 * 65], s[5 * 65]); o.w = cvtpk(s[6 * 65], s[7 * 65]);
        *(GAS v4u*)(WT + (size_t)dest_row(n0 + n, mode) * ldk + k0 + 8 * c) = o; }
    LDS_WAIT(); asm volatile("" ::: "memory");
}
__device__ __forceinline__ void convert_weights(Frame& F, int l) {
    LAS float* scr = (LAS float*)(F.lds + F.wave * 16640);
    const int gw = F.vcu * NWAVES + F.wave, NGW = F.G * NWAVES;
    constexpr int I_IN = (DM / 64) * (DIN / 64), I_OUT = (DM / 64) * (DM / 64), I_GU = NE * (DM / 64) * (DE / 64), I_D = NE * (DE / 64) * (DM / 64);
    constexpr int I_PW = (DCONF / 64) * (DCONF / 64), I_LW = 8;
    constexpr int NITEMS = I_IN + I_OUT + 2 * I_GU + I_D + I_PW + I_LW;
    for (int it = gw; it < NITEMS; it += NGW) {
        int r = it;
        if (r < 2 * I_GU) { const int up = r >= I_GU; if (up) r -= I_GU; const int e = r / 128, q = r % 128, kb = q / 8, nb = q % 8; const float* src = F.in[up ? 24 : 23] + (size_t)l * NE * DM * DE + (size_t)e * DM * DE;
            transpose_item(src, DE, 64 * kb, 64 * nb, F.in[20] + l * DM, (bf16*)(F.ws + WS_W1) + (size_t)e * 1024 * 1024, DM, up ? 3 : 2, scr, F.lane); continue; } r -= 2 * I_GU;
        if (r < I_D) { const int e = r / 128, q = r % 128, kb = q / 16, nb = q % 16; transpose_item(F.in[25] + (size_t)l * NE * DE * DM + (size_t)e * DE * DM, DM, 64 * kb, 64 * nb, nullptr, (bf16*)(F.ws + WS_W2) + (size_t)e * 1024 * 512, DE, 0, scr, F.lane); continue; } r -= I_D;
        if (r < I_IN) { const int kb = r / (DIN / 64), nb = r % (DIN / 64); transpose_item(F.in[2] + (size_t)l * DM * DIN, DIN, 64 * kb, 64 * nb, F.in[1] + l * DM, (bf16*)(F.ws + WS_WIN), DM, 1, scr, F.lane); continue; } r -= I_IN;
        if (r < I_OUT) { const int kb = r / 16, nb = r % 16; transpose_item(F.in[19] + (size_t)l * DM * DM, DM, 64 * kb, 64 * nb, F.in[18] + l * DM, (bf16*)(F.ws + WS_WOUT), DM, 0, scr, F.lane); continue; } r -= I_OUT;
        if (r < I_PW) { const int kb = r / 4, nb = r % 4; transpose_item(F.in[16] + (size_t)l * DCONF * DCONF, DCONF, 64 * kb, 64 * nb, nullptr, (bf16*)(F.ws + WS_PW), DCONF, 0, scr, F.lane); continue; } r -= I_PW;
        { const int mat = r; const float* src = F.in[mat < 4 ? 7 : 9] + (size_t)l * 4 * 64 * 64 + (size_t)(mat & 3) * 64 * 64; transpose_item(src, 64, 0, 0, nullptr, (bf16*)(F.ws + WS_LRUW) + (size_t)mat * 64 * 64, 64, 0, scr, F.lane); }
    }
    const float* g2 = F.in[20] + l * DM; const float* rc = F.in[21] + (size_t)l * DM * 4; const float* rf = F.in[22] + (size_t)l * DM * NE; float* WR = (float*)(F.ws + WS_WR);
    for (int idx = (F.vcu * NTHR + F.tid); idx < NRTP * DM; idx += F.G * NTHR) { const int n = idx / DM, k = idx % DM;
        float v = 0.f; if (n < 4) v = rc[k * 4 + n] * g2[k]; else if (n < NRT) v = rf[k * NE + (n - 4)] * g2[k]; WR[idx] = v; }
    LDS_WAIT(); WG_SYNC();
}
__device__ __forceinline__ void x_to_bf16_rows(Frame& F, const float* x, bf16* XB, float* RS1) {
    const int gw = F.vcu * NWAVES + F.wave, NGW = F.G * NWAVES;
    for (int m = 2 * gw; m < MTOK; m += 2 * NGW) {
        f32x4 v[2][4]; float s[2] = {0.f, 0.f};
#pragma unroll
        for (int q = 0; q < 2; ++q) { const GAS f32x4* xr = (const GAS f32x4*)(x + (size_t)(m + q) * DM) + F.lane;
#pragma unroll
            for (int j = 0; j < 4; ++j) v[q][j] = xr[64 * j]; }
#pragma unroll
        for (int q = 0; q < 2; ++q) {
#pragma unroll
            for (int j = 0; j < 4; ++j) s[q] += (v[q][j].x * v[q][j].x + v[q][j].y * v[q][j].y) + (v[q][j].z * v[q][j].z + v[q][j].w * v[q][j].w);
            s[q] = wave_sum(s[q]);
            GAS u32x2* o8 = (GAS u32x2*)(XB + (size_t)(m + q) * DM) + F.lane;
#pragma unroll
            for (int j = 0; j < 4; ++j) { u32x2 w; w.x = cvtpk(v[q][j].x, v[q][j].y); w.y = cvtpk(v[q][j].z, v[q][j].w); o8[64 * j] = w; }
            if (F.lane == 0) RS1[m + q] = __builtin_amdgcn_rsqf(s[q] * (1.0f / DM) + EPSN); }
    }
}

namespace att {
constexpr int SLOT16 = 16384, NSLOT = 5, L_OST = NSLOT * SLOT16, L_FLAG = L_OST + NWAVES * 4096;
__device__ __forceinline__ int crow(int r, int hi) { return (r & 3) + 8 * (r >> 2) + 4 * hi; }
typedef const LAS unsigned char* lptr;
template <bool DIAG> __device__ __forceinline__ void tile(lptr kslot, int vb, const bf16x8 (&qr)[4], f32x16 (&o)[2], float& R, int kbase, int qpos, int r32, int hi) {
    f32x16 p0 = f32x16{}, p1 = f32x16{};
    { lptr kb = kslot + hi * 1024 + r32 * 16;
#pragma unroll
      for (int d0 = 0; d0 < 4; ++d0) { const bf16x8 b0 = *(const LAS bf16x8*)(kb + d0 * 2048), b1 = *(const LAS bf16x8*)(kb + d0 * 2048 + 512);
          p0 = __builtin_amdgcn_mfma_f32_32x32x16_bf16(b0, qr[d0], p0, 0, 0, 0); p1 = __builtin_amdgcn_mfma_f32_32x32x16_bf16(b1, qr[d0], p1, 0, 0, 0); } }
    f32x16 K0, K1;
#pragma unroll
    for (int r = 0; r < 16; ++r) {
        const int kk = kbase + (r & 3) + 8 * (r >> 2);
        { const float x = __builtin_amdgcn_fmed3f(p0[r], -100.f, 100.f); const float e = fexp2(-x); float bt = frcp(1.0f + e); float kp = e * bt; if (DIAG && !(kk < qpos)) { kp = 1.f; bt = 0.f; } K0[r] = kp; p0[r] = bt; }
        { const float x = __builtin_amdgcn_fmed3f(p1[r], -100.f, 100.f); const float e = fexp2(-x); float bt = frcp(1.0f + e); float kp = e * bt; if (DIAG && !(kk + 32 < qpos)) { kp = 1.f; bt = 0.f; } K1[r] = kp; p1[r] = bt; }
    }
    float Gs[2][4], T[2][4];
#pragma unroll
    for (int bq = 0; bq < 4; ++bq) {
        const float g0 = (K0[4 * bq] * K0[4 * bq + 1]) * (K0[4 * bq + 2] * K0[4 * bq + 3]), g1 = (K1[4 * bq] * K1[4 * bq + 1]) * (K1[4 * bq + 2] * K1[4 * bq + 3]);
        auto r0 = __builtin_amdgcn_permlane32_swap(__float_as_uint(g0), __float_as_uint(g0), false, false);
        auto r1 = __builtin_amdgcn_permlane32_swap(__float_as_uint(g1), __float_as_uint(g1), false, false);
        Gs[0][bq] = hi ? 1.0f : __uint_as_float(r0[1]); T[0][bq] = __uint_as_float(r0[0]) * __uint_as_float(r0[1]);
        Gs[1][bq] = hi ? 1.0f : __uint_as_float(r1[1]); T[1][bq] = __uint_as_float(r1[0]) * __uint_as_float(r1[1]);
    }
    float cum = fexp2(R), tt0 = 1.0f, tt1 = 1.0f;
#pragma unroll
    for (int a = 1; a >= 0; --a)
#pragma unroll
        for (int bq = 3; bq >= 0; --bq) {
            const float s3 = cum * Gs[a][bq];
            if (a == 1) { const float s2 = s3 * K1[4 * bq + 3], s1 = s2 * K1[4 * bq + 2], s0 = s1 * K1[4 * bq + 1];
                p1[4 * bq + 3] *= s3; p1[4 * bq + 2] *= s2; p1[4 * bq + 1] *= s1; p1[4 * bq] *= s0; }
            else { const float s2 = s3 * K0[4 * bq + 3], s1 = s2 * K0[4 * bq + 2], s0 = s1 * K0[4 * bq + 1];
                p0[4 * bq + 3] *= s3; p0[4 * bq + 2] *= s2; p0[4 * bq + 1] *= s1; p0[4 * bq] *= s0; }
            cum *= T[a][bq]; if (a == 1) tt1 *= T[a][bq]; else tt0 *= T[a][bq];
        }
    R += flog2(tt1) + flog2(tt0);
    v4u pw0, pw1, pw2, pw3;
    pw0.x = cvtpk(p0[0], p0[1]); pw0.y = cvtpk(p0[2], p0[3]); pw0.z = cvtpk(p0[4], p0[5]); pw0.w = cvtpk(p0[6], p0[7]);
    pw1.x = cvtpk(p0[8], p0[9]); pw1.y = cvtpk(p0[10], p0[11]); pw1.z = cvtpk(p0[12], p0[13]); pw1.w = cvtpk(p0[14], p0[15]);
    pw2.x = cvtpk(p1[0], p1[1]); pw2.y = cvtpk(p1[2], p1[3]); pw2.z = cvtpk(p1[4], p1[5]); pw2.w = cvtpk(p1[6], p1[7]);
    pw3.x = cvtpk(p1[8], p1[9]); pw3.y = cvtpk(p1[10], p1[11]); pw3.z = cvtpk(p1[12], p1[13]); pw3.w = cvtpk(p1[14], p1[15]);
#pragma unroll
    for (int d0 = 0; d0 < 2; ++d0) { s16x4 lo[4], hh[4];
#pragma unroll
        for (int ks = 0; ks < 4; ++ks) {
            asm volatile("ds_read_b64_tr_b16 %0,%1 offset:%c2" : "=&v"(lo[ks]) : "v"(vb), "i"(d0 * 4096 + ks * 1024) : "memory");
            asm volatile("ds_read_b64_tr_b16 %0,%1 offset:%c2" : "=&v"(hh[ks]) : "v"(vb), "i"(d0 * 4096 + ks * 1024 + 512) : "memory"); }
        asm volatile("s_waitcnt lgkmcnt(0)" ::: "memory"); __builtin_amdgcn_sched_barrier(0);
#define ATT_PK(k) (bf16x8){lo[k][0], lo[k][1], lo[k][2], lo[k][3], hh[k][0], hh[k][1], hh[k][2], hh[k][3]}
        o[d0] = __builtin_amdgcn_mfma_f32_32x32x16_bf16(__builtin_bit_cast(bf16x8, pw0), ATT_PK(0), o[d0], 0, 0, 0);
        o[d0] = __builtin_amdgcn_mfma_f32_32x32x16_bf16(__builtin_bit_cast(bf16x8, pw1), ATT_PK(1), o[d0], 0, 0, 0);
        o[d0] = __builtin_amdgcn_mfma_f32_32x32x16_bf16(__builtin_bit_cast(bf16x8, pw2), ATT_PK(2), o[d0], 0, 0, 0);
        o[d0] = __builtin_amdgcn_mfma_f32_32x32x16_bf16(__builtin_bit_cast(bf16x8, pw3), ATT_PK(3), o[d0], 0, 0, 0);
#undef ATT_PK
    }
}
__device__ __forceinline__ void unit(Frame& F, int b, int h, int qb, const bf16* PROJ, bf16* Y) {
    const int lane = (opq((int)threadIdx.x) & 63), r32 = lane & 31, hi = lane >> 5, wid = F.wave;
    LAS unsigned char* shm = F.lds;
    const long rowbase = (long)b * SEQ; const int q0 = qb * 256;
    const bf16* Qw = PROJ + (rowbase + q0 + wid * 32) * DIN + COL_Q + h * HD;
    const bf16* Kh = PROJ + rowbase * DIN + COL_K + h * HD; const bf16* Vh = PROJ + rowbase * DIN + COL_V + h * HD;
    bf16x8 qr[4];
#pragma unroll
    for (int d0 = 0; d0 < 4; ++d0) qr[d0] = *(const GAS bf16x8*)(Qw + (long)r32 * DIN + d0 * 16 + hi * 8);
    f32x16 o[2]; o[0] = f32x16{}; o[1] = f32x16{};
    float R = 0.f;
    const int Dt = 4 * qb + (wid >> 1);
    const int qpos = q0 + wid * 32 + r32;
    bool wave_done = false;
    const bf16* ksrc = Kh + (long)lane * DIN + wid * 8;
    const bf16* vsrc = Vh + (long)(16 * (wid & 3) + (lane >> 2)) * DIN + (wid >> 2) * 32 + (lane & 3) * 8;
    LAS unsigned char* kdst = shm + wid * 1024 + lane * 16; LAS unsigned char* vdst = shm + 8192 + wid * 1024 + lane * 16;
    const int vb0 = (int)(uintptr_t)(shm + 8192) + ((lane >> 4) & 1) * 32 + (lane & 3) * 8 + (4 * hi + ((lane & 15) >> 2)) * 64;
    volatile LAS int* flag = (volatile LAS int*)(shm + L_FLAG);
    { v4u kr[4], vr[4];
#pragma unroll
      for (int p = 0; p < 4; ++p) { kr[p] = *(const GAS v4u*)(ksrc + (long)(4 * qb + p) * 64 * DIN); vr[p] = *(const GAS v4u*)(vsrc + (long)(4 * qb + p) * 64 * DIN); }
#pragma unroll
      for (int p = 0; p < 4; ++p) { const int sl = (4 * qb + p) % NSLOT; *(LAS v4u*)(kdst + sl * SLOT16) = kr[p]; *(LAS v4u*)(vdst + sl * SLOT16) = vr[p]; } }
    LDS_WAIT(); WG_SYNC();
    v4u kreg, vreg;
    for (int j = 0;; ++j) {
        const int tn = 4 * qb - j - 1;
        if (tn >= 0) { kreg = *(const GAS v4u*)(ksrc + (long)tn * 64 * DIN); vreg = *(const GAS v4u*)(vsrc + (long)tn * 64 * DIN); }
        const int t = Dt - j; const int s = (t >= 0) ? (t % NSLOT) : 0;
        if (t >= 0 && !wave_done) {
            if (j == 0) tile<true>(shm + s * SLOT16, vb0 + s * SLOT16, qr, o, R, t * 64 + 4 * hi, qpos, r32, hi);
            else tile<false>(shm + s * SLOT16, vb0 + s * SLOT16, qr, o, R, t * 64 + 4 * hi, qpos, r32, hi);
            wave_done = __all(R < -EXIT_THR2);
        }
        if (t <= 0) wave_done = true;
        if (lane == 0) flag[(j & 1) * 8 + wid] = wave_done ? 1 : 0;
        if (tn >= 0) { const int sl = tn % NSLOT; *(LAS v4u*)(kdst + sl * SLOT16) = kreg; *(LAS v4u*)(vdst + sl * SLOT16) = vreg; }
        LDS_WAIT(); WG_SYNC();
        int alld = 1;
#pragma unroll
        for (int w = 0; w < 8; ++w) alld &= flag[(j & 1) * 8 + w];
        if (alld) break;
    }
    { LAS bf16* stg = (LAS bf16*)(shm + L_OST) + wid * 2048;
#pragma unroll
      for (int r = 0; r < 16; ++r) { const int orow = crow(r, hi);
#pragma unroll
          for (int d0 = 0; d0 < 2; ++d0) stg[orow * 64 + d0 * 32 + r32] = (bf16)(cvtpk(o[d0][r], 0.f) & 0xffffu); }
      LDS_WAIT(); asm volatile("" ::: "memory");
      bf16* Ow = Y + (rowbase + q0 + wid * 32) * DM + h * HD;
#pragma unroll
      for (int i = 0; i < 4; ++i) { const int row = i * 8 + (lane >> 3), ch = lane & 7; const v4u v = *(const LAS v4u*)(stg + row * 64 + ch * 8); *(GAS v4u*)(Ow + (long)row * DM + ch * 8) = v; } }
    LDS_WAIT(); WG_SYNC();
}
}

namespace conf {
constexpr int TM = 64, HALO = 30, UROWS = TM + HALO;
constexpr int L_U = 0  , L_Z = 49152  , L_S = 0  , ZS = 260, SS = 264;
__device__ __forceinline__ void unit(Frame& F, int ut, int l, const bf16* PROJ, bf16* Y) {
    const int tid = opq((int)threadIdx.x), lane = tid & 63, wid = F.wave;
    const int row0 = ut * TM; const int t0 = row0 % SEQ;
    LAS bf16* U = (LAS bf16*)(F.lds + L_U); LAS float* Z = (LAS float*)(F.lds + L_Z); LAS bf16* S = (LAS bf16*)(F.lds + L_S);
    const float* dw_w = F.in[12] + (size_t)l * 31 * DCONF; const float* dw_b = F.in[13] + l * DCONF; const float* ln_g = F.in[14] + l * DCONF; const float* ln_b = F.in[15] + l * DCONF;
    const float* pw_b = F.in[17] + l * DCONF; const bf16* PW = (const bf16*)(F.ws + WS_PW);
    for (int task = tid; task < UROWS * 32; task += NTHR) { const int ur = task >> 5, c8 = task & 31; const int t = t0 - HALO + ur; v4u o = {0u, 0u, 0u, 0u};
        if (t >= 0) { const bf16* pr = PROJ + (size_t)(row0 - HALO + ur) * DIN + COL_XC + c8 * 8; const v4u a = *(const GAS v4u*)pr, g = *(const GAS v4u*)(pr + 256);
            unsigned av[4] = {a.x, a.y, a.z, a.w}, gv[4] = {g.x, g.y, g.z, g.w}, ov[4];
#pragma unroll
            for (int j = 0; j < 4; ++j) ov[j] = cvtpk(bflo(av[j]) * sigmoidf_(bflo(gv[j])), bfhi(av[j]) * sigmoidf_(bfhi(gv[j])));
            o.x = ov[0]; o.y = ov[1]; o.z = ov[2]; o.w = ov[3]; }
        *(LAS v4u*)(U + ur * 256 + c8 * 8) = o; }
    LDS_WAIT(); WG_SYNC();
    { const int c = tid & 255, hf = tid >> 8; float w[31];
#pragma unroll
      for (int j = 0; j < 31; ++j) w[j] = dw_w[j * DCONF + c];
      const float bias = dw_b[c]; float acc[32];
#pragma unroll
      for (int i = 0; i < 32; ++i) acc[i] = bias;
      const LAS bf16* up = U + (hf * 32) * 256 + c;
#pragma unroll
      for (int rho = 0; rho < 62; ++rho) { const float x = __uint_as_float((unsigned)up[rho * 256] << 16);
#pragma unroll
          for (int i = 0; i < 32; ++i) { const int j = rho - i; if (j >= 0 && j <= 30) acc[i] += w[j] * x; } }
#pragma unroll
      for (int i = 0; i < 32; ++i) Z[(hf * 32 + i) * ZS + c] = acc[i]; }
    LDS_WAIT(); WG_SYNC();
    { const f32x4 g = *(const GAS f32x4*)(ln_g + 4 * lane), bb = *(const GAS f32x4*)(ln_b + 4 * lane);
      for (int i = 0; i < 8; ++i) { const int tk = wid * 8 + i; f32x4 v = *(const LAS f32x4*)(Z + tk * ZS + 4 * lane);
          const float mean = wave_sum((v.x + v.y) + (v.z + v.w)) * (1.0f / 256.0f); v = v - mean;
          const float var = wave_sum((v.x * v.x + v.y * v.y) + (v.z * v.z + v.w * v.w)) * (1.0f / 256.0f); const float rstd = __builtin_amdgcn_rsqf(var + EPSN);
          f32x4 y = v * rstd * g + bb; y.x *= sigmoidf_(y.x); y.y *= sigmoidf_(y.y); y.z *= sigmoidf_(y.z); y.w *= sigmoidf_(y.w);
          u32x2 w2; w2.x = cvtpk(y.x, y.y); w2.y = cvtpk(y.z, y.w); *(LAS u32x2*)(S + tk * SS + 4 * lane) = w2; } }
    LDS_WAIT(); WG_SYNC();
    { const int fr = lane & 15, fq = lane >> 4; f32x4 acc[4][2];
#pragma unroll
      for (int m = 0; m < 4; ++m) { acc[m][0] = (f32x4){0.f, 0.f, 0.f, 0.f}; acc[m][1] = (f32x4){0.f, 0.f, 0.f, 0.f}; }
#pragma unroll 2
      for (int ks = 0; ks < 8; ++ks) { bf16x8 bfr[2], afr[4];
#pragma unroll
          for (int n = 0; n < 2; ++n) bfr[n] = *(const GAS bf16x8*)(PW + (size_t)(32 * wid + 16 * n + fr) * DCONF + 32 * ks + 8 * fq);
#pragma unroll
          for (int m = 0; m < 4; ++m) afr[m] = *(const LAS bf16x8*)(S + (16 * m + fr) * SS + 32 * ks + 8 * fq);
#pragma unroll
          for (int m = 0; m < 4; ++m)
#pragma unroll
              for (int n = 0; n < 2; ++n) acc[m][n] = __builtin_amdgcn_mfma_f32_16x16x32_bf16(afr[m], bfr[n], acc[m][n], 0, 0, 0); }
#pragma unroll
      for (int m = 0; m < 4; ++m)
#pragma unroll
          for (int n = 0; n < 2; ++n)
#pragma unroll
              for (int i = 0; i < 4; ++i) Z[(16 * m + 4 * fq + i) * ZS + 32 * wid + 16 * n + fr] = acc[m][n][i]; }
    LDS_WAIT(); WG_SYNC();
    { const f32x4 pb = *(const GAS f32x4*)(pw_b + 4 * lane);
      for (int i = 0; i < 8; ++i) { const int tk = wid * 8 + i; f32x4 v = *(const LAS f32x4*)(Z + tk * ZS + 4 * lane) + pb;
          const float ss = wave_sum((v.x * v.x + v.y * v.y) + (v.z * v.z + v.w * v.w)); const float rs = __builtin_amdgcn_rsqf(ss * (1.0f / 256.0f) + EPSN); v = v * rs;
          u32x2 w2; w2.x = cvtpk(v.x, v.y); w2.y = cvtpk(v.z, v.w); *(GAS u32x2*)(Y + (size_t)(row0 + tk) * DM + 768 + 4 * lane) = w2; } }
    LDS_WAIT(); WG_SYNC();
}
}

namespace lru {
constexpr int TM = 64, XS_ = 260, XBS = 264;
constexpr int L_XC = 0  , L_A = 66560  , L_XB = 66560  ;
__device__ __forceinline__ void unit(Frame& F, int ut, int l, const bf16* PROJ, float* HL, float* PL, float* SUMM) {
    const int tid = opq((int)threadIdx.x), lane = tid & 63, wid = F.wave;
    const int row0 = ut * TM; const int t0 = row0 % SEQ;
    LAS float* XC = (LAS float*)(F.lds + L_XC); LAS float* A = (LAS float*)(F.lds + L_A); LAS bf16* XB = (LAS bf16*)(F.lds + L_XB);
    const float* cw = F.in[5] + (size_t)l * 4 * DLRU; const float* cb = F.in[6] + l * DLRU; const float* ba = F.in[8] + l * DLRU; const float* bx = F.in[10] + l * DLRU; const float* lam = F.in[11] + l * DLRU;
    const bf16* LW = (const bf16*)(F.ws + WS_LRUW);
    for (int task = tid; task < TM * 32; task += NTHR) { const int tk = task >> 5, c8 = task & 31; float acc[8];
        { const f32x4 b0 = *(const GAS f32x4*)(cb + c8 * 8), b1 = *(const GAS f32x4*)(cb + c8 * 8 + 4); acc[0] = b0.x; acc[1] = b0.y; acc[2] = b0.z; acc[3] = b0.w; acc[4] = b1.x; acc[5] = b1.y; acc[6] = b1.z; acc[7] = b1.w; }
#pragma unroll
        for (int j = 0; j < 4; ++j) { const int t = t0 + tk - 3 + j; if (t >= 0) { const v4u a = *(const GAS v4u*)(PROJ + (size_t)(row0 + tk - 3 + j) * DIN + COL_XR + c8 * 8);
                const f32x4 w0 = *(const GAS f32x4*)(cw + j * DLRU + c8 * 8), w1 = *(const GAS f32x4*)(cw + j * DLRU + c8 * 8 + 4);
                acc[0] += w0.x * bflo(a.x); acc[1] += w0.y * bfhi(a.x); acc[2] += w0.z * bflo(a.y); acc[3] += w0.w * bfhi(a.y);
                acc[4] += w1.x * bflo(a.z); acc[5] += w1.y * bfhi(a.z); acc[6] += w1.z * bflo(a.w); acc[7] += w1.w * bfhi(a.w); } }
        *(LAS f32x4*)(XC + tk * XS_ + c8 * 8) = (f32x4){acc[0], acc[1], acc[2], acc[3]}; *(LAS f32x4*)(XC + tk * XS_ + c8 * 8 + 4) = (f32x4){acc[4], acc[5], acc[6], acc[7]};
        v4u o; o.x = cvtpk(acc[0], acc[1]); o.y = cvtpk(acc[2], acc[3]); o.z = cvtpk(acc[4], acc[5]); o.w = cvtpk(acc[6], acc[7]); *(LAS v4u*)(XB + tk * XBS + c8 * 8) = o; }
    LDS_WAIT(); WG_SYNC();
    const int nb = wid >> 1, mh = wid & 1, fr = lane & 15, fq = lane >> 4;
    f32x4 ar[2][4], ai[2][4];
#pragma unroll
    for (int m = 0; m < 2; ++m)
#pragma unroll
        for (int n = 0; n < 4; ++n) { ar[m][n] = (f32x4){0.f, 0.f, 0.f, 0.f}; ai[m][n] = (f32x4){0.f, 0.f, 0.f, 0.f}; }
#pragma unroll
    for (int ks = 0; ks < 2; ++ks) { bf16x8 af[2];
#pragma unroll
        for (int m = 0; m < 2; ++m) af[m] = *(const LAS bf16x8*)(XB + (32 * mh + 16 * m + fr) * XBS + 64 * nb + 32 * ks + 8 * fq);
#pragma unroll
        for (int n = 0; n < 4; ++n) { const bf16x8 bA = *(const GAS bf16x8*)(LW + (size_t)nb * 4096 + (16 * n + fr) * 64 + 32 * ks + 8 * fq), bX = *(const GAS bf16x8*)(LW + (size_t)(4 + nb) * 4096 + (16 * n + fr) * 64 + 32 * ks + 8 * fq);
#pragma unroll
            for (int m = 0; m < 2; ++m) { ar[m][n] = __builtin_amdgcn_mfma_f32_16x16x32_bf16(af[m], bA, ar[m][n], 0, 0, 0); ai[m][n] = __builtin_amdgcn_mfma_f32_16x16x32_bf16(af[m], bX, ai[m][n], 0, 0, 0); } } }
    LDS_WAIT(); WG_SYNC();
#pragma unroll
    for (int n = 0; n < 4; ++n) { const int ch = 64 * nb + 16 * n + fr; const float lsl8 = -8.0f * log1pf(__expf(-lam[ch])), bav = ba[ch], bxv = bx[ch];
#pragma unroll
        for (int m = 0; m < 2; ++m)
#pragma unroll
            for (int i = 0; i < 4; ++i) { const int tk = 32 * mh + 16 * m + 4 * fq + i; const float gr = ar[m][n][i] + bav, gi = ai[m][n][i] + bxv; const float xcv = XC[tk * XS_ + ch];
                const float la = lsl8 * sigmoidf_(gr); const float a = fexp2(LOG2E * la); const float mult = __builtin_sqrtf(__builtin_fmaxf(1.0f - a * a, 0.f));
                A[tk * XS_ + ch] = a; XC[tk * XS_ + ch] = mult * sigmoidf_(gi) * xcv; } }
    LDS_WAIT(); WG_SYNC();
    if (tid < 256) { const int c = tid; float h = 0.f, p = 1.f; float* hl = HL + (size_t)row0 * DLRU + c; float* pl = PL + (size_t)row0 * DLRU + c;
#pragma unroll 8
        for (int tk = 0; tk < TM; ++tk) { const float a = A[tk * XS_ + c], u = XC[tk * XS_ + c]; p *= a; h = a * h + u; hl[(size_t)tk * DLRU] = h; pl[(size_t)tk * DLRU] = p; }
        SUMM[(size_t)ut * 512 + c] = p; SUMM[(size_t)ut * 512 + 256 + c] = h; }
    LDS_WAIT(); WG_SYNC();
}
}

__device__ __forceinline__ void fixup_unit(Frame& F, int ut, const bf16* PROJ, const float* HL, const float* PL, const float* SUMM, bf16* Y) {
    const int tid = opq((int)threadIdx.x), lane = tid & 63, wid = F.wave; const int row0 = ut * 64; const int cb = (row0 % SEQ) / 64, ub0 = ut - cb;
    LAS float* CAR = (LAS float*)F.lds;
    if (tid < 256) { float car = 0.f;
#pragma unroll 8
        for (int j = 0; j < cb; ++j) { const float p = SUMM[(size_t)(ub0 + j) * 512 + tid], h = SUMM[(size_t)(ub0 + j) * 512 + 256 + tid]; car = p * car + h; }
        CAR[tid] = car; }
    LDS_WAIT(); WG_SYNC();
    const f32x4 car = *(const LAS f32x4*)(CAR + 4 * lane);
#pragma unroll 4
    for (int i = 0; i < 8; ++i) { const size_t row = (size_t)row0 + wid * 8 + i;
        const f32x4 hl = *(const GAS f32x4*)(HL + row * DLRU + 4 * lane), pl = *(const GAS f32x4*)(PL + row * DLRU + 4 * lane);
        const u32x2 xg = *(const GAS u32x2*)(PROJ + row * DIN + COL_XG + 4 * lane); const v4u ya = *(const GAS v4u*)(Y + row * DM + 8 * lane);
        f32x4 h = hl + pl * car; const float xv[4] = {bflo(xg.x), bfhi(xg.x), bflo(xg.y), bfhi(xg.y)}; float y[4];
#pragma unroll
        for (int j = 0; j < 4; ++j) { const float x = xv[j]; const float u2 = 1.5957691216057308f * (x + 0.044715f * x * x * x); y[j] = h[j] * x * sigmoidf_(u2); }
        const float ssb = wave_sum((y[0] * y[0] + y[1] * y[1]) + (y[2] * y[2] + y[3] * y[3])); const float rsb = __builtin_amdgcn_rsqf(ssb * (1.0f / 256.0f) + EPSN);
        u32x2 w2; w2.x = cvtpk(y[0] * rsb, y[1] * rsb); w2.y = cvtpk(y[2] * rsb, y[3] * rsb); *(GAS u32x2*)(Y + row * DM + 512 + 4 * lane) = w2;
        float a[8] = {bflo(ya.x), bfhi(ya.x), bflo(ya.y), bfhi(ya.y), bflo(ya.z), bfhi(ya.z), bflo(ya.w), bfhi(ya.w)}; float ssa = 0.f;
#pragma unroll
        for (int j = 0; j < 8; ++j) ssa += a[j] * a[j];
        ssa = wave_sum(ssa); const float rsa = __builtin_amdgcn_rsqf(ssa * (1.0f / 512.0f) + EPSN);
        v4u oa; oa.x = cvtpk(a[0] * rsa, a[1] * rsa); oa.y = cvtpk(a[2] * rsa, a[3] * rsa); oa.z = cvtpk(a[4] * rsa, a[5] * rsa); oa.w = cvtpk(a[6] * rsa, a[7] * rsa);
        *(GAS v4u*)(Y + row * DM + 8 * lane) = oa; }
    LDS_WAIT(); WG_SYNC();
}

__device__ __forceinline__ void router_unit(Frame& F, int ut, int l, const float* X, float* RS2, int* TOKE, int* TOKR, float* TOKG) {
    const int tid = opq((int)threadIdx.x), lane = tid & 63, wid = F.wave, fr = lane & 15, fq = lane >> 4;
    const float* WR = (const float*)(F.ws + WS_WR);
    LAS float* LG = (LAS float*)F.lds + wid * (16 * NRTP + 16);
    LAS int* CNT = (LAS int*)(F.lds + 32768); LAS int* BASE = CNT + 32;
    if (tid < 32) CNT[tid] = 0;
    const int r0 = ut * 128 + wid * 16;
    f32x4 acc[3]; acc[0] = (f32x4){0.f, 0.f, 0.f, 0.f}; acc[1] = acc[0]; acc[2] = acc[0]; float ss = 0.f;
    const float* xp = X + (size_t)(r0 + fr) * DM + 4 * fq; const float* wp = WR + (size_t)fr * DM + 4 * fq;
#pragma unroll 4
    for (int s = 0; s < DM / 16; ++s) { const f32x4 a = *(const GAS f32x4*)(xp + 16 * s); ss += (a.x * a.x + a.y * a.y) + (a.z * a.z + a.w * a.w);
#pragma unroll
        for (int n = 0; n < 3; ++n) { const f32x4 b = *(const GAS f32x4*)(wp + (size_t)16 * n * DM + 16 * s);
            acc[n] = __builtin_amdgcn_mfma_f32_16x16x4f32(a.x, b.x, acc[n], 0, 0, 0); acc[n] = __builtin_amdgcn_mfma_f32_16x16x4f32(a.y, b.y, acc[n], 0, 0, 0);
            acc[n] = __builtin_amdgcn_mfma_f32_16x16x4f32(a.z, b.z, acc[n], 0, 0, 0); acc[n] = __builtin_amdgcn_mfma_f32_16x16x4f32(a.w, b.w, acc[n], 0, 0, 0); } }
    ss += __shfl_xor(ss, 16); ss += __shfl_xor(ss, 32);
    const float rs = __builtin_amdgcn_rsqf(ss * (1.0f / DM) + EPSN);
    if (fq == 0) LG[16 * NRTP + fr] = rs;
#pragma unroll
    for (int n = 0; n < 3; ++n)
#pragma unroll
        for (int i = 0; i < 4; ++i) LG[(4 * fq + i) * NRTP + 16 * n + fr] = acc[n][i];
    LDS_WAIT(); WG_SYNC();
    int e0 = 0, e1 = 0, lr0 = 0, lr1 = 0; float g0 = 0.f, g1 = 0.f, rsv = 0.f;
    if (lane < 16) { const LAS float* lg = LG + lane * NRTP; rsv = LG[16 * NRTP + lane];
        float c[4]; int grp = 0; float cm;
#pragma unroll
        for (int j = 0; j < 4; ++j) c[j] = lg[j] * rsv;
        cm = c[0];
#pragma unroll
        for (int j = 1; j < 4; ++j) if (c[j] > cm) { cm = c[j]; grp = j; }
        float den = 0.f;
#pragma unroll
        for (int j = 0; j < 4; ++j) den += __expf(c[j] - cm);
        const float wgrp = 1.0f / den;
        float v0 = -INFINITY, v1 = -INFINITY; int i0 = 0, i1 = 0;
#pragma unroll
        for (int j = 0; j < 8; ++j) { const float v = lg[4 + grp * 8 + j] * rsv; if (v > v0) { v1 = v0; i1 = i0; v0 = v; i0 = j; } else if (v > v1) { v1 = v; i1 = j; } }
        const float ex = __expf(v1 - v0); g0 = wgrp / (1.0f + ex); g1 = wgrp * ex / (1.0f + ex);
        e0 = grp * 8 + i0; e1 = grp * 8 + i1;
        lr0 = atomicAdd((int*)(CNT + e0), 1); lr1 = atomicAdd((int*)(CNT + e1), 1); }
    LDS_WAIT(); WG_SYNC();
    if (tid < 32) { const int c = CNT[tid]; int bse = 0; if (c > 0) bse = (int)__hip_atomic_fetch_add((unsigned*)(F.ctl + CW_CNT + 64 * l + tid), (unsigned)c, __ATOMIC_RELAXED, __HIP_MEMORY_SCOPE_AGENT); BASE[tid] = bse; }
    LDS_WAIT(); WG_SYNC();
    if (lane < 16) { const int tok = r0 + lane; RS2[tok] = rsv; TOKE[2 * tok] = e0; TOKE[2 * tok + 1] = e1; TOKR[2 * tok] = BASE[e0] + lr0; TOKR[2 * tok + 1] = BASE[e1] + lr1; TOKG[2 * tok] = g0; TOKG[2 * tok + 1] = g1; }
    LDS_WAIT(); WG_SYNC();
}
__device__ __forceinline__ int moe_tables(Frame& F, int l, LAS int* PST, LAS int* TE) {
    if (F.tid == 0) { int acc = 0; for (int e = 0; e < NE; ++e) { const int c = (int)__hip_atomic_load(F.ctl + CW_CNT + 64 * l + e, __ATOMIC_RELAXED, __HIP_MEMORY_SCOPE_AGENT); PST[e] = acc; acc += (c + 255) & ~255; } PST[NE] = acc; }
    LDS_WAIT(); WG_SYNC();
    const int ntile = PST[NE] >> 8;
    for (int rt = F.tid; rt < ntile; rt += NTHR) { int e = 0;
        for (int j = 1; j < NE; ++j) if ((PST[j] >> 8) <= rt) e = j;
        TE[rt] = e; }
    LDS_WAIT(); WG_SYNC();
    return ntile;
}
__device__ __forceinline__ void gather_phase(Frame& F, int l, const float* X, const float* RS2, const int* TOKE, const int* TOKR, const float* TOKG, bf16* XS, float* RSS, float* GTS) {
    LAS int* PST = (LAS int*)F.lds; LAS int* TE = PST + 64;
    (void)moe_tables(F, l, PST, TE);
    const int gw = F.vcu * NWAVES + F.wave, NGW = F.G * NWAVES;
    for (int m = 2 * gw; m < MTOK; m += 2 * NGW) {
        f32x4 v[2][4]; int slot[2][2]; float rs[2], gt[2][2];
#pragma unroll
        for (int q = 0; q < 2; ++q) { const GAS f32x4* xr = (const GAS f32x4*)(X + (size_t)(m + q) * DM) + F.lane;
#pragma unroll
            for (int j = 0; j < 4; ++j) v[q][j] = xr[64 * j];
            rs[q] = RS2[m + q];
#pragma unroll
            for (int k = 0; k < 2; ++k) { slot[q][k] = PST[TOKE[2 * (m + q) + k]] + TOKR[2 * (m + q) + k]; gt[q][k] = TOKG[2 * (m + q) + k]; } }
#pragma unroll
        for (int q = 0; q < 2; ++q) { u32x2 w[4];
#pragma unroll
            for (int j = 0; j < 4; ++j) { w[j].x = cvtpk(v[q][j].x, v[q][j].y); w[j].y = cvtpk(v[q][j].z, v[q][j].w); }
#pragma unroll
            for (int k = 0; k < 2; ++k) { GAS u32x2* o8 = (GAS u32x2*)(XS + (size_t)slot[q][k] * DM) + F.lane;
#pragma unroll
                for (int j = 0; j < 4; ++j) o8[64 * j] = w[j];
                if (F.lane == 0) { RSS[slot[q][k]] = rs[q]; GTS[slot[q][k]] = gt[q][k]; } } }
    }
    for (int e = gw; e < NE; e += NGW) { const int c = (int)__hip_atomic_load(F.ctl + CW_CNT + 64 * l + e, __ATOMIC_RELAXED, __HIP_MEMORY_SCOPE_AGENT);
        for (int slot = PST[e] + c; slot < PST[e + 1]; ++slot) { GAS u32x2* o8 = (GAS u32x2*)(XS + (size_t)slot * DM) + F.lane;
#pragma unroll
            for (int j = 0; j < 4; ++j) o8[64 * j] = (u32x2){0u, 0u};
            if (F.lane == 0) { RSS[slot] = 0.f; GTS[slot] = 0.f; } } }
    LDS_WAIT(); WG_SYNC();
}
__device__ __forceinline__ void combine_phase(Frame& F, int l, float* X, const int* TOKE, const int* TOKR, const bf16* OB, bool next_layer, bf16* XB, float* RS1) {
    LAS int* PST = (LAS int*)F.lds; LAS int* TE = PST + 64;
    (void)moe_tables(F, l, PST, TE);
    const int gw = F.vcu * NWAVES + F.wave, NGW = F.G * NWAVES;
    for (int m = 2 * gw; m < MTOK; m += 2 * NGW) {
        f32x4 v[2][4]; u32x2 oa[2][4], ob[2][4];
#pragma unroll
        for (int q = 0; q < 2; ++q) { const int mm = m + q; const int s0 = PST[TOKE[2 * mm]] + TOKR[2 * mm], s1 = PST[TOKE[2 * mm + 1]] + TOKR[2 * mm + 1];
            const GAS f32x4* xr = (const GAS f32x4*)(X + (size_t)mm * DM) + F.lane;
            const GAS u32x2* o0 = (const GAS u32x2*)(OB + (size_t)s0 * DM) + F.lane; const GAS u32x2* o1 = (const GAS u32x2*)(OB + (size_t)s1 * DM) + F.lane;
#pragma unroll
            for (int j = 0; j < 4; ++j) { v[q][j] = xr[64 * j]; oa[q][j] = o0[64 * j]; ob[q][j] = o1[64 * j]; } }
#pragma unroll
        for (int q = 0; q < 2; ++q) { const int mm = m + q; float ss = 0.f; GAS f32x4* xw = (GAS f32x4*)(X + (size_t)mm * DM) + F.lane;
#pragma unroll
            for (int j = 0; j < 4; ++j) { const u32x2 a = oa[q][j], b = ob[q][j]; f32x4& x = v[q][j];
                x.x += bflo(a.x) + bflo(b.x); x.y += bfhi(a.x) + bfhi(b.x); x.z += bflo(a.y) + bflo(b.y); x.w += bfhi(a.y) + bfhi(b.y);
                ss += (x.x * x.x + x.y * x.y) + (x.z * x.z + x.w * x.w); xw[64 * j] = x; }
            if (next_layer) { ss = wave_sum(ss); GAS u32x2* o8 = (GAS u32x2*)(XB + (size_t)mm * DM) + F.lane;
#pragma unroll
                for (int j = 0; j < 4; ++j) { u32x2 w; w.x = cvtpk(v[q][j].x, v[q][j].y); w.y = cvtpk(v[q][j].z, v[q][j].w); o8[64 * j] = w; }
                if (F.lane == 0) RS1[mm] = __builtin_amdgcn_rsqf(ss * (1.0f / DM) + EPSN); } }
    }
    LDS_WAIT(); WG_SYNC();
}

constexpr int PH_PER_LAYER = 9, N_PHASES = 1 + DEPTH * PH_PER_LAYER;
struct Args { const float* in[26]; float* out; unsigned char* ws; int ph_lo, ph_hi; };
__global__ void __launch_bounds__(NTHR, 2) mk_fwd(Args args) {
    extern __shared__ __attribute__((aligned(16))) unsigned char lds[];
    Frame F;
    F.lds = (LAS unsigned char*)lds;
    F.tid = threadIdx.x; F.lane = F.tid & 63; F.wave = __builtin_amdgcn_readfirstlane(F.tid >> 6);
    F.G = gridDim.x; { const int bx = blockIdx.x; F.vcu = (F.G % 8 == 0) ? (bx % 8) * (F.G / 8) + bx / 8 : bx; }
    F.in = args.in;
    F.out = args.out; F.ws = args.ws; F.ctl = (gu32*)(args.ws + WS_CTL);
    for (int u = F.tid; u < (LDS_BYTES - LDSCTL_OFF) / 4; u += NTHR) ((LAS unsigned*)(F.lds + LDSCTL_OFF))[u] = 0u;
    __syncthreads();
    const bool one_launch = (args.ph_hi - args.ph_lo) > 1;
    XcdBarrier bar; bar.bar = (unsigned*)(F.ctl + CW_BAR); bar.x = 0; bar.st = nullptr;
    if (one_launch) bar = xcd_barrier_post((unsigned*)(F.ctl + CW_BAR), (volatile LAS unsigned*)(F.lds + LDSCTL_OFF + 32));
    const int lo = args.ph_lo, hi = args.ph_hi;
#ifndef PH_MASK
#define PH_MASK 0x1fff
#endif
#define IN(k) (lo <= (k) && (k) < hi)
#define EN(j) (((PH_MASK) >> (j)) & 1)
#ifndef DBL_MASK
#define DBL_MASK 0
#endif
#define NREP(j) ((((DBL_MASK) >> (j)) & 1) ? 2 : 1)
#define PHASE_BEGIN() do { F.tid = opq((int)threadIdx.x); F.lane = F.tid & 63; F.wave = __builtin_amdgcn_readfirstlane(F.tid >> 6); { int v_ = F.vcu; asm volatile("" : "+s"(v_)); F.vcu = v_; } } while (0)
#define SEAM(k) do { if (IN(k) && IN((k) + 1)) xcd_barrier(bar); } while (0)
#define XBY ((bf16*)(F.ws + WS_XBY))
#define PROJ ((bf16*)(F.ws + WS_PROJ))
#define XSOB ((bf16*)(F.ws + WS_PROJ))
#define HB ((bf16*)(F.ws + WS_HP))
#define HL ((float*)(F.ws + WS_HP))
#define PL ((float*)(F.ws + WS_HP) + (size_t)MTOK * DLRU)
#define SUMM ((float*)(F.ws + WS_SUMM))
#define RS1 ((float*)(F.ws + WS_RS1))
#define RS2 ((float*)(F.ws + WS_RS2))
#define TOKE ((int*)(F.ws + WS_TOKE))
#define TOKR ((int*)(F.ws + WS_TOKR))
#define TOKG ((float*)(F.ws + WS_TOKG))
#define RSS ((float*)(F.ws + WS_RSS))
#define GTS ((float*)(F.ws + WS_GTS))

    if (EN(0) && IN(0)) { PHASE_BEGIN(); for (int rep = 0; rep < NREP(0); ++rep) { convert_weights(F, 0); x_to_bf16_rows(F, F.in[0], XBY, RS1); } }
    SEAM(0);
#pragma unroll 1
    for (int l = 0; l < DEPTH; ++l) {
        const int pb = 1 + l * PH_PER_LAYER;
        const float* xin = (l == 0) ? F.in[0] : F.out;
        if (EN(1) && IN(pb + 0)) { PHASE_BEGIN(); pg8::Gemm g{XBY, (const bf16*)(F.ws + WS_WIN), MTOK, DIN, DM}; pg8::StaticOrder S; S.init(MTOK, DIN, F.G, (int)blockIdx.x);
            pg8::EpiProj E{PROJ, RS1, F.in[3] + l * HD, F.in[4] + l * HD, DIN, QSCALE};
            for (int rep = 0; rep < NREP(1); ++rep) pg8::gemm_phase<pg8::EpiProj, pg8::StaticOrder, true, true>(F.lds, g, S, E); }
        SEAM(pb + 0);
        if (EN(2) && IN(pb + 1)) { PHASE_BEGIN();
            if (EN(10)) for (int rep = 0; rep < NREP(2); ++rep) for (int a = F.vcu; a < NB * NH * (SEQ / 256); a += F.G) { const int qb = a & 31, bh = a >> 5; att::unit(F, bh >> 3, bh & 7, qb, PROJ, XBY); }
            if (EN(11)) for (int rep = 0; rep < NREP(3); ++rep) for (int u = F.vcu; u < MTOK / 64; u += F.G) conf::unit(F, u, l, PROJ, XBY);
            if (EN(12)) for (int rep = 0; rep < NREP(4); ++rep) for (int u = F.vcu; u < MTOK / 64; u += F.G) lru::unit(F, u, l, PROJ, HL, PL, SUMM);
        }
        SEAM(pb + 1);
        if (EN(3) && IN(pb + 2)) { PHASE_BEGIN(); for (int rep = 0; rep < NREP(5); ++rep) for (int u = F.vcu; u < MTOK / 64; u += F.G) fixup_unit(F, u, PROJ, HL, PL, SUMM, XBY); }
        SEAM(pb + 2);
        if (EN(4) && IN(pb + 3)) { PHASE_BEGIN(); pg8::Gemm g{XBY, (const bf16*)(F.ws + WS_WOUT), MTOK, DM, DM}; pg8::StaticOrder S; S.init(MTOK, DM, F.G, (int)blockIdx.x);
            pg8::EpiResid E{xin, F.out, DM};
            for (int rep = 0; rep < ((l == 0) ? NREP(6) : 1); ++rep) pg8::gemm_phase<pg8::EpiResid, pg8::StaticOrder, true, true>(F.lds, g, S, E); }
        SEAM(pb + 3);
        if (EN(5) && IN(pb + 4)) { PHASE_BEGIN(); for (int u = F.vcu; u < MTOK / 128; u += F.G) router_unit(F, u, l, F.out, RS2, TOKE, TOKR, TOKG); }
        SEAM(pb + 4);
        if (EN(6) && IN(pb + 5)) { PHASE_BEGIN(); for (int rep = 0; rep < NREP(7); ++rep) gather_phase(F, l, F.out, RS2, TOKE, TOKR, TOKG, XSOB, RSS, GTS); }
        SEAM(pb + 5);
        if (EN(7) && IN(pb + 6)) { PHASE_BEGIN(); LAS int* PST = (LAS int*)(F.lds + SCR_BYTES - 2048); LAS int* TE = PST + 64; const int ntile = moe_tables(F, l, PST, TE);
            pg8::Gemm g{XSOB, (const bf16*)(F.ws + WS_W1), MAXSLOT, NE * 1024, DM}; pg8::MoeOrder S{ntile * 4, F.G, F.vcu, (const PG8_LAS int*)TE};
            pg8::EpiSwiglu E{HB, RSS, DE};
            for (int rep = 0; rep < NREP(8); ++rep) pg8::gemm_phase<pg8::EpiSwiglu, pg8::MoeOrder, true, true>(F.lds, g, S, E); }
        SEAM(pb + 6);
        if (EN(8) && IN(pb + 7)) { PHASE_BEGIN(); LAS int* PST = (LAS int*)(F.lds + SCR_BYTES - 2048); LAS int* TE = PST + 64; const int ntile = moe_tables(F, l, PST, TE);
            pg8::Gemm g{HB, (const bf16*)(F.ws + WS_W2), MAXSLOT, NE * 1024, DE}; pg8::MoeOrder S{ntile * 4, F.G, F.vcu, (const PG8_LAS int*)TE};
            pg8::EpiGate E{XSOB, GTS, DM};
            for (int rep = 0; rep < NREP(9); ++rep) pg8::gemm_phase<pg8::EpiGate, pg8::MoeOrder, true, true>(F.lds, g, S, E); }
        SEAM(pb + 7);
        if (EN(9) && IN(pb + 8)) { PHASE_BEGIN(); combine_phase(F, l, F.out, TOKE, TOKR, XSOB, l + 1 < DEPTH, XBY, RS1); if (l + 1 < DEPTH) convert_weights(F, l + 1); }
        if (l + 1 < DEPTH) SEAM(pb + 8);
    }
#undef IN
#undef SEAM
}

extern "C" void kernel_launch(void* const* d_in, const int* in_sizes, int n_in, void* d_out, int out_size, void* d_ws, size_t ws_size, hipStream_t stream) {
    static int grid = 0;
    if (grid == 0) {
        if (n_in != 26 || in_sizes[0] != MTOK * DM || out_size != MTOK * DM || ws_size < WS_END) { fprintf(stderr, "kernel_launch: unexpected shapes (n_in %d, in0 %d, out %d, ws %zu < %zu); nothing launched\n", n_in, n_in > 0 ? in_sizes[0] : -1, out_size, ws_size, (size_t)WS_END); grid = -1; return; }
        int dev = 0, cus = 0, per_cu = 0;
        if (hipGetDevice(&dev) != hipSuccess || hipDeviceGetAttribute(&cus, hipDeviceAttributeMultiprocessorCount, dev) != hipSuccess) { grid = -1; return; }
        if (hipFuncSetAttribute((const void*)mk_fwd, hipFuncAttributeMaxDynamicSharedMemorySize, LDS_BYTES) != hipSuccess) { fprintf(stderr, "kernel_launch: hipFuncSetAttribute failed\n"); grid = -1; return; }
        if (hipOccupancyMaxActiveBlocksPerMultiprocessor(&per_cu, (const void*)mk_fwd, NTHR, LDS_BYTES) != hipSuccess || per_cu < 1) { fprintf(stderr, "kernel_launch: occupancy query reports %d blocks per CU; nothing launched\n", per_cu); (void)hipGetLastError(); grid = -1; return; }
        grid = cus;
    }
    if (grid < 0) return;
    if (hipMemsetAsync((char*)d_ws + WS_CTL, 0, CTL_ZERO_BYTES, stream) != hipSuccess) { fprintf(stderr, "kernel_launch: memset failed\n"); return; }
    Args a{};
    for (int i = 0; i < 26; ++i) a.in[i] = (const float*)d_in[i];
    a.out = (float*)d_out; a.ws = (unsigned char*)d_ws;
#if defined(MK_PER_PHASE) && MK_PER_PHASE
    for (int p = 0; p < N_PHASES; ++p) { a.ph_lo = p; a.ph_hi = p + 1; hipLaunchKernelGGL(mk_fwd, dim3(grid), dim3(NTHR), LDS_BYTES, stream, a); }
#else
    a.ph_lo = 0; a.ph_hi = N_PHASES; hipLaunchKernelGGL(mk_fwd, dim3(grid), dim3(NTHR), LDS_BYTES, stream, a);
#endif
    const hipError_t le = hipPeekAtLastError();
    if (le != hipSuccess) fprintf(stderr, "kernel_launch: launch failed: %s\n", hipGetErrorName(le));
}
```

```cpp
#include <hip/hip_runtime.h>
#include <cstdio>
#include <cstdint>
namespace pg8 {
#define PG8_LAS __attribute__((address_space(3)))
typedef unsigned short bf16_t;
typedef short bf16x8 __attribute__((ext_vector_type(8)));
typedef float f32x4 __attribute__((ext_vector_type(4)));
typedef unsigned u32x4 __attribute__((ext_vector_type(4)));
constexpr int BM = 256, BK = 64, HALF = 128, HTB = HALF * BK * 2  , STAGE_BYTES = 8 * HTB, NXCD = 8, WGM = 8;

__host__ __device__ __forceinline__ int lds_byte(int r, int c) { const int st = (r >> 4) * 2 + (c >> 5), rr = r & 15, cc = c & 31, ob = rr * 64 + cc * 2; return st * 1024 + (ob ^ (((ob >> 9) & 1) << 5)); }
__host__ __device__ __forceinline__ void stage_rc(int b, int& R, int& C) { const int st = b / 1024, sb = b % 1024, swz = sb ^ (((sb >> 9) & 1) << 5); R = (st >> 1) * 16 + swz / 64; C = (st & 1) * 32 + (swz % 64) / 2; }
__host__ __device__ __forceinline__ int perm32(int rho) { const int n = rho >> 4, i = rho & 15; return 8 * (i >> 2) + 4 * n + (i & 3); }

struct Unit { int pm, pn; };
struct Gemm { const bf16_t* A; const bf16_t* Bt; int M, N, K; };

struct StaticOrder {
    static constexpr bool GATHER = false;
    int nM, nN, nwg, G, c;
    __host__ __device__ void init(int M, int N, int G_, int c_) { nM = M / BM; nN = N / BM; nwg = nM * nN; G = G_; c = c_; }
    __host__ __device__ bool next(int i, Unit& u) const {
        const long L = (long)i * G + c; if (L >= nwg) return false;
        int wgid = (int)L; { const int q = nwg / NXCD, r = nwg % NXCD, xcd = wgid % NXCD, off = wgid / NXCD; wgid = (xcd < r ? xcd * (q + 1) : r * (q + 1) + (xcd - r) * q) + off; }
        const int nig = WGM * nN, gid = wgid / nig, fm = gid * WGM, gsz = (nM - fm) < WGM ? (nM - fm) : WGM;
        u.pm = fm + ((wgid % nig) % gsz); u.pn = (wgid % nig) / gsz; return true;
    }
    __device__ __forceinline__ void a_ready(const Unit&) const {}
    __device__ __forceinline__ void done(const Unit&) const {}
};
__device__ __forceinline__ unsigned cvt_pk_bf16(float lo, float hi) { unsigned r; asm volatile("v_cvt_pk_bf16_f32 %0, %1, %2" : "=v"(r) : "v"(lo), "v"(hi)); return r; }
typedef float f32x2 __attribute__((ext_vector_type(2)));
typedef float f32x2 __attribute__((ext_vector_type(2)));
typedef unsigned u32x2 __attribute__((ext_vector_type(2)));
struct EpiProj {
    static constexpr bool PERM = true, AFTER_DRAIN = false;
    bf16_t* P; const float* rs; const float* gq; const float* gk; int ldp; float qscale;
    __device__ __forceinline__ void operator()(const f32x4 (&acc)[2][2][4][2], const Unit& u, int wr, int wc, int fr, int fq) const {
        const int pn = u.pn; const bool headnorm = pn < 4;
        f32x4 g[2][2];
        if (headnorm) { const float* gp = (pn < 2) ? gq : gk; const float s = (pn < 2) ? qscale : 1.0f;
#pragma unroll
            for (int bj = 0; bj < 2; ++bj)
#pragma unroll
                for (int n = 0; n < 2; ++n) g[bj][n] = *(const f32x4*)(gp + 32 * bj + 8 * fq + 4 * n) * s; }
#pragma unroll
        for (int ai = 0; ai < 2; ++ai)
#pragma unroll
            for (int m = 0; m < 4; ++m) {
                asm volatile("" ::: "memory");
                const int row = u.pm * BM + ai * HALF + wr * 64 + m * 16 + fr; const float r = rs[row];
                f32x4 v[2][2];
#pragma unroll
                for (int bj = 0; bj < 2; ++bj)
#pragma unroll
                    for (int n = 0; n < 2; ++n) v[bj][n] = acc[ai][bj][m][n] * r;
                if (headnorm) { float ss = 0.f;
#pragma unroll
                    for (int bj = 0; bj < 2; ++bj)
#pragma unroll
                        for (int n = 0; n < 2; ++n) { const f32x4 x = v[bj][n]; ss += (x[0] * x[0] + x[1] * x[1]) + (x[2] * x[2] + x[3] * x[3]); }
                    ss += __shfl_xor(ss, 16); ss += __shfl_xor(ss, 32);
                    const float sc = __builtin_amdgcn_rsqf(ss * (1.0f / 64.0f) + 1e-6f);
#pragma unroll
                    for (int bj = 0; bj < 2; ++bj)
#pragma unroll
                        for (int n = 0; n < 2; ++n) v[bj][n] = v[bj][n] * g[bj][n] * sc; }
                bf16_t* rowp = P + (size_t)row * ldp + pn * BM + 64 * wc + 8 * fq;
#pragma unroll
                for (int bj = 0; bj < 2; ++bj) { u32x4 w; w.x = cvt_pk_bf16(v[bj][0][0], v[bj][0][1]); w.y = cvt_pk_bf16(v[bj][0][2], v[bj][0][3]); w.z = cvt_pk_bf16(v[bj][1][0], v[bj][1][1]); w.w = cvt_pk_bf16(v[bj][1][2], v[bj][1][3]);
                    *(u32x4*)(rowp + 32 * bj) = w; }
            }
    }
};
struct EpiResid {
    static constexpr bool PERM = true, AFTER_DRAIN = false;
    const bf16_t* base; bf16_t* out; int ldc;
    __device__ __forceinline__ void operator()(const f32x4 (&acc)[2][2][4][2], const Unit& u, int wr, int wc, int fr, int fq) const {
        const int col0 = u.pn * BM + wc * 32 + 8 * fq;
#pragma unroll
        for (int ai = 0; ai < 2; ++ai)
#pragma unroll
            for (int m = 0; m < 4; ++m) { const size_t off = (size_t)(u.pm * BM + ai * HALF + wr * 64 + m * 16 + fr) * ldc + col0;
                u32x4 b[2];
#pragma unroll
                for (int bj = 0; bj < 2; ++bj) b[bj] = *(const u32x4*)(base + off + bj * HALF);
#pragma unroll
                for (int bj = 0; bj < 2; ++bj) { const f32x4 v0 = acc[ai][bj][m][0], v1 = acc[ai][bj][m][1]; u32x4 w;
                    w.x = cvt_pk_bf16(v0[0] + __uint_as_float(b[bj].x << 16), v0[1] + __uint_as_float(b[bj].x & 0xffff0000u)); w.y = cvt_pk_bf16(v0[2] + __uint_as_float(b[bj].y << 16), v0[3] + __uint_as_float(b[bj].y & 0xffff0000u));
                    w.z = cvt_pk_bf16(v1[0] + __uint_as_float(b[bj].z << 16), v1[1] + __uint_as_float(b[bj].z & 0xffff0000u)); w.w = cvt_pk_bf16(v1[2] + __uint_as_float(b[bj].w << 16), v1[3] + __uint_as_float(b[bj].w & 0xffff0000u));
                    *(u32x4*)(out + off + bj * HALF) = w; }
                if (m & 1) asm volatile("" ::: "memory"); }
    }
};
struct MoeTabs { const PG8_LAS int* pst; const PG8_LAS int* cnt; const PG8_LAS int* tile_e; };
struct EpiSwiglu {
    static constexpr bool PERM = true, AFTER_DRAIN = false;
    bf16_t* H; const float* rsv; int ldh; MoeTabs tb;
    __device__ __forceinline__ void operator()(const f32x4 (&acc)[2][2][4][2], const Unit& u, int wr, int wc, int fr, int fq) const {
        const int col0 = (u.pn & 3) * 128 + 16 * wc + 4 * fq; const int ex = u.pn >> 2, br = u.pm * BM - tb.pst[ex], ce = tb.cnt[ex];
#pragma unroll
        for (int ai = 0; ai < 2; ++ai)
#pragma unroll
            for (int m = 0; m < 4; ++m) { const int rl = ai * HALF + wr * 64 + m * 16 + fr; const int row = u.pm * BM + rl; const int rank = br + rl; const float r = (rank < ce) ? rsv[ex * 32768 + rank] : 0.f;
#pragma unroll
                for (int bj = 0; bj < 2; ++bj) { const f32x4 g = acc[ai][bj][m][0] * r, up = acc[ai][bj][m][1] * r; float h[4];
#pragma unroll
                    for (int i = 0; i < 4; ++i) h[i] = g[i] * __builtin_amdgcn_rcpf(1.0f + __builtin_amdgcn_exp2f(-1.4426950408889634f * g[i])) * up[i];
                    u32x2 w; w.x = cvt_pk_bf16(h[0], h[1]); w.y = cvt_pk_bf16(h[2], h[3]);
                    *(u32x2*)(H + (size_t)row * ldh + col0 + 64 * bj) = w; } }
    }
};
struct EpiGate {
    static constexpr bool PERM = true, AFTER_DRAIN = false;
    bf16_t* O; const float* gtv; int ldo; MoeTabs tb;
    __device__ __forceinline__ void operator()(const f32x4 (&acc)[2][2][4][2], const Unit& u, int wr, int wc, int fr, int fq) const {
        const int col0 = (u.pn & 3) * BM + wc * 32 + 8 * fq; const int ex = u.pn >> 2, br = u.pm * BM - tb.pst[ex], ce = tb.cnt[ex];
#pragma unroll
        for (int ai = 0; ai < 2; ++ai)
#pragma unroll
            for (int m = 0; m < 4; ++m) { const int rl = ai * HALF + wr * 64 + m * 16 + fr; const int row = u.pm * BM + rl; const int rank = br + rl; const float gt = (rank < ce) ? gtv[ex * 32768 + rank] : 0.f;
#pragma unroll
                for (int bj = 0; bj < 2; ++bj) { const f32x4 v0 = acc[ai][bj][m][0] * gt, v1 = acc[ai][bj][m][1] * gt;
                    u32x4 w; w.x = cvt_pk_bf16(v0[0], v0[1]); w.y = cvt_pk_bf16(v0[2], v0[3]); w.z = cvt_pk_bf16(v1[0], v1[1]); w.w = cvt_pk_bf16(v1[2], v1[3]);
                    *(u32x4*)(O + (size_t)row * ldo + col0 + bj * HALF) = w; } }
    }
};
template <bool GATHER_> struct MoeOrder {
    static constexpr bool GATHER = GATHER_;
    int nunits, G, c; MoeTabs tb; const int* stv; int zrow;
    __device__ __forceinline__ bool next(int i, Unit& u) const { const int L = i * G + c; if (L >= nunits) return false; const int rt = L >> 2; u.pm = rt; u.pn = tb.tile_e[rt] * 4 + (L & 3); return true; }
    __device__ __forceinline__ void a_ready(const Unit&) const {}
    __device__ __forceinline__ void done(const Unit&) const {}
    __device__ __forceinline__ void rows(const Unit& u, const int (&R)[2], const unsigned (&C2)[2], unsigned (&v)[2][2], int K) const {
        const int ex = u.pn >> 2, br = u.pm * BM - tb.pst[ex], ce = tb.cnt[ex];
#pragma unroll
        for (int h = 0; h < 2; ++h)
#pragma unroll
            for (int i = 0; i < 2; ++i) { const int rank = br + HALF * h + R[i]; int tok = zrow; if (rank < ce) tok = stv[ex * 32768 + rank]; v[h][i] = (unsigned)tok * (unsigned)(K * 2) + C2[i]; }
    }
};
template <class Epi, class Sched, bool ALIGN_EPI = false, bool SP2 = false>
__device__ __forceinline__ void gemm_phase(PG8_LAS unsigned char* lds, const Gemm g, const Sched& S, const Epi& E) {
    int tid_ = threadIdx.x; asm volatile("" : "+v"(tid_));
    const int tid = tid_, wid = __builtin_amdgcn_readfirstlane(tid >> 6), lane = tid & 63, wr = wid >> 2, wc = wid & 3, fr = lane & 15, fq = lane >> 4;
    const int K = g.K, nt = K / BK;
    unsigned voffA[2], voffB[2];
    int gR[2]; unsigned gC2[2];
    unsigned vC[2][2], vN[2][2];
#pragma unroll
    for (int i = 0; i < 2; ++i) { int R, C; stage_rc(tid * 16 + i * 8192, R, C); const int Rb = Epi::PERM ? ((R & ~31) + perm32(R & 31)) : R;
        voffA[i] = (unsigned)(R * K + C) * 2u; voffB[i] = (unsigned)(Rb * K + C) * 2u; gR[i] = R; gC2[i] = (unsigned)C * 2u; }
    const size_t kstep = (size_t)(BK * 2);
    const size_t hstep = (size_t)HALF * K * 2;
    const size_t tstep = 2 * hstep;
    const unsigned ldsw = (unsigned)wid * 1024u;
    const int aoff = lds_byte(wr * 64 + fr, fq * 8), boff = lds_byte(wc * 32 + fr, fq * 8);
#define PG8_SA(b, h) (((b) * 2 + (h)) * HTB)
#define PG8_SB(b, h) ((4 + (b) * 2 + (h)) * HTB)
#define PG8_STAGE(bufoff, gbase, voff) do { _Pragma("unroll") for (int _i = 0; _i < 2; ++_i) \
        __builtin_amdgcn_global_load_lds((const unsigned*)((const char*)(gbase) + (voff)[_i]), (PG8_LAS unsigned*)(lds + (bufoff) + ldsw + _i * 8192), 16, 0, 0); } while (0)
#define PG8_STAGEA(bufoff, P, h, V) do { if constexpr (Sched::GATHER) { PG8_STAGE(bufoff, P, (V)[h]); } else { PG8_STAGE(bufoff, (P) + (h) * hstep, voffA); } } while (0)
#define PG8_LDA(dst, b, h) do { _Pragma("unroll") for (int m = 0; m < 4; ++m) _Pragma("unroll") for (int k = 0; k < 2; ++k) dst[m][k] = *(const PG8_LAS bf16x8*)(lds + PG8_SA(b, h) + aoff + m * 2048 + k * 1024); } while (0)
#define PG8_LDB(dst, b, h) do { _Pragma("unroll") for (int n = 0; n < 2; ++n) _Pragma("unroll") for (int k = 0; k < 2; ++k) dst[n][k] = *(const PG8_LAS bf16x8*)(lds + PG8_SB(b, h) + boff + n * 2048 + k * 1024); } while (0)
#define PG8_MMA(ai, bj, At, Bt) do { __builtin_amdgcn_s_setprio(1); _Pragma("unroll") for (int m = 0; m < 4; ++m) _Pragma("unroll") for (int n = 0; n < 2; ++n) _Pragma("unroll") for (int k = 0; k < 2; ++k) \
        acc[ai][bj][m][n] = __builtin_amdgcn_mfma_f32_16x16x32_bf16(Bt[n][k], At[m][k], acc[ai][bj][m][n], 0, 0, 0); __builtin_amdgcn_s_setprio(0); } while (0)
#define PG8_WAIT_V(n) asm volatile("s_waitcnt vmcnt(" #n ")" ::: "memory")
#define PG8_WAIT_L(n) asm volatile("s_waitcnt lgkmcnt(" #n ")" ::: "memory")
#define PG8_BAR __builtin_amdgcn_s_barrier()
#define PG8_SCHED __builtin_amdgcn_sched_barrier(0)
    Unit cur, nxt; int ui = 0;
    if (!S.next(0, cur)) return;
    f32x4 acc[2][2][4][2];
#pragma unroll
    for (int a = 0; a < 2; ++a)
#pragma unroll
        for (int b = 0; b < 2; ++b)
#pragma unroll
            for (int m = 0; m < 4; ++m)
#pragma unroll
                for (int n = 0; n < 2; ++n) acc[a][b][m][n] = (f32x4){0.f, 0.f, 0.f, 0.f};
    bf16x8 At[4][2], B0[2][2], B1[2][2];
    const char* cA = Sched::GATHER ? (const char*)g.A : (const char*)g.A + (size_t)cur.pm * tstep; const char* cB = (const char*)g.Bt + (size_t)cur.pn * tstep;
    S.a_ready(cur);
    if constexpr (Sched::GATHER) S.rows(cur, gR, gC2, vC, K);
    if constexpr (SP2) {
        PG8_STAGE(PG8_SB(0, 0), cB, voffB); PG8_STAGE(PG8_SB(0, 1), cB + hstep, voffB); PG8_STAGEA(PG8_SA(0, 0), cA, 0, vC); PG8_STAGEA(PG8_SA(0, 1), cA, 1, vC);
        if (wr == 1) PG8_BAR;
        PG8_WAIT_V(2); PG8_BAR;
        PG8_STAGE(PG8_SB(1, 0), cB + kstep, voffB); PG8_STAGEA(PG8_SA(1, 0), cA + kstep, 0, vC); PG8_STAGE(PG8_SB(1, 1), cB + hstep + kstep, voffB);
        PG8_WAIT_V(6); PG8_BAR;
    } else {
        PG8_STAGE(PG8_SB(0, 0), cB, voffB); PG8_STAGE(PG8_SA(0, 0), cA, voffA); PG8_STAGE(PG8_SB(0, 1), cB + hstep, voffB); PG8_STAGE(PG8_SA(0, 1), cA + hstep, voffA);
        if (wr == 1) PG8_BAR;
        PG8_WAIT_V(4); PG8_BAR;
        PG8_STAGE(PG8_SB(1, 0), cB + kstep, voffB); PG8_STAGE(PG8_SA(1, 0), cA + kstep, voffA); PG8_STAGE(PG8_SB(1, 1), cB + hstep + kstep, voffB);
        PG8_WAIT_V(6); PG8_BAR;
    }
    for (;;) {
        const bool has_next = S.next(ui + 1, nxt);
        const char* nA = (has_next && !Sched::GATHER) ? (const char*)g.A + (size_t)nxt.pm * tstep : cA; const char* nB = has_next ? (const char*)g.Bt + (size_t)nxt.pn * tstep : cB;
        for (int t = 0; t < nt; t += 2) {
            const bool last = (t == nt - 2);
            const char* a1 = cA + (size_t)(t + 1) * kstep;
            const char* a2 = last ? nA : cA + (size_t)(t + 2) * kstep; const char* b2 = last ? nB : cB + (size_t)(t + 2) * kstep;
            const char* a3 = a2 + kstep; const char* b3 = b2 + kstep;
            if (last && has_next) { S.a_ready(nxt); if constexpr (Sched::GATHER) S.rows(nxt, gR, gC2, vN, K); }
            unsigned v2[2][2];
            if constexpr (Sched::GATHER) { const bool usen = last && has_next;
#pragma unroll
                for (int h_ = 0; h_ < 2; ++h_)
#pragma unroll
                    for (int i_ = 0; i_ < 2; ++i_) v2[h_][i_] = usen ? vN[h_][i_] : vC[h_][i_]; }
            if constexpr (SP2) {
            PG8_LDB(B0, 0, 0); PG8_LDB(B1, 0, 1); PG8_SCHED; PG8_LDA(At, 0, 0); PG8_STAGEA(PG8_SA(1, 1), a1, 1, vC);
            PG8_WAIT_V(8); PG8_WAIT_L(0); PG8_BAR; PG8_MMA(0, 0, At, B0); PG8_MMA(0, 1, At, B1); PG8_BAR; PG8_SCHED;
            PG8_LDA(At, 0, 1); PG8_STAGE(PG8_SB(0, 0), b2, voffB); PG8_STAGE(PG8_SB(0, 1), b2 + hstep, voffB); PG8_STAGEA(PG8_SA(0, 0), a2, 0, v2);
            PG8_WAIT_V(8); PG8_WAIT_L(0); PG8_BAR; PG8_MMA(1, 0, At, B0); PG8_MMA(1, 1, At, B1); PG8_BAR; PG8_SCHED;
            PG8_LDB(B0, 1, 0); PG8_LDB(B1, 1, 1); PG8_SCHED; PG8_LDA(At, 1, 0); PG8_STAGEA(PG8_SA(0, 1), a2, 1, v2);
            PG8_WAIT_V(8); PG8_WAIT_L(0); PG8_BAR; PG8_MMA(0, 0, At, B0); PG8_MMA(0, 1, At, B1); PG8_BAR; PG8_SCHED;
            PG8_LDA(At, 1, 1); PG8_STAGE(PG8_SB(1, 0), b3, voffB); PG8_STAGE(PG8_SB(1, 1), b3 + hstep, voffB); PG8_STAGEA(PG8_SA(1, 0), a3, 0, v2);
            PG8_WAIT_V(8); PG8_WAIT_L(0); PG8_BAR; PG8_MMA(1, 0, At, B0); PG8_MMA(1, 1, At, B1); PG8_BAR; PG8_SCHED;
            } else {
            static_assert(SP2 || !Sched::GATHER, "gather mode: SP2 loop only");
            PG8_LDB(B0, 0, 0); PG8_SCHED; PG8_LDA(At, 0, 0); PG8_STAGE(PG8_SA(1, 1), a1 + hstep, voffA);
            PG8_WAIT_L(8); PG8_BAR; PG8_WAIT_L(0); PG8_MMA(0, 0, At, B0); PG8_BAR; PG8_SCHED;
            PG8_LDB(B1, 0, 1); PG8_STAGE(PG8_SB(0, 0), b2, voffB);
            PG8_BAR; PG8_WAIT_L(0); PG8_MMA(0, 1, At, B1); PG8_BAR;
            PG8_LDA(At, 0, 1); PG8_STAGE(PG8_SA(0, 0), a2, voffA);
            PG8_BAR; PG8_WAIT_L(0); PG8_MMA(1, 0, At, B0); PG8_BAR; PG8_SCHED;
            PG8_STAGE(PG8_SB(0, 1), b2 + hstep, voffB);
            PG8_WAIT_V(6); PG8_BAR; PG8_MMA(1, 1, At, B1); PG8_BAR;
            PG8_LDB(B0, 1, 0); PG8_SCHED; PG8_LDA(At, 1, 0); PG8_STAGE(PG8_SA(0, 1), a2 + hstep, voffA);
            PG8_WAIT_L(8); PG8_BAR; PG8_WAIT_L(0); PG8_MMA(0, 0, At, B0); PG8_BAR; PG8_SCHED;
            PG8_LDB(B1, 1, 1); PG8_STAGE(PG8_SB(1, 0), b3, voffB);
            PG8_BAR; PG8_WAIT_L(0); PG8_MMA(0, 1, At, B1); PG8_BAR;
            PG8_LDA(At, 1, 1); PG8_STAGE(PG8_SA(1, 0), a3, voffA);
            PG8_BAR; PG8_WAIT_L(0); PG8_MMA(1, 0, At, B0); PG8_BAR; PG8_SCHED;
            PG8_STAGE(PG8_SB(1, 1), b3 + hstep, voffB);
            PG8_WAIT_V(6); PG8_BAR; PG8_MMA(1, 1, At, B1); PG8_BAR;
            }
        }
        if constexpr (ALIGN_EPI) { if (wr == 0) PG8_BAR; }
        if constexpr (!Epi::AFTER_DRAIN) { E(acc, cur, wr, wc, fr, fq); S.done(cur); }
        if (!has_next) break;
#pragma unroll
        for (int a = 0; a < 2; ++a)
#pragma unroll
            for (int b = 0; b < 2; ++b)
#pragma unroll
                for (int m = 0; m < 4; ++m)
#pragma unroll
                    for (int n = 0; n < 2; ++n) acc[a][b][m][n] = (f32x4){0.f, 0.f, 0.f, 0.f};
        cur = nxt; cA = nA; cB = nB; ++ui;
        if constexpr (Sched::GATHER) {
#pragma unroll
            for (int h_ = 0; h_ < 2; ++h_)
#pragma unroll
                for (int i_ = 0; i_ < 2; ++i_) vC[h_][i_] = vN[h_][i_]; }
        if constexpr (ALIGN_EPI) { if (wr == 1) PG8_BAR; }
    }
    PG8_WAIT_V(0);
    if constexpr (!ALIGN_EPI) { if (wr == 0) PG8_BAR; }
    PG8_BAR;
    if constexpr (Epi::AFTER_DRAIN) { E.fused(acc, cur, wr, wc, fr, fq, lds, wid, lane); S.done(cur); }
#undef PG8_SA
#undef PG8_SB
#undef PG8_STAGE
#undef PG8_STAGEA
#undef PG8_LDA
#undef PG8_LDB
#undef PG8_MMA
#undef PG8_WAIT_V
#undef PG8_WAIT_L
#undef PG8_BAR
#undef PG8_SCHED
}
}
#define GAS __attribute__((address_space(1)))
#define LAS __attribute__((address_space(3)))
typedef unsigned short bf16;
typedef unsigned v4u __attribute__((ext_vector_type(4)));
typedef float f32x4 __attribute__((ext_vector_type(4)));
typedef short bf16x8 __attribute__((ext_vector_type(8)));
typedef GAS unsigned gu32;
typedef GAS unsigned long long gu64;
#define RLX_AGENT __ATOMIC_RELAXED, __HIP_MEMORY_SCOPE_AGENT
#define LDS_WAIT() asm volatile("s_waitcnt lgkmcnt(0)" ::: "memory")
#define VM_WAIT() asm volatile("s_waitcnt vmcnt(0)" ::: "memory")
__device__ __forceinline__ unsigned long long rt() { return __builtin_amdgcn_s_memrealtime(); }
__device__ __forceinline__ unsigned f2bf(float f) { unsigned u = __builtin_bit_cast(unsigned, f); return (u + 0x7fffu + ((u >> 16) & 1u)) >> 16; }
__device__ __forceinline__ unsigned pk2(float lo, float hi) { return f2bf(lo) | (f2bf(hi) << 16); }

#define XB_TMO      128
#define XB_XCNT(j)  (256  + 64 * (j))
#define XB_XSUB(j)  (1280 + 64 * (j))
#define XB_XGEN(j)  (2304 + 64 * (j))
#define XB_TOP      3328
#define XB_TOPGEN   3392
#define XCD_BAR_WORDS 3456
#define XB_SPIN_CAP (1u << 18)

__device__ __forceinline__ unsigned xb_ld(unsigned* p)              { return __hip_atomic_load(p, __ATOMIC_RELAXED, __HIP_MEMORY_SCOPE_AGENT); }
__device__ __forceinline__ unsigned xb_add(unsigned* p, unsigned v) { return __hip_atomic_fetch_add(p, v, __ATOMIC_RELAXED, __HIP_MEMORY_SCOPE_AGENT); }
__device__ __forceinline__ unsigned xb_xcc_id() { return (unsigned)__builtin_amdgcn_s_getreg((3 << 11) | 20) & 0xFu; }
#define XB_SPIN(cond, bar) do { unsigned _sp = 0; while (cond) { __builtin_amdgcn_s_sleep(1); \
    if ((++_sp & 255u) == 0u) { if (xb_ld(&(bar)[XB_TMO])) break; if (_sp > XB_SPIN_CAP) { atomicAdd(&(bar)[XB_TMO], 1u); break; } } } } while (0)

struct XcdBarrier {
    unsigned* bar; unsigned x;
    volatile LAS unsigned* st;
};

__device__ __forceinline__ XcdBarrier xcd_barrier_post(unsigned* bar, volatile LAS unsigned* st) {
    XcdBarrier b; b.bar = bar; b.x = xb_xcc_id(); b.st = st;
    if (threadIdx.x == 0) (void)xb_add(&bar[XB_XCNT(b.x)], 1u);
    return b;
}
__device__ __forceinline__ void xcd_barrier_complete(unsigned* bar, unsigned x, unsigned& nloc, unsigned& nx) {
    const unsigned G = gridDim.x * gridDim.y * gridDim.z;
    unsigned sum, cnt, mine, sp = 0u;
    for (;;) {
        sum = 0u; cnt = 0u; mine = 0u;
#pragma unroll
        for (unsigned j = 0; j < 16; ++j) { const unsigned c = xb_ld(&bar[XB_XCNT(j)]); sum += c; cnt += (c > 0u) ? 1u : 0u; mine = (j == x) ? c : mine; }
        if (sum == G) break;
        __builtin_amdgcn_s_sleep(1);
        if ((++sp & 255u) == 0u) { if (xb_ld(&bar[XB_TMO])) break; if (sp > XB_SPIN_CAP) { atomicAdd(&bar[XB_TMO], 1u); break; } }
    }
    nloc = mine > 0u ? mine : 1u; nx = cnt > 0u ? cnt : 1u;
}

__device__ __forceinline__ void xcd_barrier(const XcdBarrier& b) {
    asm volatile("s_waitcnt vmcnt(0)" ::: "memory");
    __syncthreads();
    if (threadIdx.x == 0) {
        unsigned* bar = b.bar;
        __builtin_amdgcn_s_waitcnt(0);
        unsigned nloc = b.st[0], nx = b.st[1];
        if (nloc == 0u) { xcd_barrier_complete(bar, b.x, nloc, nx); b.st[0] = nloc; b.st[1] = nx; }
        const unsigned old = xb_add(&bar[XB_XSUB(b.x)], 1u);
        const unsigned gen = old / nloc;
        if (old + 1u == (gen + 1u) * nloc) {
            __builtin_amdgcn_fence(__ATOMIC_RELEASE, "agent");
            asm volatile("s_waitcnt vmcnt(0)" ::: "memory");
            const unsigned og = xb_add(&bar[XB_TOP], 1u);
            const unsigned tg = og / nx;
            if (og + 1u == (tg + 1u) * nx) xb_add(&bar[XB_TOPGEN], 1u);
            else XB_SPIN(xb_ld(&bar[XB_TOPGEN]) == tg, bar);
            __builtin_amdgcn_fence(__ATOMIC_ACQUIRE, "agent");
            xb_add(&bar[XB_XGEN(b.x)], 1u);
            asm volatile("s_waitcnt vmcnt(0)" ::: "memory");
        } else {
            XB_SPIN(xb_ld(&bar[XB_XGEN(b.x)]) == gen, bar);
            __builtin_amdgcn_fence(__ATOMIC_ACQUIRE, "agent");
            asm volatile("s_waitcnt vmcnt(0)" ::: "memory");
        }
    }
    __syncthreads();
}

constexpr int NB = 4, SEQ = 8192, DM = 1024, MTOK = NB * SEQ, DEPTH = 2;
constexpr int DIN = 2560, NH = 8, HD = 64, DLRU = 256, DCONF = 256, NE = 32, DE = 512;
constexpr int COL_Q = 0, COL_K = 512, COL_V = 1024, COL_XR = 1536, COL_XG = 1792, COL_XC = 2048;
constexpr int NRT = 36, NRTP = 48;
constexpr int MAXSLOT = 73728;
constexpr float EPSN = 1e-6f;
constexpr float LOG2E = 1.4426950408889634f;
constexpr float QSCALE = 0.125f * LOG2E;
constexpr float EXIT_THR2 = 120.0f * LOG2E;

constexpr size_t MiB = 1u << 20;
constexpr size_t WS_CTL = 0, CTL_ZERO_BYTES = 1 * MiB;
constexpr size_t WS_WIN = 1 * MiB;
constexpr size_t WS_WOUT = 6 * MiB;
constexpr size_t WS_W1 = 8 * MiB;
constexpr size_t WS_W2 = 72 * MiB;
constexpr size_t WS_PW = 104 * MiB;
constexpr size_t WS_LRUW = WS_PW + 128 * 1024;
constexpr size_t WS_WR = WS_PW + 256 * 1024;
constexpr size_t WS_RS1 = 105 * MiB;
constexpr size_t WS_RS2 = WS_RS1 + 128 * 1024;
constexpr size_t WS_TOKE = WS_RS2 + 128 * 1024;
constexpr size_t WS_TOKR = WS_TOKE + 256 * 1024;
constexpr size_t WS_SUMM = 107 * MiB;
constexpr size_t WS_X0 = 109 * MiB;
constexpr size_t WS_X1 = 174 * MiB;
constexpr size_t WS_PROJ = 239 * MiB;
constexpr size_t WS_HP = 399 * MiB;
constexpr size_t WS_STV = 471 * MiB;
constexpr size_t WS_RSV = 475 * MiB;
constexpr size_t WS_GTV = 479 * MiB;
constexpr size_t WS_END = 483 * MiB;
constexpr int CW_TMO = 0, CW_BAR = 4096, CW_CNT = 8192;

constexpr int SCR_BYTES = 143360;
constexpr int LDSCTL_OFF = SCR_BYTES;
constexpr int LDS_BYTES = 147456;
constexpr int NWAVES = 8, NTHR = 512;

typedef float f32x16 __attribute__((ext_vector_type(16)));
typedef short s16x4 __attribute__((ext_vector_type(4)));
typedef unsigned u32x2 __attribute__((ext_vector_type(2)));
typedef float f32x2 __attribute__((ext_vector_type(2)));
typedef __bf16 bf16x2_t __attribute__((ext_vector_type(2)));

__device__ __forceinline__ unsigned cvtpk(float lo, float hi) { f32x2 v = {lo, hi}; bf16x2_t b = __builtin_convertvector(v, bf16x2_t); return __builtin_bit_cast(unsigned, b); }
__device__ __forceinline__ float bflo(unsigned w) { return __uint_as_float(w << 16); }
__device__ __forceinline__ float bfhi(unsigned w) { return __uint_as_float(w & 0xffff0000u); }
__device__ __forceinline__ float fexp2(float x) { return __builtin_amdgcn_exp2f(x); }
__device__ __forceinline__ float flog2(float x) { return __builtin_amdgcn_logf(x); }
__device__ __forceinline__ float frcp(float x) { return __builtin_amdgcn_rcpf(x); }
__device__ __forceinline__ float sigmoidf_(float x) { return frcp(1.0f + fexp2(-LOG2E * x)); }
__device__ __forceinline__ float wave_sum(float v) {
#pragma unroll
    for (int o = 1; o < 64; o <<= 1) v += __shfl_xor(v, o);
    return v;
}
#define WG_SYNC() __syncthreads()
__device__ __forceinline__ int opq(int x) { asm volatile("" : "+v"(x)); return x; }

struct Frame {
    LAS unsigned char* lds;
    gu32* ctl;
    int tid, lane, wave, vcu, G;
    const float* const* in;
    float* out; unsigned char* ws;
};

__device__ __forceinline__ int dest_row(int n, int mode) {
    if (mode == 1) { const int t = n & ~255, c = n & 255; return t + 128 * ((c >> 5) & 1) + 32 * (c >> 6) + (c & 31); }
    if (mode == 2) return 8 * (n >> 2) + (n & 3);
    if (mode == 3) return 8 * (n >> 2) + 4 + (n & 3);
    return n;
}
__device__ __forceinline__ void transpose_item(const float* W, int ldn, int k0, int n0, const float* gain, bf16* WT, int ldk, int mode, LAS float* scr  , int lane) {
    float v[64]; const float* p = W + (size_t)k0 * ldn + n0 + lane;
#pragma unroll
    for (int i = 0; i < 64; ++i) { v[i] = *(const GAS float*)p; p += ldn; }
    if (gain) {
#pragma unroll
        for (int i = 0; i < 64; ++i) v[i] *= gain[k0 + i]; }
#pragma unroll
    for (int i = 0; i < 64; ++i) scr[i * 65 + lane] = v[i];
    LDS_WAIT(); asm volatile("" ::: "memory");
    const int c = lane & 7;
#pragma unroll
    for (int j = 0; j < 8; ++j) { const int n = (lane >> 3) + 8 * j; const LAS float* s = scr + (8 * c) * 65 + n;
        v4u o; o.x = cvtpk(s[0 * 65], s[1 * 65]); o.y = cvtpk(s[2 * 65], s[3 * 65]); o.z = cvtpk(s[4 * 65], s[5 * 65]); o.w = cvtpk(s[6 * 65], s[7 * 65]);
        *(GAS v4u*)(WT + (size_t)dest_row(n0 + n, mode) * ldk + k0 + 8 * c) = o; }
    LDS_WAIT(); asm volatile("" ::: "memory");
}
__device__ __forceinline__ void convert_weights(Frame& F, int l) {
    LAS float* scr = (LAS float*)(F.lds + F.wave * 16640);
    const int gw = F.vcu * NWAVES + F.wave, NGW = F.G * NWAVES;
    constexpr int I_IN = (DM / 64) * (DIN / 64), I_OUT = (DM / 64) * (DM / 64), I_GU = NE * (DM / 64) * (DE / 64), I_D = NE * (DE / 64) * (DM / 64);
    constexpr int I_PW = (DCONF / 64) * (DCONF / 64), I_LW = 8;
    constexpr int NITEMS = I_IN + I_OUT + 2 * I_GU + I_D + I_PW + I_LW;
    for (int it = gw; it < NITEMS; it += NGW) {
        int r = it;
        if (r < 2 * I_GU) { const int up = r >= I_GU; if (up) r -= I_GU; const int e = r / 128, q = r % 128, kb = q / 8, nb = q % 8; const float* src = F.in[up ? 24 : 23] + (size_t)l * NE * DM * DE + (size_t)e * DM * DE;
            transpose_item(src, DE, 64 * kb, 64 * nb, F.in[20] + l * DM, (bf16*)(F.ws + WS_W1) + (size_t)e * 1024 * 1024, DM, up ? 3 : 2, scr, F.lane); continue; } r -= 2 * I_GU;
        if (r < I_D) { const int e = r / 128, q = r % 128, kb = q / 16, nb = q % 16; transpose_item(F.in[25] + (size_t)l * NE * DE * DM + (size_t)e * DE * DM, DM, 64 * kb, 64 * nb, nullptr, (bf16*)(F.ws + WS_W2) + (size_t)e * 1024 * 512, DE, 0, scr, F.lane); continue; } r -= I_D;
        if (r < I_IN) { const int kb = r / (DIN / 64), nb = r % (DIN / 64); transpose_item(F.in[2] + (size_t)l * DM * DIN, DIN, 64 * kb, 64 * nb, F.in[1] + l * DM, (bf16*)(F.ws + WS_WIN), DM, 1, scr, F.lane); continue; } r -= I_IN;
        if (r < I_OUT) { const int kb = r / 16, nb = r % 16; transpose_item(F.in[19] + (size_t)l * DM * DM, DM, 64 * kb, 64 * nb, F.in[18] + l * DM, (bf16*)(F.ws + WS_WOUT), DM, 0, scr, F.lane); continue; } r -= I_OUT;
        if (r < I_PW) { const int kb = r / 4, nb = r % 4; transpose_item(F.in[16] + (size_t)l * DCONF * DCONF, DCONF, 64 * kb, 64 * nb, nullptr, (bf16*)(F.ws + WS_PW), DCONF, 0, scr, F.lane); continue; } r -= I_PW;
        { const int mat = r; const float* src = F.in[mat < 4 ? 7 : 9] + (size_t)l * 4 * 64 * 64 + (size_t)(mat & 3) * 64 * 64; transpose_item(src, 64, 0, 0, nullptr, (bf16*)(F.ws + WS_LRUW) + (size_t)mat * 64 * 64, 64, 0, scr, F.lane); }
    }
    const float* g2 = F.in[20] + l * DM; const float* rc = F.in[21] + (size_t)l * DM * 4; const float* rf = F.in[22] + (size_t)l * DM * NE; float* WR = (float*)(F.ws + WS_WR);
    for (int idx = (F.vcu * NTHR + F.tid); idx < NRTP * DM; idx += F.G * NTHR) { const int n = idx / DM, k = idx % DM;
        float v = 0.f; if (n < 4) v = rc[k * 4 + n] * g2[k]; else if (n < NRT) v = rf[k * NE + (n - 4)] * g2[k]; WR[idx] = v; }
    LDS_WAIT(); WG_SYNC();
}
__device__ __forceinline__ void x_to_bf16_rows(Frame& F, const float* x, bf16* XB, float* RS1) {
    const int gw = F.vcu * NWAVES + F.wave, NGW = F.G * NWAVES;
    for (int m = 2 * gw; m < MTOK; m += 2 * NGW) {
        f32x4 v[2][4]; float s[2] = {0.f, 0.f};
#pragma unroll
        for (int q = 0; q < 2; ++q) { const GAS f32x4* xr = (const GAS f32x4*)(x + (size_t)(m + q) * DM) + F.lane;
#pragma unroll
            for (int j = 0; j < 4; ++j) v[q][j] = xr[64 * j]; }
#pragma unroll
        for (int q = 0; q < 2; ++q) {
#pragma unroll
            for (int j = 0; j < 4; ++j) s[q] += (v[q][j].x * v[q][j].x + v[q][j].y * v[q][j].y) + (v[q][j].z * v[q][j].z + v[q][j].w * v[q][j].w);
            s[q] = wave_sum(s[q]);
            GAS u32x2* o8 = (GAS u32x2*)(XB + (size_t)(m + q) * DM) + F.lane;
#pragma unroll
            for (int j = 0; j < 4; ++j) { u32x2 w; w.x = cvtpk(v[q][j].x, v[q][j].y); w.y = cvtpk(v[q][j].z, v[q][j].w); o8[64 * j] = w; }
            if (F.lane == 0) RS1[m + q] = __builtin_amdgcn_rsqf(s[q] * (1.0f / DM) + EPSN); }
    }
}

namespace att {
constexpr int SLOT16 = 16384, NSLOT = 5, L_OST = NSLOT * SLOT16, L_FLAG = L_OST + NWAVES * 4096;
__device__ __forceinline__ int crow(int r, int hi) { return (r & 3) + 8 * (r >> 2) + 4 * hi; }
typedef const LAS unsigned char* lptr;
template <bool DIAG> __device__ __forceinline__ void tile(lptr kslot, int vb, const bf16x8 (&qr)[4], f32x16 (&o)[2], float& R, int kbase, int qpos, int r32, int hi) {
    f32x16 p0 = f32x16{}, p1 = f32x16{};
    { lptr kb = kslot + hi * 1024 + r32 * 16;
#pragma unroll
      for (int d0 = 0; d0 < 4; ++d0) { const bf16x8 b0 = *(const LAS bf16x8*)(kb + d0 * 2048), b1 = *(const LAS bf16x8*)(kb + d0 * 2048 + 512);
          p0 = __builtin_amdgcn_mfma_f32_32x32x16_bf16(b0, qr[d0], p0, 0, 0, 0); p1 = __builtin_amdgcn_mfma_f32_32x32x16_bf16(b1, qr[d0], p1, 0, 0, 0); } }
    f32x16 K0, K1;
#pragma unroll
    for (int r = 0; r < 16; ++r) {
        const int kk = kbase + (r & 3) + 8 * (r >> 2);
        { const float x = __builtin_amdgcn_fmed3f(p0[r], -100.f, 100.f); const float e = fexp2(-x); float bt = frcp(1.0f + e); float kp = e * bt; if (DIAG && !(kk < qpos)) { kp = 1.f; bt = 0.f; } K0[r] = kp; p0[r] = bt; }
        { const float x = __builtin_amdgcn_fmed3f(p1[r], -100.f, 100.f); const float e = fexp2(-x); float bt = frcp(1.0f + e); float kp = e * bt; if (DIAG && !(kk + 32 < qpos)) { kp = 1.f; bt = 0.f; } K1[r] = kp; p1[r] = bt; }
    }
    float Gs[2][4], T[2][4];
#pragma unroll
    for (int bq = 0; bq < 4; ++bq) {
        const float g0 = (K0[4 * bq] * K0[4 * bq + 1]) * (K0[4 * bq + 2] * K0[4 * bq + 3]), g1 = (K1[4 * bq] * K1[4 * bq + 1]) * (K1[4 * bq + 2] * K1[4 * bq + 3]);
        auto r0 = __builtin_amdgcn_permlane32_swap(__float_as_uint(g0), __float_as_uint(g0), false, false);
        auto r1 = __builtin_amdgcn_permlane32_swap(__float_as_uint(g1), __float_as_uint(g1), false, false);
        Gs[0][bq] = hi ? 1.0f : __uint_as_float(r0[1]); T[0][bq] = __uint_as_float(r0[0]) * __uint_as_float(r0[1]);
        Gs[1][bq] = hi ? 1.0f : __uint_as_float(r1[1]); T[1][bq] = __uint_as_float(r1[0]) * __uint_as_float(r1[1]);
    }
    float cum = fexp2(R), tt0 = 1.0f, tt1 = 1.0f;
#pragma unroll
    for (int a = 1; a >= 0; --a)
#pragma unroll
        for (int bq = 3; bq >= 0; --bq) {
            const float s3 = cum * Gs[a][bq];
            if (a == 1) { const float s2 = s3 * K1[4 * bq + 3], s1 = s2 * K1[4 * bq + 2], s0 = s1 * K1[4 * bq + 1];
                p1[4 * bq + 3] *= s3; p1[4 * bq + 2] *= s2; p1[4 * bq + 1] *= s1; p1[4 * bq] *= s0; }
            else { const float s2 = s3 * K0[4 * bq + 3], s1 = s2 * K0[4 * bq + 2], s0 = s1 * K0[4 * bq + 1];
                p0[4 * bq + 3] *= s3; p0[4 * bq + 2] *= s2; p0[4 * bq + 1] *= s1; p0[4 * bq] *= s0; }
            cum *= T[a][bq]; if (a == 1) tt1 *= T[a][bq]; else tt0 *= T[a][bq];
        }
    R += flog2(tt1) + flog2(tt0);
    v4u pw0, pw1, pw2, pw3;
    pw0.x = cvtpk(p0[0], p0[1]); pw0.y = cvtpk(p0[2], p0[3]); pw0.z = cvtpk(p0[4], p0[5]); pw0.w = cvtpk(p0[6], p0[7]);
    pw1.x = cvtpk(p0[8], p0[9]); pw1.y = cvtpk(p0[10], p0[11]); pw1.z = cvtpk(p0[12], p0[13]); pw1.w = cvtpk(p0[14], p0[15]);
    pw2.x = cvtpk(p1[0], p1[1]); pw2.y = cvtpk(p1[2], p1[3]); pw2.z = cvtpk(p1[4], p1[5]); pw2.w = cvtpk(p1[6], p1[7]);
    pw3.x = cvtpk(p1[8], p1[9]); pw3.y = cvtpk(p1[10], p1[11]); pw3.z = cvtpk(p1[12], p1[13]); pw3.w = cvtpk(p1[14], p1[15]);
#pragma unroll
    for (int d0 = 0; d0 < 2; ++d0) { s16x4 lo[4], hh[4];
#pragma unroll
        for (int ks = 0; ks < 4; ++ks) {
            asm volatile("ds_read_b64_tr_b16 %0,%1 offset:%c2" : "=&v"(lo[ks]) : "v"(vb), "i"(d0 * 4096 + ks * 1024) : "memory");
            asm volatile("ds_read_b64_tr_b16 %0,%1 offset:%c2" : "=&v"(hh[ks]) : "v"(vb), "i"(d0 * 4096 + ks * 1024 + 512) : "memory"); }
        asm volatile("s_waitcnt lgkmcnt(0)" ::: "memory"); __builtin_amdgcn_sched_barrier(0);
#define ATT_PK(k) (bf16x8){lo[k][0], lo[k][1], lo[k][2], lo[k][3], hh[k][0], hh[k][1], hh[k][2], hh[k][3]}
        o[d0] = __builtin_amdgcn_mfma_f32_32x32x16_bf16(__builtin_bit_cast(bf16x8, pw0), ATT_PK(0), o[d0], 0, 0, 0);
        o[d0] = __builtin_amdgcn_mfma_f32_32x32x16_bf16(__builtin_bit_cast(bf16x8, pw1), ATT_PK(1), o[d0], 0, 0, 0);
        o[d0] = __builtin_amdgcn_mfma_f32_32x32x16_bf16(__builtin_bit_cast(bf16x8, pw2), ATT_PK(2), o[d0], 0, 0, 0);
        o[d0] = __builtin_amdgcn_mfma_f32_32x32x16_bf16(__builtin_bit_cast(bf16x8, pw3), ATT_PK(3), o[d0], 0, 0, 0);
#undef ATT_PK
    }
}
__device__ __forceinline__ void unit(Frame& F, int b, int h, int qb, const bf16* PROJ, bf16* Y) {
    const int lane = (opq((int)threadIdx.x) & 63), r32 = lane & 31, hi = lane >> 5, wid = F.wave;
    LAS unsigned char* shm = F.lds;
    const long rowbase = (long)b * SEQ; const int q0 = qb * 256;
    const bf16* Qw = PROJ + (rowbase + q0 + wid * 32) * DIN + COL_Q + h * HD;
    const bf16* Kh = PROJ + rowbase * DIN + COL_K + h * HD; const bf16* Vh = PROJ + rowbase * DIN + COL_V + h * HD;
    bf16x8 qr[4];
#pragma unroll
    for (int d0 = 0; d0 < 4; ++d0) qr[d0] = *(const GAS bf16x8*)(Qw + (long)r32 * DIN + d0 * 16 + hi * 8);
    f32x16 o[2]; o[0] = f32x16{}; o[1] = f32x16{};
    float R = 0.f;
    const int Dt = 4 * qb + (wid >> 1);
    const int qpos = q0 + wid * 32 + r32;
    bool wave_done = false;
    const bf16* ksrc = Kh + (long)lane * DIN + wid * 8;
    const bf16* vsrc = Vh + (long)(16 * (wid & 3) + (lane >> 2)) * DIN + (wid >> 2) * 32 + (lane & 3) * 8;
    LAS unsigned char* kdst = shm + wid * 1024 + lane * 16; LAS unsigned char* vdst = shm + 8192 + wid * 1024 + lane * 16;
    const int vb0 = (int)(uintptr_t)(shm + 8192) + ((lane >> 4) & 1) * 32 + (lane & 3) * 8 + (4 * hi + ((lane & 15) >> 2)) * 64;
    volatile LAS int* flag = (volatile LAS int*)(shm + L_FLAG);
    { v4u kr[4], vr[4];
#pragma unroll
      for (int p = 0; p < 4; ++p) { kr[p] = *(const GAS v4u*)(ksrc + (long)(4 * qb + p) * 64 * DIN); vr[p] = *(const GAS v4u*)(vsrc + (long)(4 * qb + p) * 64 * DIN); }
#pragma unroll
      for (int p = 0; p < 4; ++p) { const int sl = (4 * qb + p) % NSLOT; *(LAS v4u*)(kdst + sl * SLOT16) = kr[p]; *(LAS v4u*)(vdst + sl * SLOT16) = vr[p]; } }
    LDS_WAIT(); WG_SYNC();
    v4u kreg, vreg;
    for (int j = 0;; ++j) {
        const int tn = 4 * qb - j - 1;
        if (tn >= 0) { kreg = *(const GAS v4u*)(ksrc + (long)tn * 64 * DIN); vreg = *(const GAS v4u*)(vsrc + (long)tn * 64 * DIN); }
        const int t = Dt - j; const int s = (t >= 0) ? (t % NSLOT) : 0;
        if (t >= 0 && !wave_done) {
            if (j == 0) tile<true>(shm + s * SLOT16, vb0 + s * SLOT16, qr, o, R, t * 64 + 4 * hi, qpos, r32, hi);
            else tile<false>(shm + s * SLOT16, vb0 + s * SLOT16, qr, o, R, t * 64 + 4 * hi, qpos, r32, hi);
            wave_done = __all(R < -EXIT_THR2);
        }
        if (t <= 0) wave_done = true;
        if (lane == 0) flag[(j & 1) * 8 + wid] = wave_done ? 1 : 0;
        if (tn >= 0) { const int sl = tn % NSLOT; *(LAS v4u*)(kdst + sl * SLOT16) = kreg; *(LAS v4u*)(vdst + sl * SLOT16) = vreg; }
        LDS_WAIT(); WG_SYNC();
        int alld = 1;
#pragma unroll
        for (int w = 0; w < 8; ++w) alld &= flag[(j & 1) * 8 + w];
        if (alld) break;
    }
    { LAS bf16* stg = (LAS bf16*)(shm + L_OST) + wid * 2048;
#pragma unroll
      for (int r = 0; r < 16; ++r) { const int orow = crow(r, hi);
#pragma unroll
          for (int d0 = 0; d0 < 2; ++d0) stg[orow * 64 + d0 * 32 + r32] = (bf16)(cvtpk(o[d0][r], 0.f) & 0xffffu); }
      LDS_WAIT(); asm volatile("" ::: "memory");
      bf16* Ow = Y + (rowbase + q0 + wid * 32) * DM + h * HD;
#pragma unroll
      for (int i = 0; i < 4; ++i) { const int row = i * 8 + (lane >> 3), ch = lane & 7; const v4u v = *(const LAS v4u*)(stg + row * 64 + ch * 8); *(GAS v4u*)(Ow + (long)row * DM + ch * 8) = v; } }
    LDS_WAIT(); WG_SYNC();
}
}

namespace conf {
constexpr int TM = 64, HALO = 30, UROWS = TM + HALO;
constexpr int L_U = 0  , L_Z = 49152  , L_S = 0  , ZS = 260, SS = 264;
__device__ __forceinline__ void unit(Frame& F, int ut, int l, const bf16* PROJ, bf16* Y) {
    const int tid = opq((int)threadIdx.x), lane = tid & 63, wid = F.wave;
    const int row0 = ut * TM; const int t0 = row0 % SEQ;
    LAS bf16* U = (LAS bf16*)(F.lds + L_U); LAS float* Z = (LAS float*)(F.lds + L_Z); LAS bf16* S = (LAS bf16*)(F.lds + L_S);
    const float* dw_w = F.in[12] + (size_t)l * 31 * DCONF; const float* dw_b = F.in[13] + l * DCONF; const float* ln_g = F.in[14] + l * DCONF; const float* ln_b = F.in[15] + l * DCONF;
    const float* pw_b = F.in[17] + l * DCONF; const bf16* PW = (const bf16*)(F.ws + WS_PW);
    for (int task = tid; task < UROWS * 32; task += NTHR) { const int ur = task >> 5, c8 = task & 31; const int t = t0 - HALO + ur; v4u o = {0u, 0u, 0u, 0u};
        if (t >= 0) { const bf16* pr = PROJ + (size_t)(row0 - HALO + ur) * DIN + COL_XC + c8 * 8; const v4u a = *(const GAS v4u*)pr, g = *(const GAS v4u*)(pr + 256);
            unsigned av[4] = {a.x, a.y, a.z, a.w}, gv[4] = {g.x, g.y, g.z, g.w}, ov[4];
#pragma unroll
            for (int j = 0; j < 4; ++j) ov[j] = cvtpk(bflo(av[j]) * sigmoidf_(bflo(gv[j])), bfhi(av[j]) * sigmoidf_(bfhi(gv[j])));
            o.x = ov[0]; o.y = ov[1]; o.z = ov[2]; o.w = ov[3]; }
        *(LAS v4u*)(U + ur * 256 + c8 * 8) = o; }
    LDS_WAIT(); WG_SYNC();
    { const int c = tid & 255, hf = tid >> 8; float w[31];
#pragma unroll
      for (int j = 0; j < 31; ++j) w[j] = dw_w[j * DCONF + c];
      const float bias = dw_b[c]; float acc[32];
#pragma unroll
      for (int i = 0; i < 32; ++i) acc[i] = bias;
      const LAS bf16* up = U + (hf * 32) * 256 + c;
#pragma unroll
      for (int rho = 0; rho < 62; ++rho) { const float x = __uint_as_float((unsigned)up[rho * 256] << 16);
#pragma unroll
          for (int i = 0; i < 32; ++i) { const int j = rho - i; if (j >= 0 && j <= 30) acc[i] += w[j] * x; } }
#pragma unroll
      for (int i = 0; i < 32; ++i) Z[(hf * 32 + i) * ZS + c] = acc[i]; }
    LDS_WAIT(); WG_SYNC();
    { const f32x4 g = *(const GAS f32x4*)(ln_g + 4 * lane), bb = *(const GAS f32x4*)(ln_b + 4 * lane);
      for (int i = 0; i < 8; ++i) { const int tk = wid * 8 + i; f32x4 v = *(const LAS f32x4*)(Z + tk * ZS + 4 * lane);
          const float mean = wave_sum((v.x + v.y) + (v.z + v.w)) * (1.0f / 256.0f); v = v - mean;
          const float var = wave_sum((v.x * v.x + v.y * v.y) + (v.z * v.z + v.w * v.w)) * (1.0f / 256.0f); const float rstd = __builtin_amdgcn_rsqf(var + EPSN);
          f32x4 y = v * rstd * g + bb; y.x *= sigmoidf_(y.x); y.y *= sigmoidf_(y.y); y.z *= sigmoidf_(y.z); y.w *= sigmoidf_(y.w);
          u32x2 w2; w2.x = cvtpk(y.x, y.y); w2.y = cvtpk(y.z, y.w); *(LAS u32x2*)(S + tk * SS + 4 * lane) = w2; } }
    LDS_WAIT(); WG_SYNC();
    { const int fr = lane & 15, fq = lane >> 4; f32x4 acc[4][2];
#pragma unroll
      for (int m = 0; m < 4; ++m) { acc[m][0] = (f32x4){0.f, 0.f, 0.f, 0.f}; acc[m][1] = (f32x4){0.f, 0.f, 0.f, 0.f}; }
#pragma unroll 2
      for (int ks = 0; ks < 8; ++ks) { bf16x8 bfr[2], afr[4];
#pragma unroll
          for (int n = 0; n < 2; ++n) bfr[n] = *(const GAS bf16x8*)(PW + (size_t)(32 * wid + 16 * n + fr) * DCONF + 32 * ks + 8 * fq);
#pragma unroll
          for (int m = 0; m < 4; ++m) afr[m] = *(const LAS bf16x8*)(S + (16 * m + fr) * SS + 32 * ks + 8 * fq);
#pragma unroll
          for (int m = 0; m < 4; ++m)
#pragma unroll
              for (int n = 0; n < 2; ++n) acc[m][n] = __builtin_amdgcn_mfma_f32_16x16x32_bf16(afr[m], bfr[n], acc[m][n], 0, 0, 0); }
#pragma unroll
      for (int m = 0; m < 4; ++m)
#pragma unroll
          for (int n = 0; n < 2; ++n)
#pragma unroll
              for (int i = 0; i < 4; ++i) Z[(16 * m + 4 * fq + i) * ZS + 32 * wid + 16 * n + fr] = acc[m][n][i]; }
    LDS_WAIT(); WG_SYNC();
    { const f32x4 pb = *(const GAS f32x4*)(pw_b + 4 * lane);
      for (int i = 0; i < 8; ++i) { const int tk = wid * 8 + i; f32x4 v = *(const LAS f32x4*)(Z + tk * ZS + 4 * lane) + pb;
          const float ss = wave_sum((v.x * v.x + v.y * v.y) + (v.z * v.z + v.w * v.w)); const float rs = __builtin_amdgcn_rsqf(ss * (1.0f / 256.0f) + EPSN); v = v * rs;
          u32x2 w2; w2.x = cvtpk(v.x, v.y); w2.y = cvtpk(v.z, v.w); *(GAS u32x2*)(Y + (size_t)(row0 + tk) * DM + 768 + 4 * lane) = w2; } }
    LDS_WAIT(); WG_SYNC();
}
}

namespace lru {
constexpr int TM = 64, XS_ = 260, XBS = 264;
constexpr int L_XC = 0  , L_A = 66560  , L_XB = 66560  ;
__device__ __forceinline__ void unit(Frame& F, int ut, int l, const bf16* PROJ, bf16* HL, bf16* PL, float* SUMM) {
    const int tid = opq((int)threadIdx.x), lane = tid & 63, wid = F.wave;
    const int row0 = ut * TM; const int t0 = row0 % SEQ;
    LAS float* XC = (LAS float*)(F.lds + L_XC); LAS float* A = (LAS float*)(F.lds + L_A); LAS bf16* XB = (LAS bf16*)(F.lds + L_XB);
    const float* cw = F.in[5] + (size_t)l * 4 * DLRU; const float* cb = F.in[6] + l * DLRU; const float* ba = F.in[8] + l * DLRU; const float* bx = F.in[10] + l * DLRU; const float* lam = F.in[11] + l * DLRU;
    const bf16* LW = (const bf16*)(F.ws + WS_LRUW);
    for (int task = tid; task < TM * 32; task += NTHR) { const int tk = task >> 5, c8 = task & 31; float acc[8];
        { const f32x4 b0 = *(const GAS f32x4*)(cb + c8 * 8), b1 = *(const GAS f32x4*)(cb + c8 * 8 + 4); acc[0] = b0.x; acc[1] = b0.y; acc[2] = b0.z; acc[3] = b0.w; acc[4] = b1.x; acc[5] = b1.y; acc[6] = b1.z; acc[7] = b1.w; }
#pragma unroll
        for (int j = 0; j < 4; ++j) { const int t = t0 + tk - 3 + j; if (t >= 0) { const v4u a = *(const GAS v4u*)(PROJ + (size_t)(row0 + tk - 3 + j) * DIN + COL_XR + c8 * 8);
                const f32x4 w0 = *(const GAS f32x4*)(cw + j * DLRU + c8 * 8), w1 = *(const GAS f32x4*)(cw + j * DLRU + c8 * 8 + 4);
                acc[0] += w0.x * bflo(a.x); acc[1] += w0.y * bfhi(a.x); acc[2] += w0.z * bflo(a.y); acc[3] += w0.w * bfhi(a.y);
                acc[4] += w1.x * bflo(a.z); acc[5] += w1.y * bfhi(a.z); acc[6] += w1.z * bflo(a.w); acc[7] += w1.w * bfhi(a.w); } }
        *(LAS f32x4*)(XC + tk * XS_ + c8 * 8) = (f32x4){acc[0], acc[1], acc[2], acc[3]}; *(LAS f32x4*)(XC + tk * XS_ + c8 * 8 + 4) = (f32x4){acc[4], acc[5], acc[6], acc[7]};
        v4u o; o.x = cvtpk(acc[0], acc[1]); o.y = cvtpk(acc[2], acc[3]); o.z = cvtpk(acc[4], acc[5]); o.w = cvtpk(acc[6], acc[7]); *(LAS v4u*)(XB + tk * XBS + c8 * 8) = o; }
    LDS_WAIT(); WG_SYNC();
    const int nb = wid >> 1, mh = wid & 1, fr = lane & 15, fq = lane >> 4;
    f32x4 ar[2][4], ai[2][4];
#pragma unroll
    for (int m = 0; m < 2; ++m)
#pragma unroll
        for (int n = 0; n < 4; ++n) { ar[m][n] = (f32x4){0.f, 0.f, 0.f, 0.f}; ai[m][n] = (f32x4){0.f, 0.f, 0.f, 0.f}; }
#pragma unroll
    for (int ks = 0; ks < 2; ++ks) { bf16x8 af[2];
#pragma unroll
        for (int m = 0; m < 2; ++m) af[m] = *(const LAS bf16x8*)(XB + (32 * mh + 16 * m + fr) * XBS + 64 * nb + 32 * ks + 8 * fq);
#pragma unroll
        for (int n = 0; n < 4; ++n) { const bf16x8 bA = *(const GAS bf16x8*)(LW + (size_t)nb * 4096 + (16 * n + fr) * 64 + 32 * ks + 8 * fq), bX = *(const GAS bf16x8*)(LW + (size_t)(4 + nb) * 4096 + (16 * n + fr) * 64 + 32 * ks + 8 * fq);
#pragma unroll
            for (int m = 0; m < 2; ++m) { ar[m][n] = __builtin_amdgcn_mfma_f32_16x16x32_bf16(af[m], bA, ar[m][n], 0, 0, 0); ai[m][n] = __builtin_amdgcn_mfma_f32_16x16x32_bf16(af[m], bX, ai[m][n], 0, 0, 0); } } }
    LDS_WAIT(); WG_SYNC();
#pragma unroll
    for (int n = 0; n < 4; ++n) { const int ch = 64 * nb + 16 * n + fr; const float lsl8 = -8.0f * log1pf(__expf(-lam[ch])), bav = ba[ch], bxv = bx[ch];
#pragma unroll
        for (int m = 0; m < 2; ++m)
#pragma unroll
            for (int i = 0; i < 4; ++i) { const int tk = 32 * mh + 16 * m + 4 * fq + i; const float gr = ar[m][n][i] + bav, gi = ai[m][n][i] + bxv; const float xcv = XC[tk * XS_ + ch];
                const float la = lsl8 * sigmoidf_(gr); const float a = fexp2(LOG2E * la); const float mult = __builtin_sqrtf(__builtin_fmaxf(1.0f - a * a, 0.f));
                A[tk * XS_ + ch] = a; XC[tk * XS_ + ch] = mult * sigmoidf_(gi) * xcv; } }
    LDS_WAIT(); WG_SYNC();
    if (tid < 256) { const int c = tid; float h = 0.f, p = 1.f; bf16* hl = HL + (size_t)row0 * DLRU + c; bf16* pl = PL + (size_t)row0 * DLRU + c;
#pragma unroll 8
        for (int tk = 0; tk < TM; ++tk) { const float a = A[tk * XS_ + c], u = XC[tk * XS_ + c]; p *= a; h = a * h + u; hl[(size_t)tk * DLRU] = (bf16)(cvtpk(h, 0.f) & 0xffffu); pl[(size_t)tk * DLRU] = (bf16)(cvtpk(p, 0.f) & 0xffffu); }
        SUMM[(size_t)ut * 512 + c] = p; SUMM[(size_t)ut * 512 + 256 + c] = h; }
    LDS_WAIT(); WG_SYNC();
}
}

__device__ __forceinline__ void fixup_unit(Frame& F, int ut, const bf16* PROJ, const bf16* HL, const bf16* PL, const float* SUMM, bf16* Y) {
    const int tid = opq((int)threadIdx.x), lane = tid & 63, wid = F.wave; const int row0 = ut * 64; const int cb = (row0 % SEQ) / 64, ub0 = ut - cb;
    LAS float* CAR = (LAS float*)F.lds;
    { const int c = tid & 255, hf = tid >> 8; const int mid = cb >> 1; const int j0 = hf ? mid : 0, j1 = hf ? cb : mid; float P = 1.f, H = 0.f;
#pragma unroll 16
      for (int j = j0; j < j1; ++j) { const float p = SUMM[(size_t)(ub0 + j) * 512 + c], h = SUMM[(size_t)(ub0 + j) * 512 + 256 + c]; H = p * H + h; P = p * P; }
      CAR[hf * 512 + c] = P; CAR[hf * 512 + 256 + c] = H; }
    LDS_WAIT(); WG_SYNC();
    f32x4 car;
    { const f32x4 h0 = *(const LAS f32x4*)(CAR + 256 + 4 * lane), p1 = *(const LAS f32x4*)(CAR + 512 + 4 * lane), h1 = *(const LAS f32x4*)(CAR + 768 + 4 * lane); car = p1 * h0 + h1; }
#pragma unroll 4
    for (int i = 0; i < 8; ++i) { const size_t row = (size_t)row0 + wid * 8 + i;
        const u32x2 hl = *(const GAS u32x2*)(HL + row * DLRU + 4 * lane), pl = *(const GAS u32x2*)(PL + row * DLRU + 4 * lane);
        const u32x2 xg = *(const GAS u32x2*)(PROJ + row * DIN + COL_XG + 4 * lane); const v4u ya = *(const GAS v4u*)(Y + row * DM + 8 * lane);
        const float hv[4] = {bflo(hl.x) + bflo(pl.x) * car.x, bfhi(hl.x) + bfhi(pl.x) * car.y, bflo(hl.y) + bflo(pl.y) * car.z, bfhi(hl.y) + bfhi(pl.y) * car.w};
        const float xv[4] = {bflo(xg.x), bfhi(xg.x), bflo(xg.y), bfhi(xg.y)}; float y[4];
#pragma unroll
        for (int j = 0; j < 4; ++j) { const float x = xv[j]; const float u2 = 1.5957691216057308f * (x + 0.044715f * x * x * x); y[j] = hv[j] * x * sigmoidf_(u2); }
        const float ssb = wave_sum((y[0] * y[0] + y[1] * y[1]) + (y[2] * y[2] + y[3] * y[3])); const float rsb = __builtin_amdgcn_rsqf(ssb * (1.0f / 256.0f) + EPSN);
        u32x2 w2; w2.x = cvtpk(y[0] * rsb, y[1] * rsb); w2.y = cvtpk(y[2] * rsb, y[3] * rsb); *(GAS u32x2*)(Y + row * DM + 512 + 4 * lane) = w2;
        float a[8] = {bflo(ya.x), bfhi(ya.x), bflo(ya.y), bfhi(ya.y), bflo(ya.z), bfhi(ya.z), bflo(ya.w), bfhi(ya.w)}; float ssa = 0.f;
#pragma unroll
        for (int j = 0; j < 8; ++j) ssa += a[j] * a[j];
        ssa = wave_sum(ssa); const float rsa = __builtin_amdgcn_rsqf(ssa * (1.0f / 512.0f) + EPSN);
        v4u oa; oa.x = cvtpk(a[0] * rsa, a[1] * rsa); oa.y = cvtpk(a[2] * rsa, a[3] * rsa); oa.z = cvtpk(a[4] * rsa, a[5] * rsa); oa.w = cvtpk(a[6] * rsa, a[7] * rsa);
        *(GAS v4u*)(Y + row * DM + 8 * lane) = oa; }
    LDS_WAIT(); WG_SYNC();
}

__device__ __forceinline__ void router_unit(Frame& F, int ut, int l, const bf16* X, float* RS2, int* TOKE, int* TOKR, int* STV, float* RSV, float* GTV) {
    const int tid = opq((int)threadIdx.x), lane = tid & 63, wid = F.wave, fr = lane & 15, fq = lane >> 4;
    const float* WR = (const float*)(F.ws + WS_WR);
    LAS float* LG = (LAS float*)F.lds + wid * (16 * NRTP + 16);
    LAS int* CNT = (LAS int*)(F.lds + 32768); LAS int* BASE = CNT + 32;
    if (tid < 32) CNT[tid] = 0;
    const int r0 = ut * 128 + wid * 16;
    f32x4 acc[3]; acc[0] = (f32x4){0.f, 0.f, 0.f, 0.f}; acc[1] = acc[0]; acc[2] = acc[0]; float ss = 0.f;
    const bf16* xp = X + (size_t)(r0 + fr) * DM + 4 * fq; const float* wp = WR + (size_t)fr * DM + 4 * fq;
#pragma unroll 4
    for (int s = 0; s < DM / 16; ++s) { const u32x2 aw = *(const GAS u32x2*)(xp + 16 * s); const f32x4 a = {bflo(aw.x), bfhi(aw.x), bflo(aw.y), bfhi(aw.y)}; ss += (a.x * a.x + a.y * a.y) + (a.z * a.z + a.w * a.w);
#pragma unroll
        for (int n = 0; n < 3; ++n) { const f32x4 b = *(const GAS f32x4*)(wp + (size_t)16 * n * DM + 16 * s);
            acc[n] = __builtin_amdgcn_mfma_f32_16x16x4f32(a.x, b.x, acc[n], 0, 0, 0); acc[n] = __builtin_amdgcn_mfma_f32_16x16x4f32(a.y, b.y, acc[n], 0, 0, 0);
            acc[n] = __builtin_amdgcn_mfma_f32_16x16x4f32(a.z, b.z, acc[n], 0, 0, 0); acc[n] = __builtin_amdgcn_mfma_f32_16x16x4f32(a.w, b.w, acc[n], 0, 0, 0); } }
    ss += __shfl_xor(ss, 16); ss += __shfl_xor(ss, 32);
    const float rs = __builtin_amdgcn_rsqf(ss * (1.0f / DM) + EPSN);
    if (fq == 0) LG[16 * NRTP + fr] = rs;
#pragma unroll
    for (int n = 0; n < 3; ++n)
#pragma unroll
        for (int i = 0; i < 4; ++i) LG[(4 * fq + i) * NRTP + 16 * n + fr] = acc[n][i];
    LDS_WAIT(); WG_SYNC();
    int e0 = 0, e1 = 0, lr0 = 0, lr1 = 0; float g0 = 0.f, g1 = 0.f, rsv = 0.f;
    if (lane < 16) { const LAS float* lg = LG + lane * NRTP; rsv = LG[16 * NRTP + lane];
        float c[4]; int grp = 0; float cm;
#pragma unroll
        for (int j = 0; j < 4; ++j) c[j] = lg[j] * rsv;
        cm = c[0];
#pragma unroll
        for (int j = 1; j < 4; ++j) if (c[j] > cm) { cm = c[j]; grp = j; }
        float den = 0.f;
#pragma unroll
        for (int j = 0; j < 4; ++j) den += __expf(c[j] - cm);
        const float wgrp = 1.0f / den;
        float v0 = -INFINITY, v1 = -INFINITY; int i0 = 0, i1 = 0;
#pragma unroll
        for (int j = 0; j < 8; ++j) { const float v = lg[4 + grp * 8 + j] * rsv; if (v > v0) { v1 = v0; i1 = i0; v0 = v; i0 = j; } else if (v > v1) { v1 = v; i1 = j; } }
        const float ex = __expf(v1 - v0); g0 = wgrp / (1.0f + ex); g1 = wgrp * ex / (1.0f + ex);
        e0 = grp * 8 + i0; e1 = grp * 8 + i1;
        lr0 = atomicAdd((int*)(CNT + e0), 1); lr1 = atomicAdd((int*)(CNT + e1), 1); }
    LDS_WAIT(); WG_SYNC();
    if (tid < 32) { const int c = CNT[tid]; int bse = 0; if (c > 0) bse = (int)__hip_atomic_fetch_add((unsigned*)(F.ctl + CW_CNT + 64 * l + tid), (unsigned)c, __ATOMIC_RELAXED, __HIP_MEMORY_SCOPE_AGENT); BASE[tid] = bse; }
    LDS_WAIT(); WG_SYNC();
    if (lane < 16) { const int tok = r0 + lane; const int k0 = BASE[e0] + lr0, k1 = BASE[e1] + lr1; RS2[tok] = rsv; TOKE[2 * tok] = e0; TOKE[2 * tok + 1] = e1; TOKR[2 * tok] = k0; TOKR[2 * tok + 1] = k1;
        STV[e0 * 32768 + k0] = tok; RSV[e0 * 32768 + k0] = rsv; GTV[e0 * 32768 + k0] = g0; STV[e1 * 32768 + k1] = tok; RSV[e1 * 32768 + k1] = rsv; GTV[e1 * 32768 + k1] = g1; }
    LDS_WAIT(); WG_SYNC();
}
__device__ __forceinline__ int moe_tables(Frame& F, int l, LAS int* PST, LAS int* CNT, LAS int* TE) {
    if (F.tid == 0) { int acc = 0; for (int e = 0; e < NE; ++e) { const int c = (int)__hip_atomic_load(F.ctl + CW_CNT + 64 * l + e, __ATOMIC_RELAXED, __HIP_MEMORY_SCOPE_AGENT); PST[e] = acc; CNT[e] = c; acc += (c + 255) & ~255; } PST[NE] = acc; }
    LDS_WAIT(); WG_SYNC();
    const int ntile = PST[NE] >> 8;
    for (int rt = F.tid; rt < ntile; rt += NTHR) { int e = 0;
        for (int j = 1; j < NE; ++j) if ((PST[j] >> 8) <= rt) e = j;
        TE[rt] = e; }
    LDS_WAIT(); WG_SYNC();
    return ntile;
}
__device__ __forceinline__ void combine_phase(Frame& F, int l, const bf16* X1, const int* TOKE, const int* TOKR, const bf16* OB, bool last_layer, bf16* X0, float* RS1, float* OUT) {
    LAS int* PST = (LAS int*)F.lds; LAS int* CNT = PST + 64; LAS int* TE = PST + 128;
    (void)moe_tables(F, l, PST, CNT, TE);
    const int gw = F.vcu * NWAVES + F.wave, NGW = F.G * NWAVES;
    for (int m = 2 * gw; m < MTOK; m += 2 * NGW) {
        u32x2 xv[2][4], oa[2][4], ob[2][4];
#pragma unroll
        for (int q = 0; q < 2; ++q) { const int mm = m + q; const int s0 = PST[TOKE[2 * mm]] + TOKR[2 * mm], s1 = PST[TOKE[2 * mm + 1]] + TOKR[2 * mm + 1];
            const GAS u32x2* xr = (const GAS u32x2*)(X1 + (size_t)mm * DM) + F.lane;
            const GAS u32x2* o0 = (const GAS u32x2*)(OB + (size_t)s0 * DM) + F.lane; const GAS u32x2* o1 = (const GAS u32x2*)(OB + (size_t)s1 * DM) + F.lane;
#pragma unroll
            for (int j = 0; j < 4; ++j) { xv[q][j] = xr[64 * j]; oa[q][j] = o0[64 * j]; ob[q][j] = o1[64 * j]; } }
#pragma unroll
        for (int q = 0; q < 2; ++q) { const int mm = m + q; float ss = 0.f; f32x4 v[4];
#pragma unroll
            for (int j = 0; j < 4; ++j) { const u32x2 x = xv[q][j], a = oa[q][j], b = ob[q][j];
                v[j].x = bflo(x.x) + (bflo(a.x) + bflo(b.x)); v[j].y = bfhi(x.x) + (bfhi(a.x) + bfhi(b.x)); v[j].z = bflo(x.y) + (bflo(a.y) + bflo(b.y)); v[j].w = bfhi(x.y) + (bfhi(a.y) + bfhi(b.y));
                ss += (v[j].x * v[j].x + v[j].y * v[j].y) + (v[j].z * v[j].z + v[j].w * v[j].w); }
            if (last_layer) { GAS f32x4* xw = (GAS f32x4*)(OUT + (size_t)mm * DM) + F.lane;
#pragma unroll
                for (int j = 0; j < 4; ++j) xw[64 * j] = v[j]; }
            else { ss = wave_sum(ss); GAS u32x2* o8 = (GAS u32x2*)(X0 + (size_t)mm * DM) + F.lane;
#pragma unroll
                for (int j = 0; j < 4; ++j) { u32x2 w; w.x = cvtpk(v[j].x, v[j].y); w.y = cvtpk(v[j].z, v[j].w); o8[64 * j] = w; }
                if (F.lane == 0) RS1[mm] = __builtin_amdgcn_rsqf(ss * (1.0f / DM) + EPSN); } }
    }
    LDS_WAIT(); WG_SYNC();
}

constexpr int PH_PER_LAYER = 8, N_PHASES = 1 + DEPTH * PH_PER_LAYER;
struct Args { const float* in[26]; float* out; unsigned char* ws; int ph_lo, ph_hi; };
__global__ void __launch_bounds__(NTHR, 2) mk_fwd(Args args) {
    extern __shared__ __attribute__((aligned(16))) unsigned char lds[];
    Frame F;
    F.lds = (LAS unsigned char*)lds;
    F.tid = threadIdx.x; F.lane = F.tid & 63; F.wave = __builtin_amdgcn_readfirstlane(F.tid >> 6);
    F.G = gridDim.x; { const int bx = blockIdx.x; F.vcu = (F.G % 8 == 0) ? (bx % 8) * (F.G / 8) + bx / 8 : bx; }
    F.in = args.in;
    F.out = args.out; F.ws = args.ws; F.ctl = (gu32*)(args.ws + WS_CTL);
    for (int u = F.tid; u < (LDS_BYTES - LDSCTL_OFF) / 4; u += NTHR) ((LAS unsigned*)(F.lds + LDSCTL_OFF))[u] = 0u;
    __syncthreads();
    const bool one_launch = (args.ph_hi - args.ph_lo) > 1;
    XcdBarrier bar; bar.bar = (unsigned*)(F.ctl + CW_BAR); bar.x = 0; bar.st = nullptr;
    if (one_launch) bar = xcd_barrier_post((unsigned*)(F.ctl + CW_BAR), (volatile LAS unsigned*)(F.lds + LDSCTL_OFF + 32));
    const int lo = args.ph_lo, hi = args.ph_hi;
#ifndef PH_MASK
#define PH_MASK 0x1fff
#endif
#define IN(k) (lo <= (k) && (k) < hi)
#define EN(j) (((PH_MASK) >> (j)) & 1)
#ifndef DBL_MASK
#define DBL_MASK 0
#endif
#define NREP(j) ((((DBL_MASK) >> (j)) & 1) ? 2 : 1)
#define PHASE_BEGIN() do { F.tid = opq((int)threadIdx.x); F.lane = F.tid & 63; F.wave = __builtin_amdgcn_readfirstlane(F.tid >> 6); { int v_ = F.vcu; asm volatile("" : "+s"(v_)); F.vcu = v_; } } while (0)
#define SEAM(k) do { if (IN(k) && IN((k) + 1)) xcd_barrier(bar); } while (0)
#define X0 ((bf16*)(F.ws + WS_X0))
#define X1 ((bf16*)(F.ws + WS_X1))
#define YB ((bf16*)F.out)
#define PROJ ((bf16*)(F.ws + WS_PROJ))
#define OB ((bf16*)(F.ws + WS_PROJ))
#define HB ((bf16*)(F.ws + WS_HP))
#define HL ((bf16*)(F.ws + WS_HP))
#define PL ((bf16*)(F.ws + WS_HP) + (size_t)MTOK * DLRU)
#define SUMM ((float*)(F.ws + WS_SUMM))
#define RS1 ((float*)(F.ws + WS_RS1))
#define RS2 ((float*)(F.ws + WS_RS2))
#define TOKE ((int*)(F.ws + WS_TOKE))
#define TOKR ((int*)(F.ws + WS_TOKR))
#define STV ((int*)(F.ws + WS_STV))
#define RSV ((float*)(F.ws + WS_RSV))
#define GTV ((float*)(F.ws + WS_GTV))
#define MOE_TABS() LAS int* PST = (LAS int*)(F.lds + SCR_BYTES - 2048); LAS int* CNTL = PST + 64; LAS int* TE = PST + 128; const int ntile = moe_tables(F, l, PST, CNTL, TE); \
    const pg8::MoeTabs tb{(const PG8_LAS int*)PST, (const PG8_LAS int*)CNTL, (const PG8_LAS int*)TE}

    if (EN(0) && IN(0)) { PHASE_BEGIN(); for (int rep = 0; rep < NREP(0); ++rep) { convert_weights(F, 0); x_to_bf16_rows(F, F.in[0], X0, RS1); }
        if (blockIdx.x == 0) { GAS unsigned* z = (GAS unsigned*)(X1 + (size_t)MTOK * DM); for (int i = F.tid; i < DM / 2; i += NTHR) z[i] = 0u; } }
    SEAM(0);
#pragma unroll 1
    for (int l = 0; l < DEPTH; ++l) {
        const int pb = 1 + l * PH_PER_LAYER;
        if (EN(1) && IN(pb + 0)) { PHASE_BEGIN(); pg8::Gemm g{X0, (const bf16*)(F.ws + WS_WIN), MTOK, DIN, DM}; pg8::StaticOrder S; S.init(MTOK, DIN, F.G, (int)blockIdx.x);
            pg8::EpiProj E{PROJ, RS1, F.in[3] + l * HD, F.in[4] + l * HD, DIN, QSCALE};
            for (int rep = 0; rep < NREP(1); ++rep) pg8::gemm_phase<pg8::EpiProj, pg8::StaticOrder, true, true>(F.lds, g, S, E); }
        SEAM(pb + 0);
        if (EN(2) && IN(pb + 1)) { PHASE_BEGIN();
            if (EN(10)) for (int rep = 0; rep < NREP(2); ++rep) for (int a = F.vcu; a < NB * NH * (SEQ / 256); a += F.G) { const int qb = a & 31, bh = a >> 5; att::unit(F, bh >> 3, bh & 7, qb, PROJ, YB); }
            if (EN(11)) for (int rep = 0; rep < NREP(3); ++rep) for (int u = F.vcu; u < MTOK / 64; u += F.G) conf::unit(F, u, l, PROJ, YB);
            if (EN(12)) for (int rep = 0; rep < NREP(4); ++rep) for (int u = F.vcu; u < MTOK / 64; u += F.G) lru::unit(F, u, l, PROJ, HL, PL, SUMM);
        }
        SEAM(pb + 1);
        if (EN(3) && IN(pb + 2)) { PHASE_BEGIN(); for (int rep = 0; rep < NREP(5); ++rep) for (int u = F.vcu; u < MTOK / 64; u += F.G) fixup_unit(F, u, PROJ, HL, PL, SUMM, YB); }
        SEAM(pb + 2);
        if (EN(4) && IN(pb + 3)) { PHASE_BEGIN(); pg8::Gemm g{YB, (const bf16*)(F.ws + WS_WOUT), MTOK, DM, DM}; pg8::StaticOrder S; S.init(MTOK, DM, F.G, (int)blockIdx.x);
            pg8::EpiResid E{X0, X1, DM};
            for (int rep = 0; rep < NREP(6); ++rep) pg8::gemm_phase<pg8::EpiResid, pg8::StaticOrder, true, true>(F.lds, g, S, E); }
        SEAM(pb + 3);
        if (EN(5) && IN(pb + 4)) { PHASE_BEGIN(); for (int u = F.vcu; u < MTOK / 128; u += F.G) router_unit(F, u, l, X1, RS2, TOKE, TOKR, STV, RSV, GTV); }
        SEAM(pb + 4);
        if (EN(7) && IN(pb + 5)) { PHASE_BEGIN(); MOE_TABS();
            pg8::Gemm g{X1, (const bf16*)(F.ws + WS_W1), MAXSLOT, NE * 1024, DM}; pg8::MoeOrder<true> S{ntile * 4, F.G, F.vcu, tb, STV, MTOK};
            pg8::EpiSwiglu E{HB, RSV, DE, tb};
            for (int rep = 0; rep < NREP(8); ++rep) pg8::gemm_phase<pg8::EpiSwiglu, pg8::MoeOrder<true>, true, true>(F.lds, g, S, E); }
        SEAM(pb + 5);
        if (EN(8) && IN(pb + 6)) { PHASE_BEGIN(); MOE_TABS();
            pg8::Gemm g{HB, (const bf16*)(F.ws + WS_W2), MAXSLOT, NE * 1024, DE}; pg8::MoeOrder<false> S{ntile * 4, F.G, F.vcu, tb, STV, MTOK};
            pg8::EpiGate E{OB, GTV, DM, tb};
            for (int rep = 0; rep < NREP(9); ++rep) pg8::gemm_phase<pg8::EpiGate, pg8::MoeOrder<false>, true, true>(F.lds, g, S, E); }
        SEAM(pb + 6);
        if (EN(9) && IN(pb + 7)) { PHASE_BEGIN(); combine_phase(F, l, X1, TOKE, TOKR, OB, l + 1 == DEPTH, X0, RS1, F.out); if (l + 1 < DEPTH) convert_weights(F, l + 1); }
        if (l + 1 < DEPTH) SEAM(pb + 7);
    }
#undef IN
#undef SEAM
}

extern "C" void kernel_launch(void* const* d_in, const int* in_sizes, int n_in, void* d_out, int out_size, void* d_ws, size_t ws_size, hipStream_t stream) {
    static int grid = 0;
    if (grid == 0) {
        if (n_in != 26 || in_sizes[0] != MTOK * DM || out_size != MTOK * DM || ws_size < WS_END) { fprintf(stderr, "kernel_launch: unexpected shapes (n_in %d, in0 %d, out %d, ws %zu < %zu); nothing launched\n", n_in, n_in > 0 ? in_sizes[0] : -1, out_size, ws_size, (size_t)WS_END); grid = -1; return; }
        int dev = 0, cus = 0, per_cu = 0;
        if (hipGetDevice(&dev) != hipSuccess || hipDeviceGetAttribute(&cus, hipDeviceAttributeMultiprocessorCount, dev) != hipSuccess) { grid = -1; return; }
        if (hipFuncSetAttribute((const void*)mk_fwd, hipFuncAttributeMaxDynamicSharedMemorySize, LDS_BYTES) != hipSuccess) { fprintf(stderr, "kernel_launch: hipFuncSetAttribute failed\n"); grid = -1; return; }
        if (hipOccupancyMaxActiveBlocksPerMultiprocessor(&per_cu, (const void*)mk_fwd, NTHR, LDS_BYTES) != hipSuccess || per_cu < 1) { fprintf(stderr, "kernel_launch: occupancy query reports %d blocks per CU; nothing launched\n", per_cu); (void)hipGetLastError(); grid = -1; return; }
        grid = cus;
    }
    if (grid < 0) return;
    if (hipMemsetAsync((char*)d_ws + WS_CTL, 0, CTL_ZERO_BYTES, stream) != hipSuccess) { fprintf(stderr, "kernel_launch: memset failed\n"); return; }
    Args a{};
    for (int i = 0; i < 26; ++i) a.in[i] = (const float*)d_in[i];
    a.out = (float*)d_out; a.ws = (unsigned char*)d_ws;
#if defined(MK_PER_PHASE) && MK_PER_PHASE
    for (int p = 0; p < N_PHASES; ++p) { a.ph_lo = p; a.ph_hi = p + 1; hipLaunchKernelGGL(mk_fwd, dim3(grid), dim3(NTHR), LDS_BYTES, stream, a); }
#else
    a.ph_lo = 0; a.ph_hi = N_PHASES; hipLaunchKernelGGL(mk_fwd, dim3(grid), dim3(NTHR), LDS_BYTES, stream, a);
#endif
    const hipError_t le = hipPeekAtLastError();
    if (le != hipSuccess) fprintf(stderr, "kernel_launch: launch failed: %s\n", hipGetErrorName(le));
}
```

```cpp
#include <hip/hip_runtime.h>
#include <cstdio>
#include <cstdint>
namespace pg8 {
#define PG8_LAS __attribute__((address_space(3)))
typedef unsigned short bf16_t;
typedef short bf16x8 __attribute__((ext_vector_type(8)));
typedef float f32x4 __attribute__((ext_vector_type(4)));
typedef unsigned u32x4 __attribute__((ext_vector_type(4)));
constexpr int BM = 256, BK = 64, HALF = 128, HTB = HALF * BK * 2  , STAGE_BYTES = 8 * HTB, NXCD = 8, WGM = 8;

__host__ __device__ __forceinline__ int lds_byte(int r, int c) { const int st = (r >> 4) * 2 + (c >> 5), rr = r & 15, cc = c & 31, ob = rr * 64 + cc * 2; return st * 1024 + (ob ^ (((ob >> 9) & 1) << 5)); }
__host__ __device__ __forceinline__ void stage_rc(int b, int& R, int& C) { const int st = b / 1024, sb = b % 1024, swz = sb ^ (((sb >> 9) & 1) << 5); R = (st >> 1) * 16 + swz / 64; C = (st & 1) * 32 + (swz % 64) / 2; }
__host__ __device__ __forceinline__ int perm32(int rho) { const int n = rho >> 4, i = rho & 15; return 8 * (i >> 2) + 4 * n + (i & 3); }

struct Unit { int pm, pn; };
struct Gemm { const bf16_t* A; const bf16_t* Bt; int M, N, K; };

struct StaticOrder {
    static constexpr bool GATHER = false;
    int nM, nN, nwg, G, c;
    __host__ __device__ void init(int M, int N, int G_, int c_) { nM = M / BM; nN = N / BM; nwg = nM * nN; G = G_; c = c_; }
    __host__ __device__ bool next(int i, Unit& u) const {
        const long L = (long)i * G + c; if (L >= nwg) return false;
        int wgid = (int)L; { const int q = nwg / NXCD, r = nwg % NXCD, xcd = wgid % NXCD, off = wgid / NXCD; wgid = (xcd < r ? xcd * (q + 1) : r * (q + 1) + (xcd - r) * q) + off; }
        const int nig = WGM * nN, gid = wgid / nig, fm = gid * WGM, gsz = (nM - fm) < WGM ? (nM - fm) : WGM;
        u.pm = fm + ((wgid % nig) % gsz); u.pn = (wgid % nig) / gsz; return true;
    }
    __device__ __forceinline__ void a_ready(const Unit&) const {}
    __device__ __forceinline__ void done(const Unit&) const {}
};
__device__ __forceinline__ unsigned cvt_pk_bf16(float lo, float hi) { unsigned r; asm volatile("v_cvt_pk_bf16_f32 %0, %1, %2" : "=v"(r) : "v"(lo), "v"(hi)); return r; }
typedef float f32x2 __attribute__((ext_vector_type(2)));
typedef float f32x2 __attribute__((ext_vector_type(2)));
typedef unsigned u32x2 __attribute__((ext_vector_type(2)));
struct EpiProj {
    static constexpr bool PERM = true, AFTER_DRAIN = false;
    bf16_t* P; const float* rs; const float* gq; const float* gk; int ldp; float qscale;
    __device__ __forceinline__ void operator()(const f32x4 (&acc)[2][2][4][2], const Unit& u, int wr, int wc, int fr, int fq) const {
        const int pn = u.pn; const bool headnorm = pn < 4;
        f32x4 g[2][2];
        if (headnorm) { const float* gp = (pn < 2) ? gq : gk; const float s = (pn < 2) ? qscale : 1.0f;
#pragma unroll
            for (int bj = 0; bj < 2; ++bj)
#pragma unroll
                for (int n = 0; n < 2; ++n) g[bj][n] = *(const f32x4*)(gp + 32 * bj + 8 * fq + 4 * n) * s; }
#pragma unroll
        for (int ai = 0; ai < 2; ++ai)
#pragma unroll
            for (int m = 0; m < 4; ++m) {
                asm volatile("" ::: "memory");
                const int row = u.pm * BM + ai * HALF + wr * 64 + m * 16 + fr; const float r = rs[row];
                f32x4 v[2][2];
#pragma unroll
                for (int bj = 0; bj < 2; ++bj)
#pragma unroll
                    for (int n = 0; n < 2; ++n) v[bj][n] = acc[ai][bj][m][n] * r;
                if (headnorm) { float ss = 0.f;
#pragma unroll
                    for (int bj = 0; bj < 2; ++bj)
#pragma unroll
                        for (int n = 0; n < 2; ++n) { const f32x4 x = v[bj][n]; ss += (x[0] * x[0] + x[1] * x[1]) + (x[2] * x[2] + x[3] * x[3]); }
                    ss += __shfl_xor(ss, 16); ss += __shfl_xor(ss, 32);
                    const float sc = __builtin_amdgcn_rsqf(ss * (1.0f / 64.0f) + 1e-6f);
#pragma unroll
                    for (int bj = 0; bj < 2; ++bj)
#pragma unroll
                        for (int n = 0; n < 2; ++n) v[bj][n] = v[bj][n] * g[bj][n] * sc; }
                bf16_t* rowp = P + (size_t)row * ldp + pn * BM + 64 * wc + 8 * fq;
#pragma unroll
                for (int bj = 0; bj < 2; ++bj) { u32x4 w; w.x = cvt_pk_bf16(v[bj][0][0], v[bj][0][1]); w.y = cvt_pk_bf16(v[bj][0][2], v[bj][0][3]); w.z = cvt_pk_bf16(v[bj][1][0], v[bj][1][1]); w.w = cvt_pk_bf16(v[bj][1][2], v[bj][1][3]);
                    *(u32x4*)(rowp + 32 * bj) = w; }
            }
    }
};
struct EpiResid {
    static constexpr bool PERM = true, AFTER_DRAIN = false;
    const bf16_t* base; bf16_t* out; int ldc;
    __device__ __forceinline__ void operator()(const f32x4 (&acc)[2][2][4][2], const Unit& u, int wr, int wc, int fr, int fq) const {
        const int col0 = u.pn * BM + wc * 32 + 8 * fq;
#pragma unroll
        for (int ai = 0; ai < 2; ++ai)
#pragma unroll
            for (int m = 0; m < 4; ++m) { const size_t off = (size_t)(u.pm * BM + ai * HALF + wr * 64 + m * 16 + fr) * ldc + col0;
                u32x4 b[2];
#pragma unroll
                for (int bj = 0; bj < 2; ++bj) b[bj] = *(const u32x4*)(base + off + bj * HALF);
#pragma unroll
                for (int bj = 0; bj < 2; ++bj) { const f32x4 v0 = acc[ai][bj][m][0], v1 = acc[ai][bj][m][1]; u32x4 w;
                    w.x = cvt_pk_bf16(v0[0] + __uint_as_float(b[bj].x << 16), v0[1] + __uint_as_float(b[bj].x & 0xffff0000u)); w.y = cvt_pk_bf16(v0[2] + __uint_as_float(b[bj].y << 16), v0[3] + __uint_as_float(b[bj].y & 0xffff0000u));
                    w.z = cvt_pk_bf16(v1[0] + __uint_as_float(b[bj].z << 16), v1[1] + __uint_as_float(b[bj].z & 0xffff0000u)); w.w = cvt_pk_bf16(v1[2] + __uint_as_float(b[bj].w << 16), v1[3] + __uint_as_float(b[bj].w & 0xffff0000u));
                    *(u32x4*)(out + off + bj * HALF) = w; }
                if (m & 1) asm volatile("" ::: "memory"); }
    }
};
struct MoeTabs { const PG8_LAS int* pst; const PG8_LAS int* cnt; const PG8_LAS int* tile_e; };
struct EpiSwiglu {
    static constexpr bool PERM = true, AFTER_DRAIN = false;
    bf16_t* H; const float* rsv; int ldh; MoeTabs tb;
    __device__ __forceinline__ void operator()(const f32x4 (&acc)[2][2][4][2], const Unit& u, int wr, int wc, int fr, int fq) const {
        const int col0 = (u.pn & 3) * 128 + 16 * wc + 4 * fq; const int ex = u.pn >> 2, br = u.pm * BM - tb.pst[ex], ce = tb.cnt[ex];
#pragma unroll
        for (int ai = 0; ai < 2; ++ai)
#pragma unroll
            for (int m = 0; m < 4; ++m) { const int rl = ai * HALF + wr * 64 + m * 16 + fr; const int row = u.pm * BM + rl; const int rank = br + rl; const float r = (rank < ce) ? rsv[ex * 32768 + rank] : 0.f;
#pragma unroll
                for (int bj = 0; bj < 2; ++bj) { const f32x4 g = acc[ai][bj][m][0] * r, up = acc[ai][bj][m][1] * r; float h[4];
#pragma unroll
                    for (int i = 0; i < 4; ++i) h[i] = g[i] * __builtin_amdgcn_rcpf(1.0f + __builtin_amdgcn_exp2f(-1.4426950408889634f * g[i])) * up[i];
                    u32x2 w; w.x = cvt_pk_bf16(h[0], h[1]); w.y = cvt_pk_bf16(h[2], h[3]);
                    *(u32x2*)(H + (size_t)row * ldh + col0 + 64 * bj) = w; } }
    }
};
struct EpiGate {
    static constexpr bool PERM = true, AFTER_DRAIN = false;
    bf16_t* O; const float* gtv; int ldo; MoeTabs tb;
    __device__ __forceinline__ void operator()(const f32x4 (&acc)[2][2][4][2], const Unit& u, int wr, int wc, int fr, int fq) const {
        const int col0 = (u.pn & 3) * BM + wc * 32 + 8 * fq; const int ex = u.pn >> 2, br = u.pm * BM - tb.pst[ex], ce = tb.cnt[ex];
#pragma unroll
        for (int ai = 0; ai < 2; ++ai)
#pragma unroll
            for (int m = 0; m < 4; ++m) { const int rl = ai * HALF + wr * 64 + m * 16 + fr; const int row = u.pm * BM + rl; const int rank = br + rl; const float gt = (rank < ce) ? gtv[ex * 32768 + rank] : 0.f;
#pragma unroll
                for (int bj = 0; bj < 2; ++bj) { const f32x4 v0 = acc[ai][bj][m][0] * gt, v1 = acc[ai][bj][m][1] * gt;
                    u32x4 w; w.x = cvt_pk_bf16(v0[0], v0[1]); w.y = cvt_pk_bf16(v0[2], v0[3]); w.z = cvt_pk_bf16(v1[0], v1[1]); w.w = cvt_pk_bf16(v1[2], v1[3]);
                    *(u32x4*)(O + (size_t)row * ldo + col0 + bj * HALF) = w; } }
    }
};
template <bool GATHER_> struct MoeOrder {
    static constexpr bool GATHER = GATHER_;
    int nunits, G, c; MoeTabs tb; const int* stv; int zrow;
    __device__ __forceinline__ bool next(int i, Unit& u) const { const int L = i * G + c; if (L >= nunits) return false; const int rt = L >> 2; u.pm = rt; u.pn = tb.tile_e[rt] * 4 + (L & 3); return true; }
    __device__ __forceinline__ void a_ready(const Unit&) const {}
    __device__ __forceinline__ void done(const Unit&) const {}
    __device__ __forceinline__ void rows(const Unit& u, const int (&R)[2], const unsigned (&C2)[2], unsigned (&v)[2][2], int K) const {
        const int ex = u.pn >> 2, br = u.pm * BM - tb.pst[ex], ce = tb.cnt[ex];
#pragma unroll
        for (int h = 0; h < 2; ++h)
#pragma unroll
            for (int i = 0; i < 2; ++i) { const int rank = br + HALF * h + R[i]; int tok = zrow; if (rank < ce) tok = stv[ex * 32768 + rank]; v[h][i] = (unsigned)tok * (unsigned)(K * 2) + C2[i]; }
    }
};
template <class Epi, class Sched, bool ALIGN_EPI = false, bool SP2 = false>
__device__ __forceinline__ void gemm_phase(PG8_LAS unsigned char* lds, const Gemm g, const Sched& S, const Epi& E) {
    int tid_ = threadIdx.x; asm volatile("" : "+v"(tid_));
    const int tid = tid_, wid = __builtin_amdgcn_readfirstlane(tid >> 6), lane = tid & 63, wr = wid >> 2, wc = wid & 3, fr = lane & 15, fq = lane >> 4;
    const int K = g.K, nt = K / BK;
    unsigned voffA[2], voffB[2];
    int gR[2]; unsigned gC2[2];
    unsigned vC[2][2], vN[2][2];
#pragma unroll
    for (int i = 0; i < 2; ++i) { int R, C; stage_rc(tid * 16 + i * 8192, R, C); const int Rb = Epi::PERM ? ((R & ~31) + perm32(R & 31)) : R;
        voffA[i] = (unsigned)(R * K + C) * 2u; voffB[i] = (unsigned)(Rb * K + C) * 2u; gR[i] = R; gC2[i] = (unsigned)C * 2u; }
    const size_t kstep = (size_t)(BK * 2);
    const size_t hstep = (size_t)HALF * K * 2;
    const size_t tstep = 2 * hstep;
    const unsigned ldsw = (unsigned)wid * 1024u;
    const int aoff = lds_byte(wr * 64 + fr, fq * 8), boff = lds_byte(wc * 32 + fr, fq * 8);
#define PG8_SA(b, h) (((b) * 2 + (h)) * HTB)
#define PG8_SB(b, h) ((4 + (b) * 2 + (h)) * HTB)
#define PG8_STAGE(bufoff, gbase, voff) do { _Pragma("unroll") for (int _i = 0; _i < 2; ++_i) \
        __builtin_amdgcn_global_load_lds((const unsigned*)((const char*)(gbase) + (voff)[_i]), (PG8_LAS unsigned*)(lds + (bufoff) + ldsw + _i * 8192), 16, 0, 0); } while (0)
#define PG8_STAGEA(bufoff, P, h, V) do { if constexpr (Sched::GATHER) { PG8_STAGE(bufoff, P, (V)[h]); } else { PG8_STAGE(bufoff, (P) + (h) * hstep, voffA); } } while (0)
#define PG8_LDA(dst, b, h) do { _Pragma("unroll") for (int m = 0; m < 4; ++m) _Pragma("unroll") for (int k = 0; k < 2; ++k) dst[m][k] = *(const PG8_LAS bf16x8*)(lds + PG8_SA(b, h) + aoff + m * 2048 + k * 1024); } while (0)
#define PG8_LDB(dst, b, h) do { _Pragma("unroll") for (int n = 0; n < 2; ++n) _Pragma("unroll") for (int k = 0; k < 2; ++k) dst[n][k] = *(const PG8_LAS bf16x8*)(lds + PG8_SB(b, h) + boff + n * 2048 + k * 1024); } while (0)
#define PG8_MMA(ai, bj, At, Bt) do { __builtin_amdgcn_s_setprio(1); _Pragma("unroll") for (int m = 0; m < 4; ++m) _Pragma("unroll") for (int n = 0; n < 2; ++n) _Pragma("unroll") for (int k = 0; k < 2; ++k) \
        acc[ai][bj][m][n] = __builtin_amdgcn_mfma_f32_16x16x32_bf16(Bt[n][k], At[m][k], acc[ai][bj][m][n], 0, 0, 0); __builtin_amdgcn_s_setprio(0); } while (0)
#define PG8_WAIT_V(n) asm volatile("s_waitcnt vmcnt(" #n ")" ::: "memory")
#define PG8_WAIT_L(n) asm volatile("s_waitcnt lgkmcnt(" #n ")" ::: "memory")
#define PG8_BAR __builtin_amdgcn_s_barrier()
#define PG8_SCHED __builtin_amdgcn_sched_barrier(0)
    Unit cur, nxt; int ui = 0;
    if (!S.next(0, cur)) return;
    f32x4 acc[2][2][4][2];
#pragma unroll
    for (int a = 0; a < 2; ++a)
#pragma unroll
        for (int b = 0; b < 2; ++b)
#pragma unroll
            for (int m = 0; m < 4; ++m)
#pragma unroll
                for (int n = 0; n < 2; ++n) acc[a][b][m][n] = (f32x4){0.f, 0.f, 0.f, 0.f};
    bf16x8 At[4][2], B0[2][2], B1[2][2];
    const char* cA = Sched::GATHER ? (const char*)g.A : (const char*)g.A + (size_t)cur.pm * tstep; const char* cB = (const char*)g.Bt + (size_t)cur.pn * tstep;
    S.a_ready(cur);
    if constexpr (Sched::GATHER) S.rows(cur, gR, gC2, vC, K);
    if constexpr (SP2) {
        PG8_STAGE(PG8_SB(0, 0), cB, voffB); PG8_STAGE(PG8_SB(0, 1), cB + hstep, voffB); PG8_STAGEA(PG8_SA(0, 0), cA, 0, vC); PG8_STAGEA(PG8_SA(0, 1), cA, 1, vC);
        if (wr == 1) PG8_BAR;
        PG8_WAIT_V(2); PG8_BAR;
        PG8_STAGE(PG8_SB(1, 0), cB + kstep, voffB); PG8_STAGEA(PG8_SA(1, 0), cA + kstep, 0, vC); PG8_STAGE(PG8_SB(1, 1), cB + hstep + kstep, voffB);
        PG8_WAIT_V(6); PG8_BAR;
    } else {
        PG8_STAGE(PG8_SB(0, 0), cB, voffB); PG8_STAGE(PG8_SA(0, 0), cA, voffA); PG8_STAGE(PG8_SB(0, 1), cB + hstep, voffB); PG8_STAGE(PG8_SA(0, 1), cA + hstep, voffA);
        if (wr == 1) PG8_BAR;
        PG8_WAIT_V(4); PG8_BAR;
        PG8_STAGE(PG8_SB(1, 0), cB + kstep, voffB); PG8_STAGE(PG8_SA(1, 0), cA + kstep, voffA); PG8_STAGE(PG8_SB(1, 1), cB + hstep + kstep, voffB);
        PG8_WAIT_V(6); PG8_BAR;
    }
    for (;;) {
        const bool has_next = S.next(ui + 1, nxt);
        const char* nA = (has_next && !Sched::GATHER) ? (const char*)g.A + (size_t)nxt.pm * tstep : cA; const char* nB = has_next ? (const char*)g.Bt + (size_t)nxt.pn * tstep : cB;
        for (int t = 0; t < nt; t += 2) {
            const bool last = (t == nt - 2);
            const char* a1 = cA + (size_t)(t + 1) * kstep;
            const char* a2 = last ? nA : cA + (size_t)(t + 2) * kstep; const char* b2 = last ? nB : cB + (size_t)(t + 2) * kstep;
            const char* a3 = a2 + kstep; const char* b3 = b2 + kstep;
            if (last && has_next) { S.a_ready(nxt); if constexpr (Sched::GATHER) S.rows(nxt, gR, gC2, vN, K); }
            unsigned v2[2][2];
            if constexpr (Sched::GATHER) { const bool usen = last && has_next;
#pragma unroll
                for (int h_ = 0; h_ < 2; ++h_)
#pragma unroll
                    for (int i_ = 0; i_ < 2; ++i_) v2[h_][i_] = usen ? vN[h_][i_] : vC[h_][i_]; }
            if constexpr (SP2) {
            PG8_LDB(B0, 0, 0); PG8_LDB(B1, 0, 1); PG8_SCHED; PG8_LDA(At, 0, 0); PG8_STAGEA(PG8_SA(1, 1), a1, 1, vC);
            PG8_WAIT_V(8); PG8_WAIT_L(0); PG8_BAR; PG8_MMA(0, 0, At, B0); PG8_MMA(0, 1, At, B1); PG8_BAR; PG8_SCHED;
            PG8_LDA(At, 0, 1); PG8_STAGE(PG8_SB(0, 0), b2, voffB); PG8_STAGE(PG8_SB(0, 1), b2 + hstep, voffB); PG8_STAGEA(PG8_SA(0, 0), a2, 0, v2);
            PG8_WAIT_V(8); PG8_WAIT_L(0); PG8_BAR; PG8_MMA(1, 0, At, B0); PG8_MMA(1, 1, At, B1); PG8_BAR; PG8_SCHED;
            PG8_LDB(B0, 1, 0); PG8_LDB(B1, 1, 1); PG8_SCHED; PG8_LDA(At, 1, 0); PG8_STAGEA(PG8_SA(0, 1), a2, 1, v2);
            PG8_WAIT_V(8); PG8_WAIT_L(0); PG8_BAR; PG8_MMA(0, 0, At, B0); PG8_MMA(0, 1, At, B1); PG8_BAR; PG8_SCHED;
            PG8_LDA(At, 1, 1); PG8_STAGE(PG8_SB(1, 0), b3, voffB); PG8_STAGE(PG8_SB(1, 1), b3 + hstep, voffB); PG8_STAGEA(PG8_SA(1, 0), a3, 0, v2);
            PG8_WAIT_V(8); PG8_WAIT_L(0); PG8_BAR; PG8_MMA(1, 0, At, B0); PG8_MMA(1, 1, At, B1); PG8_BAR; PG8_SCHED;
            } else {
            static_assert(SP2 || !Sched::GATHER, "gather mode: SP2 loop only");
            PG8_LDB(B0, 0, 0); PG8_SCHED; PG8_LDA(At, 0, 0); PG8_STAGE(PG8_SA(1, 1), a1 + hstep, voffA);
            PG8_WAIT_L(8); PG8_BAR; PG8_WAIT_L(0); PG8_MMA(0, 0, At, B0); PG8_BAR; PG8_SCHED;
            PG8_LDB(B1, 0, 1); PG8_STAGE(PG8_SB(0, 0), b2, voffB);
            PG8_BAR; PG8_WAIT_L(0); PG8_MMA(0, 1, At, B1); PG8_BAR;
            PG8_LDA(At, 0, 1); PG8_STAGE(PG8_SA(0, 0), a2, voffA);
            PG8_BAR; PG8_WAIT_L(0); PG8_MMA(1, 0, At, B0); PG8_BAR; PG8_SCHED;
            PG8_STAGE(PG8_SB(0, 1), b2 + hstep, voffB);
            PG8_WAIT_V(6); PG8_BAR; PG8_MMA(1, 1, At, B1); PG8_BAR;
            PG8_LDB(B0, 1, 0); PG8_SCHED; PG8_LDA(At, 1, 0); PG8_STAGE(PG8_SA(0, 1), a2 + hstep, voffA);
            PG8_WAIT_L(8); PG8_BAR; PG8_WAIT_L(0); PG8_MMA(0, 0, At, B0); PG8_BAR; PG8_SCHED;
            PG8_LDB(B1, 1, 1); PG8_STAGE(PG8_SB(1, 0), b3, voffB);
            PG8_BAR; PG8_WAIT_L(0); PG8_MMA(0, 1, At, B1); PG8_BAR;
            PG8_LDA(At, 1, 1); PG8_STAGE(PG8_SA(1, 0), a3, voffA);
            PG8_BAR; PG8_WAIT_L(0); PG8_MMA(1, 0, At, B0); PG8_BAR; PG8_SCHED;
            PG8_STAGE(PG8_SB(1, 1), b3 + hstep, voffB);
            PG8_WAIT_V(6); PG8_BAR; PG8_MMA(1, 1, At, B1); PG8_BAR;
            }
        }
        if constexpr (ALIGN_EPI) { if (wr == 0) PG8_BAR; }
        if constexpr (!Epi::AFTER_DRAIN) { E(acc, cur, wr, wc, fr, fq); S.done(cur); }
        if (!has_next) break;
#pragma unroll
        for (int a = 0; a < 2; ++a)
#pragma unroll
            for (int b = 0; b < 2; ++b)
#pragma unroll
                for (int m = 0; m < 4; ++m)
#pragma unroll
                    for (int n = 0; n < 2; ++n) acc[a][b][m][n] = (f32x4){0.f, 0.f, 0.f, 0.f};
        cur = nxt; cA = nA; cB = nB; ++ui;
        if constexpr (Sched::GATHER) {
#pragma unroll
            for (int h_ = 0; h_ < 2; ++h_)
#pragma unroll
                for (int i_ = 0; i_ < 2; ++i_) vC[h_][i_] = vN[h_][i_]; }
        if constexpr (ALIGN_EPI) { if (wr == 1) PG8_BAR; }
    }
    PG8_WAIT_V(0);
    if constexpr (!ALIGN_EPI) { if (wr == 0) PG8_BAR; }
    PG8_BAR;
    if constexpr (Epi::AFTER_DRAIN) { E.fused(acc, cur, wr, wc, fr, fq, lds, wid, lane); S.done(cur); }
#undef PG8_SA
#undef PG8_SB
#undef PG8_STAGE
#undef PG8_STAGEA
#undef PG8_LDA
#undef PG8_LDB
#undef PG8_MMA
#undef PG8_WAIT_V
#undef PG8_WAIT_L
#undef PG8_BAR
#undef PG8_SCHED
}
}
#define GAS __attribute__((address_space(1)))
#define LAS __attribute__((address_space(3)))
typedef unsigned short bf16;
typedef unsigned v4u __attribute__((ext_vector_type(4)));
typedef float f32x4 __attribute__((ext_vector_type(4)));
typedef short bf16x8 __attribute__((ext_vector_type(8)));
typedef GAS unsigned gu32;
typedef GAS unsigned long long gu64;
#define RLX_AGENT __ATOMIC_RELAXED, __HIP_MEMORY_SCOPE_AGENT
#define LDS_WAIT() asm volatile("s_waitcnt lgkmcnt(0)" ::: "memory")
#define VM_WAIT() asm volatile("s_waitcnt vmcnt(0)" ::: "memory")
__device__ __forceinline__ unsigned long long rt() { return __builtin_amdgcn_s_memrealtime(); }
__device__ __forceinline__ unsigned f2bf(float f) { unsigned u = __builtin_bit_cast(unsigned, f); return (u + 0x7fffu + ((u >> 16) & 1u)) >> 16; }
__device__ __forceinline__ unsigned pk2(float lo, float hi) { return f2bf(lo) | (f2bf(hi) << 16); }

#define XB_TMO      128
#define XB_XCNT(j)  (256  + 64 * (j))
#define XB_XSUB(j)  (1280 + 64 * (j))
#define XB_XGEN(j)  (2304 + 64 * (j))
#define XB_TOP      3328
#define XB_TOPGEN   3392
#define XCD_BAR_WORDS 3456
#define XB_SPIN_CAP (1u << 18)

__device__ __forceinline__ unsigned xb_ld(unsigned* p)              { return __hip_atomic_load(p, __ATOMIC_RELAXED, __HIP_MEMORY_SCOPE_AGENT); }
__device__ __forceinline__ unsigned xb_add(unsigned* p, unsigned v) { return __hip_atomic_fetch_add(p, v, __ATOMIC_RELAXED, __HIP_MEMORY_SCOPE_AGENT); }
__device__ __forceinline__ unsigned xb_xcc_id() { return (unsigned)__builtin_amdgcn_s_getreg((3 << 11) | 20) & 0xFu; }
#define XB_SPIN(cond, bar) do { unsigned _sp = 0; while (cond) { __builtin_amdgcn_s_sleep(1); \
    if ((++_sp & 255u) == 0u) { if (xb_ld(&(bar)[XB_TMO])) break; if (_sp > XB_SPIN_CAP) { atomicAdd(&(bar)[XB_TMO], 1u); break; } } } } while (0)

struct XcdBarrier {
    unsigned* bar; unsigned x;
    volatile LAS unsigned* st;
};

__device__ __forceinline__ XcdBarrier xcd_barrier_post(unsigned* bar, volatile LAS unsigned* st) {
    XcdBarrier b; b.bar = bar; b.x = xb_xcc_id(); b.st = st;
    if (threadIdx.x == 0) (void)xb_add(&bar[XB_XCNT(b.x)], 1u);
    return b;
}
__device__ __forceinline__ void xcd_barrier_complete(unsigned* bar, unsigned x, unsigned& nloc, unsigned& nx) {
    const unsigned G = gridDim.x * gridDim.y * gridDim.z;
    unsigned sum, cnt, mine, sp = 0u;
    for (;;) {
        sum = 0u; cnt = 0u; mine = 0u;
#pragma unroll
        for (unsigned j = 0; j < 16; ++j) { const unsigned c = xb_ld(&bar[XB_XCNT(j)]); sum += c; cnt += (c > 0u) ? 1u : 0u; mine = (j == x) ? c : mine; }
        if (sum == G) break;
        __builtin_amdgcn_s_sleep(1);
        if ((++sp & 255u) == 0u) { if (xb_ld(&bar[XB_TMO])) break; if (sp > XB_SPIN_CAP) { atomicAdd(&bar[XB_TMO], 1u); break; } }
    }
    nloc = mine > 0u ? mine : 1u; nx = cnt > 0u ? cnt : 1u;
}

__device__ __forceinline__ void xcd_barrier(const XcdBarrier& b) {
    asm volatile("s_waitcnt vmcnt(0)" ::: "memory");
    __syncthreads();
    if (threadIdx.x == 0) {
        unsigned* bar = b.bar;
        __builtin_amdgcn_s_waitcnt(0);
        unsigned nloc = b.st[0], nx = b.st[1];
        if (nloc == 0u) { xcd_barrier_complete(bar, b.x, nloc, nx); b.st[0] = nloc; b.st[1] = nx; }
        const unsigned old = xb_add(&bar[XB_XSUB(b.x)], 1u);
        const unsigned gen = old / nloc;
        if (old + 1u == (gen + 1u) * nloc) {
            __builtin_amdgcn_fence(__ATOMIC_RELEASE, "agent");
            asm volatile("s_waitcnt vmcnt(0)" ::: "memory");
            const unsigned og = xb_add(&bar[XB_TOP], 1u);
            const unsigned tg = og / nx;
            if (og + 1u == (tg + 1u) * nx) xb_add(&bar[XB_TOPGEN], 1u);
            else XB_SPIN(xb_ld(&bar[XB_TOPGEN]) == tg, bar);
            __builtin_amdgcn_fence(__ATOMIC_ACQUIRE, "agent");
            xb_add(&bar[XB_XGEN(b.x)], 1u);
            asm volatile("s_waitcnt vmcnt(0)" ::: "memory");
        } else {
            XB_SPIN(xb_ld(&bar[XB_XGEN(b.x)]) == gen, bar);
            __builtin_amdgcn_fence(__ATOMIC_ACQUIRE, "agent");
            asm volatile("s_waitcnt vmcnt(0)" ::: "memory");
        }
    }
    __syncthreads();
}

constexpr int NB = 4, SEQ = 8192, DM = 1024, MTOK = NB * SEQ, DEPTH = 2;
constexpr int DIN = 2560, NH = 8, HD = 64, DLRU = 256, DCONF = 256, NE = 32, DE = 512;
constexpr int COL_Q = 0, COL_K = 512, COL_V = 1024, COL_XR = 1536, COL_XG = 1792, COL_XC = 2048;
constexpr int NRT = 36, NRTP = 48;
constexpr int MAXSLOT = 73728;
constexpr float EPSN = 1e-6f;
constexpr float LOG2E = 1.4426950408889634f;
constexpr float QSCALE = 0.125f * LOG2E;
constexpr float EXIT_THR2 = 120.0f * LOG2E;

constexpr size_t MiB = 1u << 20;
constexpr size_t WS_CTL = 0, CTL_ZERO_BYTES = 1 * MiB;
constexpr size_t WS_WIN = 1 * MiB;
constexpr size_t WS_WOUT = 6 * MiB;
constexpr size_t WS_W1 = 8 * MiB;
constexpr size_t WS_W2 = 72 * MiB;
constexpr size_t WS_PW = 104 * MiB;
constexpr size_t WS_LRUW = WS_PW + 128 * 1024;
constexpr size_t WS_WR = WS_PW + 256 * 1024;
constexpr size_t WS_RS1 = 105 * MiB;
constexpr size_t WS_RS2 = WS_RS1 + 128 * 1024;
constexpr size_t WS_TOKE = WS_RS2 + 128 * 1024;
constexpr size_t WS_TOKR = WS_TOKE + 256 * 1024;
constexpr size_t WS_SUMM = 107 * MiB;
constexpr size_t WS_X0 = 109 * MiB;
constexpr size_t WS_X1 = 174 * MiB;
constexpr size_t WS_PROJ = 239 * MiB;
constexpr size_t WS_HP = 399 * MiB;
constexpr size_t WS_STV = 471 * MiB;
constexpr size_t WS_RSV = 475 * MiB;
constexpr size_t WS_GTV = 479 * MiB;
constexpr size_t WS_END = 483 * MiB;
constexpr int CW_TMO = 0, CW_BAR = 4096, CW_CNT = 8192;

constexpr int SCR_BYTES = 143360;
constexpr int LDSCTL_OFF = SCR_BYTES;
constexpr int LDS_BYTES = 147456;
constexpr int NWAVES = 8, NTHR = 512;

typedef float f32x16 __attribute__((ext_vector_type(16)));
typedef short s16x4 __attribute__((ext_vector_type(4)));
typedef unsigned u32x2 __attribute__((ext_vector_type(2)));
typedef float f32x2 __attribute__((ext_vector_type(2)));
typedef __bf16 bf16x2_t __attribute__((ext_vector_type(2)));

__device__ __forceinline__ unsigned cvtpk(float lo, float hi) { f32x2 v = {lo, hi}; bf16x2_t b = __builtin_convertvector(v, bf16x2_t); return __builtin_bit_cast(unsigned, b); }
__device__ __forceinline__ float bflo(unsigned w) { return __uint_as_float(w << 16); }
__device__ __forceinline__ float bfhi(unsigned w) { return __uint_as_float(w & 0xffff0000u); }
__device__ __forceinline__ float fexp2(float x) { return __builtin_amdgcn_exp2f(x); }
__device__ __forceinline__ float flog2(float x) { return __builtin_amdgcn_logf(x); }
__device__ __forceinline__ float frcp(float x) { return __builtin_amdgcn_rcpf(x); }
__device__ __forceinline__ float sigmoidf_(float x) { return frcp(1.0f + fexp2(-LOG2E * x)); }
__device__ __forceinline__ float wave_sum(float v) {
#pragma unroll
    for (int o = 1; o < 64; o <<= 1) v += __shfl_xor(v, o);
    return v;
}
#define WG_SYNC() __syncthreads()
__device__ __forceinline__ int opq(int x) { asm volatile("" : "+v"(x)); return x; }

struct Frame {
    LAS unsigned char* lds;
    gu32* ctl;
    int tid, lane, wave, vcu, G;
    const float* const* in;
    float* out; unsigned char* ws;
};

__device__ __forceinline__ int dest_row(int n, int mode) {
    if (mode == 1) { const int t = n & ~255, c = n & 255; return t + 128 * ((c >> 5) & 1) + 32 * (c >> 6) + (c & 31); }
    if (mode == 2) return 8 * (n >> 2) + (n & 3);
    if (mode == 3) return 8 * (n >> 2) + 4 + (n & 3);
    return n;
}
__device__ __forceinline__ void transpose_item(const float* W, int ldn, int k0, int n0, const float* gain, bf16* WT, int ldk, int mode, LAS float* scr  , int lane) {
    float v[64]; const float* p = W + (size_t)k0 * ldn + n0 + lane;
#pragma unroll
    for (int i = 0; i < 64; ++i) { v[i] = *(const GAS float*)p; p += ldn; }
    if (gain) {
#pragma unroll
        for (int i = 0; i < 64; ++i) v[i] *= gain[k0 + i]; }
#pragma unroll
    for (int i = 0; i < 64; ++i) scr[i * 65 + lane] = v[i];
    LDS_WAIT(); asm volatile("" ::: "memory");
    const int c = lane & 7;
#pragma unroll
    for (int j = 0; j < 8; ++j) { const int n = (lane >> 3) + 8 * j; const LAS float* s = scr + (8 * c) * 65 + n;
        v4u o; o.x = cvtpk(s[0 * 65], s[1 * 65]); o.y = cvtpk(s[2 * 65], s[3 * 65]); o.z = cvtpk(s[4 * 65], s[5 * 65]); o.w = cvtpk(s[6 * 65], s[7 * 65]);
        *(GAS v4u*)(WT + (size_t)dest_row(n0 + n, mode) * ldk + k0 + 8 * c) = o; }
    LDS_WAIT(); asm volatile("" ::: "memory");
}
__device__ __forceinline__ void convert_weights(Frame& F, int l) {
    LAS float* scr = (LAS float*)(F.lds + F.wave * 16640);
    const int gw = F.vcu * NWAVES + F.wave, NGW = F.G * NWAVES;
    constexpr int I_IN = (DM / 64) * (DIN / 64), I_OUT = (DM / 64) * (DM / 64), I_GU = NE * (DM / 64) * (DE / 64), I_D = NE * (DE / 64) * (DM / 64);
    constexpr int I_PW = (DCONF / 64) * (DCONF / 64), I_LW = 8;
    constexpr int NITEMS = I_IN + I_OUT + 2 * I_GU + I_D + I_PW + I_LW;
    for (int it = gw; it < NITEMS; it += NGW) {
        int r = it;
        if (r < 2 * I_GU) { const int up = r >= I_GU; if (up) r -= I_GU; const int e = r / 128, q = r % 128, kb = q / 8, nb = q % 8; const float* src = F.in[up ? 24 : 23] + (size_t)l * NE * DM * DE + (size_t)e * DM * DE;
            transpose_item(src, DE, 64 * kb, 64 * nb, F.in[20] + l * DM, (bf16*)(F.ws + WS_W1) + (size_t)e * 1024 * 1024, DM, up ? 3 : 2, scr, F.lane); continue; } r -= 2 * I_GU;
        if (r < I_D) { const int e = r / 128, q = r % 128, kb = q / 16, nb = q % 16; transpose_item(F.in[25] + (size_t)l * NE * DE * DM + (size_t)e * DE * DM, DM, 64 * kb, 64 * nb, nullptr, (bf16*)(F.ws + WS_W2) + (size_t)e * 1024 * 512, DE, 0, scr, F.lane); continue; } r -= I_D;
        if (r < I_IN) { const int kb = r / (DIN / 64), nb = r % (DIN / 64); transpose_item(F.in[2] + (size_t)l * DM * DIN, DIN, 64 * kb, 64 * nb, F.in[1] + l * DM, (bf16*)(F.ws + WS_WIN), DM, 1, scr, F.lane); continue; } r -= I_IN;
        if (r < I_OUT) { const int kb = r / 16, nb = r % 16; transpose_item(F.in[19] + (size_t)l * DM * DM, DM, 64 * kb, 64 * nb, F.in[18] + l * DM, (bf16*)(F.ws + WS_WOUT), DM, 0, scr, F.lane); continue; } r -= I_OUT;
        if (r < I_PW) { const int kb = r / 4, nb = r % 4; transpose_item(F.in[16] + (size_t)l * DCONF * DCONF, DCONF, 64 * kb, 64 * nb, nullptr, (bf16*)(F.ws + WS_PW), DCONF, 0, scr, F.lane); continue; } r -= I_PW;
        { const int mat = r; const float* src = F.in[mat < 4 ? 7 : 9] + (size_t)l * 4 * 64 * 64 + (size_t)(mat & 3) * 64 * 64; transpose_item(src, 64, 0, 0, nullptr, (bf16*)(F.ws + WS_LRUW) + (size_t)mat * 64 * 64, 64, 0, scr, F.lane); }
    }
    const float* g2 = F.in[20] + l * DM; const float* rc = F.in[21] + (size_t)l * DM * 4; const float* rf = F.in[22] + (size_t)l * DM * NE; bf16* WRH = (bf16*)(F.ws + WS_WR); bf16* WRL = WRH + NRTP * DM;
    for (int idx = (F.vcu * NTHR + F.tid); idx < NRTP * DM; idx += F.G * NTHR) { const int n = idx / DM, k = idx % DM;
        float v = 0.f; if (n < 4) v = rc[k * 4 + n] * g2[k]; else if (n < NRT) v = rf[k * NE + (n - 4)] * g2[k];
        const unsigned h = cvtpk(v, 0.f) & 0xffffu; const float r = v - __uint_as_float(h << 16); WRH[idx] = (bf16)h; WRL[idx] = (bf16)(cvtpk(r, 0.f) & 0xffffu); }
    LDS_WAIT(); WG_SYNC();
}
__device__ __forceinline__ void x_to_bf16_rows(Frame& F, const float* x, bf16* XB, float* RS1) {
    const int gw = F.vcu * NWAVES + F.wave, NGW = F.G * NWAVES;
    for (int m = 2 * gw; m < MTOK; m += 2 * NGW) {
        f32x4 v[2][4]; float s[2] = {0.f, 0.f};
#pragma unroll
        for (int q = 0; q < 2; ++q) { const GAS f32x4* xr = (const GAS f32x4*)(x + (size_t)(m + q) * DM) + F.lane;
#pragma unroll
            for (int j = 0; j < 4; ++j) v[q][j] = xr[64 * j]; }
#pragma unroll
        for (int q = 0; q < 2; ++q) {
#pragma unroll
            for (int j = 0; j < 4; ++j) s[q] += (v[q][j].x * v[q][j].x + v[q][j].y * v[q][j].y) + (v[q][j].z * v[q][j].z + v[q][j].w * v[q][j].w);
            s[q] = wave_sum(s[q]);
            GAS u32x2* o8 = (GAS u32x2*)(XB + (size_t)(m + q) * DM) + F.lane;
#pragma unroll
            for (int j = 0; j < 4; ++j) { u32x2 w; w.x = cvtpk(v[q][j].x, v[q][j].y); w.y = cvtpk(v[q][j].z, v[q][j].w); o8[64 * j] = w; }
            if (F.lane == 0) RS1[m + q] = __builtin_amdgcn_rsqf(s[q] * (1.0f / DM) + EPSN); }
    }
}

namespace att {
constexpr int SLOT16 = 16384, NSLOT = 5, L_OST = NSLOT * SLOT16, L_FLAG = L_OST + NWAVES * 4096;
__device__ __forceinline__ int crow(int r, int hi) { return (r & 3) + 8 * (r >> 2) + 4 * hi; }
typedef const LAS unsigned char* lptr;
template <bool DIAG> __device__ __forceinline__ void tile(lptr kslot, int vb, const bf16x8 (&qr)[4], f32x16 (&o)[2], float& R, int kbase, int qpos, int r32, int hi) {
    f32x16 p0 = f32x16{}, p1 = f32x16{};
    { lptr kb = kslot + hi * 1024 + r32 * 16;
#pragma unroll
      for (int d0 = 0; d0 < 4; ++d0) { const bf16x8 b0 = *(const LAS bf16x8*)(kb + d0 * 2048), b1 = *(const LAS bf16x8*)(kb + d0 * 2048 + 512);
          p0 = __builtin_amdgcn_mfma_f32_32x32x16_bf16(b0, qr[d0], p0, 0, 0, 0); p1 = __builtin_amdgcn_mfma_f32_32x32x16_bf16(b1, qr[d0], p1, 0, 0, 0); } }
    f32x16 K0, K1;
#pragma unroll
    for (int r = 0; r < 16; ++r) {
        const int kk = kbase + (r & 3) + 8 * (r >> 2);
        { const float x = __builtin_amdgcn_fmed3f(p0[r], -100.f, 100.f); const float e = fexp2(-x); float bt = frcp(1.0f + e); float kp = e * bt; if (DIAG && !(kk < qpos)) { kp = 1.f; bt = 0.f; } K0[r] = kp; p0[r] = bt; }
        { const float x = __builtin_amdgcn_fmed3f(p1[r], -100.f, 100.f); const float e = fexp2(-x); float bt = frcp(1.0f + e); float kp = e * bt; if (DIAG && !(kk + 32 < qpos)) { kp = 1.f; bt = 0.f; } K1[r] = kp; p1[r] = bt; }
    }
    float Gs[2][4], T[2][4];
#pragma unroll
    for (int bq = 0; bq < 4; ++bq) {
        const float g0 = (K0[4 * bq] * K0[4 * bq + 1]) * (K0[4 * bq + 2] * K0[4 * bq + 3]), g1 = (K1[4 * bq] * K1[4 * bq + 1]) * (K1[4 * bq + 2] * K1[4 * bq + 3]);
        auto r0 = __builtin_amdgcn_permlane32_swap(__float_as_uint(g0), __float_as_uint(g0), false, false);
        auto r1 = __builtin_amdgcn_permlane32_swap(__float_as_uint(g1), __float_as_uint(g1), false, false);
        Gs[0][bq] = hi ? 1.0f : __uint_as_float(r0[1]); T[0][bq] = __uint_as_float(r0[0]) * __uint_as_float(r0[1]);
        Gs[1][bq] = hi ? 1.0f : __uint_as_float(r1[1]); T[1][bq] = __uint_as_float(r1[0]) * __uint_as_float(r1[1]);
    }
    float cum = fexp2(R), tt0 = 1.0f, tt1 = 1.0f;
#pragma unroll
    for (int a = 1; a >= 0; --a)
#pragma unroll
        for (int bq = 3; bq >= 0; --bq) {
            const float s3 = cum * Gs[a][bq];
            if (a == 1) { const float s2 = s3 * K1[4 * bq + 3], s1 = s2 * K1[4 * bq + 2], s0 = s1 * K1[4 * bq + 1];
                p1[4 * bq + 3] *= s3; p1[4 * bq + 2] *= s2; p1[4 * bq + 1] *= s1; p1[4 * bq] *= s0; }
            else { const float s2 = s3 * K0[4 * bq + 3], s1 = s2 * K0[4 * bq + 2], s0 = s1 * K0[4 * bq + 1];
                p0[4 * bq + 3] *= s3; p0[4 * bq + 2] *= s2; p0[4 * bq + 1] *= s1; p0[4 * bq] *= s0; }
            cum *= T[a][bq]; if (a == 1) tt1 *= T[a][bq]; else tt0 *= T[a][bq];
        }
    R += flog2(tt1) + flog2(tt0);
    v4u pw0, pw1, pw2, pw3;
    pw0.x = cvtpk(p0[0], p0[1]); pw0.y = cvtpk(p0[2], p0[3]); pw0.z = cvtpk(p0[4], p0[5]); pw0.w = cvtpk(p0[6], p0[7]);
    pw1.x = cvtpk(p0[8], p0[9]); pw1.y = cvtpk(p0[10], p0[11]); pw1.z = cvtpk(p0[12], p0[13]); pw1.w = cvtpk(p0[14], p0[15]);
    pw2.x = cvtpk(p1[0], p1[1]); pw2.y = cvtpk(p1[2], p1[3]); pw2.z = cvtpk(p1[4], p1[5]); pw2.w = cvtpk(p1[6], p1[7]);
    pw3.x = cvtpk(p1[8], p1[9]); pw3.y = cvtpk(p1[10], p1[11]); pw3.z = cvtpk(p1[12], p1[13]); pw3.w = cvtpk(p1[14], p1[15]);
#pragma unroll
    for (int d0 = 0; d0 < 2; ++d0) { s16x4 lo[4], hh[4];
#pragma unroll
        for (int ks = 0; ks < 4; ++ks) {
            asm volatile("ds_read_b64_tr_b16 %0,%1 offset:%c2" : "=&v"(lo[ks]) : "v"(vb), "i"(d0 * 4096 + ks * 1024) : "memory");
            asm volatile("ds_read_b64_tr_b16 %0,%1 offset:%c2" : "=&v"(hh[ks]) : "v"(vb), "i"(d0 * 4096 + ks * 1024 + 512) : "memory"); }
        asm volatile("s_waitcnt lgkmcnt(0)" ::: "memory"); __builtin_amdgcn_sched_barrier(0);
#define ATT_PK(k) (bf16x8){lo[k][0], lo[k][1], lo[k][2], lo[k][3], hh[k][0], hh[k][1], hh[k][2], hh[k][3]}
        o[d0] = __builtin_amdgcn_mfma_f32_32x32x16_bf16(__builtin_bit_cast(bf16x8, pw0), ATT_PK(0), o[d0], 0, 0, 0);
        o[d0] = __builtin_amdgcn_mfma_f32_32x32x16_bf16(__builtin_bit_cast(bf16x8, pw1), ATT_PK(1), o[d0], 0, 0, 0);
        o[d0] = __builtin_amdgcn_mfma_f32_32x32x16_bf16(__builtin_bit_cast(bf16x8, pw2), ATT_PK(2), o[d0], 0, 0, 0);
        o[d0] = __builtin_amdgcn_mfma_f32_32x32x16_bf16(__builtin_bit_cast(bf16x8, pw3), ATT_PK(3), o[d0], 0, 0, 0);
#undef ATT_PK
    }
}
__device__ __forceinline__ void unit(Frame& F, int b, int h, int qb, const bf16* PROJ, bf16* Y) {
    const int lane = (opq((int)threadIdx.x) & 63), r32 = lane & 31, hi = lane >> 5, wid = F.wave;
    LAS unsigned char* shm = F.lds;
    const long rowbase = (long)b * SEQ; const int q0 = qb * 256;
    const bf16* Qw = PROJ + (rowbase + q0 + wid * 32) * DIN + COL_Q + h * HD;
    const bf16* Kh = PROJ + rowbase * DIN + COL_K + h * HD; const bf16* Vh = PROJ + rowbase * DIN + COL_V + h * HD;
    bf16x8 qr[4];
#pragma unroll
    for (int d0 = 0; d0 < 4; ++d0) qr[d0] = *(const GAS bf16x8*)(Qw + (long)r32 * DIN + d0 * 16 + hi * 8);
    f32x16 o[2]; o[0] = f32x16{}; o[1] = f32x16{};
    float R = 0.f;
    const int Dt = 4 * qb + (wid >> 1);
    const int qpos = q0 + wid * 32 + r32;
    bool wave_done = false;
    const bf16* ksrc = Kh + (long)lane * DIN + wid * 8;
    const bf16* vsrc = Vh + (long)(16 * (wid & 3) + (lane >> 2)) * DIN + (wid >> 2) * 32 + (lane & 3) * 8;
    LAS unsigned char* kdst = shm + wid * 1024 + lane * 16; LAS unsigned char* vdst = shm + 8192 + wid * 1024 + lane * 16;
    const int vb0 = (int)(uintptr_t)(shm + 8192) + ((lane >> 4) & 1) * 32 + (lane & 3) * 8 + (4 * hi + ((lane & 15) >> 2)) * 64;
    volatile LAS int* flag = (volatile LAS int*)(shm + L_FLAG);
    { v4u kr[4], vr[4];
#pragma unroll
      for (int p = 0; p < 4; ++p) { kr[p] = *(const GAS v4u*)(ksrc + (long)(4 * qb + p) * 64 * DIN); vr[p] = *(const GAS v4u*)(vsrc + (long)(4 * qb + p) * 64 * DIN); }
#pragma unroll
      for (int p = 0; p < 4; ++p) { const int sl = (4 * qb + p) % NSLOT; *(LAS v4u*)(kdst + sl * SLOT16) = kr[p]; *(LAS v4u*)(vdst + sl * SLOT16) = vr[p]; } }
    LDS_WAIT(); WG_SYNC();
    v4u kreg, vreg;
    for (int j = 0;; ++j) {
        const int tn = 4 * qb - j - 1;
        if (tn >= 0) { kreg = *(const GAS v4u*)(ksrc + (long)tn * 64 * DIN); vreg = *(const GAS v4u*)(vsrc + (long)tn * 64 * DIN); }
        const int t = Dt - j; const int s = (t >= 0) ? (t % NSLOT) : 0;
        if (t >= 0 && !wave_done) {
            if (j == 0) tile<true>(shm + s * SLOT16, vb0 + s * SLOT16, qr, o, R, t * 64 + 4 * hi, qpos, r32, hi);
            else tile<false>(shm + s * SLOT16, vb0 + s * SLOT16, qr, o, R, t * 64 + 4 * hi, qpos, r32, hi);
            wave_done = __all(R < -EXIT_THR2);
        }
        if (t <= 0) wave_done = true;
        if (lane == 0) flag[(j & 1) * 8 + wid] = wave_done ? 1 : 0;
        if (tn >= 0) { const int sl = tn % NSLOT; *(LAS v4u*)(kdst + sl * SLOT16) = kreg; *(LAS v4u*)(vdst + sl * SLOT16) = vreg; }
        LDS_WAIT(); WG_SYNC();
        int alld = 1;
#pragma unroll
        for (int w = 0; w < 8; ++w) alld &= flag[(j & 1) * 8 + w];
        if (alld) break;
    }
    { LAS bf16* stg = (LAS bf16*)(shm + L_OST) + wid * 2048;
#pragma unroll
      for (int r = 0; r < 16; ++r) { const int orow = crow(r, hi);
#pragma unroll
          for (int d0 = 0; d0 < 2; ++d0) stg[orow * 64 + d0 * 32 + r32] = (bf16)(cvtpk(o[d0][r], 0.f) & 0xffffu); }
      LDS_WAIT(); asm volatile("" ::: "memory");
      bf16* Ow = Y + (rowbase + q0 + wid * 32) * DM + h * HD;
#pragma unroll
      for (int i = 0; i < 4; ++i) { const int row = i * 8 + (lane >> 3), ch = lane & 7; const v4u v = *(const LAS v4u*)(stg + row * 64 + ch * 8); *(GAS v4u*)(Ow + (long)row * DM + ch * 8) = v; } }
    LDS_WAIT(); WG_SYNC();
}
}

namespace conf {
constexpr int TM = 64, HALO = 30, UROWS = TM + HALO;
constexpr int L_U = 0  , L_Z = 49152  , L_S = 0  , ZS = 260, SS = 264;
__device__ __forceinline__ void unit(Frame& F, int ut, int l, const bf16* PROJ, bf16* Y) {
    const int tid = opq((int)threadIdx.x), lane = tid & 63, wid = F.wave;
    const int row0 = ut * TM; const int t0 = row0 % SEQ;
    LAS bf16* U = (LAS bf16*)(F.lds + L_U); LAS float* Z = (LAS float*)(F.lds + L_Z); LAS bf16* S = (LAS bf16*)(F.lds + L_S);
    const float* dw_w = F.in[12] + (size_t)l * 31 * DCONF; const float* dw_b = F.in[13] + l * DCONF; const float* ln_g = F.in[14] + l * DCONF; const float* ln_b = F.in[15] + l * DCONF;
    const float* pw_b = F.in[17] + l * DCONF; const bf16* PW = (const bf16*)(F.ws + WS_PW);
    bf16x8 bfr[8][2];
    { const int fr_ = lane & 15, fq_ = lane >> 4;
#pragma unroll
      for (int ks = 0; ks < 8; ++ks)
#pragma unroll
          for (int n = 0; n < 2; ++n) bfr[ks][n] = *(const GAS bf16x8*)(PW + (size_t)(32 * wid + 16 * n + fr_) * DCONF + 32 * ks + 8 * fq_); }
    { const int c8 = tid & 31, ur0 = tid >> 5; v4u av[6], gv[6];
#pragma unroll
      for (int it = 0; it < 6; ++it) { const int ur = ur0 + 16 * it; const int t = t0 - HALO + ur; av[it] = (v4u){0u, 0u, 0u, 0u}; gv[it] = av[it];
          if (ur < UROWS && t >= 0) { const bf16* pr = PROJ + (size_t)(row0 - HALO + ur) * DIN + COL_XC + c8 * 8; av[it] = *(const GAS v4u*)pr; gv[it] = *(const GAS v4u*)(pr + 256); } }
#pragma unroll
      for (int it = 0; it < 6; ++it) { const int ur = ur0 + 16 * it; if (ur < UROWS) { const unsigned a4[4] = {av[it].x, av[it].y, av[it].z, av[it].w}, g4[4] = {gv[it].x, gv[it].y, gv[it].z, gv[it].w}; unsigned ov[4];
#pragma unroll
              for (int j = 0; j < 4; ++j) ov[j] = cvtpk(bflo(a4[j]) * sigmoidf_(bflo(g4[j])), bfhi(a4[j]) * sigmoidf_(bfhi(g4[j])));
              *(LAS v4u*)(U + ur * 256 + c8 * 8) = (v4u){ov[0], ov[1], ov[2], ov[3]}; } } }
    LDS_WAIT(); WG_SYNC();
    { const int c = tid & 255, hf = tid >> 8; float w[31];
#pragma unroll
      for (int j = 0; j < 31; ++j) w[j] = dw_w[j * DCONF + c];
      const float bias = dw_b[c]; float acc[32];
#pragma unroll
      for (int i = 0; i < 32; ++i) acc[i] = bias;
      const LAS bf16* up = U + (hf * 32) * 256 + c;
#pragma unroll
      for (int rho = 0; rho < 62; ++rho) { const float x = __uint_as_float((unsigned)up[rho * 256] << 16);
#pragma unroll
          for (int i = 0; i < 32; ++i) { const int j = rho - i; if (j >= 0 && j <= 30) acc[i] += w[j] * x; } }
#pragma unroll
      for (int i = 0; i < 32; ++i) Z[(hf * 32 + i) * ZS + c] = acc[i]; }
    LDS_WAIT(); WG_SYNC();
    { const f32x4 g = *(const GAS f32x4*)(ln_g + 4 * lane), bb = *(const GAS f32x4*)(ln_b + 4 * lane);
      for (int i = 0; i < 8; ++i) { const int tk = wid * 8 + i; f32x4 v = *(const LAS f32x4*)(Z + tk * ZS + 4 * lane);
          const float mean = wave_sum((v.x + v.y) + (v.z + v.w)) * (1.0f / 256.0f); v = v - mean;
          const float var = wave_sum((v.x * v.x + v.y * v.y) + (v.z * v.z + v.w * v.w)) * (1.0f / 256.0f); const float rstd = __builtin_amdgcn_rsqf(var + EPSN);
          f32x4 y = v * rstd * g + bb; y.x *= sigmoidf_(y.x); y.y *= sigmoidf_(y.y); y.z *= sigmoidf_(y.z); y.w *= sigmoidf_(y.w);
          u32x2 w2; w2.x = cvtpk(y.x, y.y); w2.y = cvtpk(y.z, y.w); *(LAS u32x2*)(S + tk * SS + 4 * lane) = w2; } }
    LDS_WAIT(); WG_SYNC();
    { const int fr = lane & 15, fq = lane >> 4; f32x4 acc[4][2];
#pragma unroll
      for (int m = 0; m < 4; ++m) { acc[m][0] = (f32x4){0.f, 0.f, 0.f, 0.f}; acc[m][1] = (f32x4){0.f, 0.f, 0.f, 0.f}; }
#pragma unroll
      for (int ks = 0; ks < 8; ++ks) { bf16x8 afr[4];
#pragma unroll
          for (int m = 0; m < 4; ++m) afr[m] = *(const LAS bf16x8*)(S + (16 * m + fr) * SS + 32 * ks + 8 * fq);
#pragma unroll
          for (int m = 0; m < 4; ++m)
#pragma unroll
              for (int n = 0; n < 2; ++n) acc[m][n] = __builtin_amdgcn_mfma_f32_16x16x32_bf16(afr[m], bfr[ks][n], acc[m][n], 0, 0, 0); }
#pragma unroll
      for (int m = 0; m < 4; ++m)
#pragma unroll
          for (int n = 0; n < 2; ++n)
#pragma unroll
              for (int i = 0; i < 4; ++i) Z[(16 * m + 4 * fq + i) * ZS + 32 * wid + 16 * n + fr] = acc[m][n][i]; }
    LDS_WAIT(); WG_SYNC();
    { const f32x4 pb = *(const GAS f32x4*)(pw_b + 4 * lane);
      for (int i = 0; i < 8; ++i) { const int tk = wid * 8 + i; f32x4 v = *(const LAS f32x4*)(Z + tk * ZS + 4 * lane) + pb;
          const float ss = wave_sum((v.x * v.x + v.y * v.y) + (v.z * v.z + v.w * v.w)); const float rs = __builtin_amdgcn_rsqf(ss * (1.0f / 256.0f) + EPSN); v = v * rs;
          u32x2 w2; w2.x = cvtpk(v.x, v.y); w2.y = cvtpk(v.z, v.w); *(GAS u32x2*)(Y + (size_t)(row0 + tk) * DM + 768 + 4 * lane) = w2; } }
    LDS_WAIT(); WG_SYNC();
}
}

namespace lru {
constexpr int TM = 64, XS_ = 260, XBS = 264;
constexpr int L_XC = 0  , L_A = 66560  , L_XB = 66560  ;
__device__ __forceinline__ void unit(Frame& F, int ut, int l, const bf16* PROJ, bf16* HL, bf16* PL, float* SUMM) {
    const int tid = opq((int)threadIdx.x), lane = tid & 63, wid = F.wave;
    const int row0 = ut * TM; const int t0 = row0 % SEQ;
    LAS float* XC = (LAS float*)(F.lds + L_XC); LAS float* A = (LAS float*)(F.lds + L_A); LAS bf16* XB = (LAS bf16*)(F.lds + L_XB);
    const float* cw = F.in[5] + (size_t)l * 4 * DLRU; const float* cb = F.in[6] + l * DLRU; const float* ba = F.in[8] + l * DLRU; const float* bx = F.in[10] + l * DLRU; const float* lam = F.in[11] + l * DLRU;
    const bf16* LW = (const bf16*)(F.ws + WS_LRUW);
    const int nb = wid >> 1, mh = wid & 1, fr = lane & 15, fq = lane >> 4;
    bf16x8 bA[2][4], bX[2][4];
#pragma unroll
    for (int ks = 0; ks < 2; ++ks)
#pragma unroll
        for (int n = 0; n < 4; ++n) { bA[ks][n] = *(const GAS bf16x8*)(LW + (size_t)nb * 4096 + (16 * n + fr) * 64 + 32 * ks + 8 * fq); bX[ks][n] = *(const GAS bf16x8*)(LW + (size_t)(4 + nb) * 4096 + (16 * n + fr) * 64 + 32 * ks + 8 * fq); }
    { const int c8 = tid & 31, tk0 = tid >> 5; f32x4 w0[4], w1[4];
#pragma unroll
      for (int j = 0; j < 4; ++j) { w0[j] = *(const GAS f32x4*)(cw + j * DLRU + c8 * 8); w1[j] = *(const GAS f32x4*)(cw + j * DLRU + c8 * 8 + 4); }
      const f32x4 b0 = *(const GAS f32x4*)(cb + c8 * 8), b1 = *(const GAS f32x4*)(cb + c8 * 8 + 4);
      v4u xr[4][4];
#pragma unroll
      for (int it = 0; it < 4; ++it)
#pragma unroll
          for (int j = 0; j < 4; ++j) { const int tk = tk0 + 16 * it; xr[it][j] = (v4u){0u, 0u, 0u, 0u}; if (t0 + tk - 3 + j >= 0) xr[it][j] = *(const GAS v4u*)(PROJ + (size_t)(row0 + tk - 3 + j) * DIN + COL_XR + c8 * 8); }
#pragma unroll
      for (int it = 0; it < 4; ++it) { const int tk = tk0 + 16 * it; float acc[8] = {b0.x, b0.y, b0.z, b0.w, b1.x, b1.y, b1.z, b1.w};
#pragma unroll
          for (int j = 0; j < 4; ++j) { const v4u a = xr[it][j];
              acc[0] += w0[j].x * bflo(a.x); acc[1] += w0[j].y * bfhi(a.x); acc[2] += w0[j].z * bflo(a.y); acc[3] += w0[j].w * bfhi(a.y);
              acc[4] += w1[j].x * bflo(a.z); acc[5] += w1[j].y * bfhi(a.z); acc[6] += w1[j].z * bflo(a.w); acc[7] += w1[j].w * bfhi(a.w); }
          *(LAS f32x4*)(XC + tk * XS_ + c8 * 8) = (f32x4){acc[0], acc[1], acc[2], acc[3]}; *(LAS f32x4*)(XC + tk * XS_ + c8 * 8 + 4) = (f32x4){acc[4], acc[5], acc[6], acc[7]};
          v4u o; o.x = cvtpk(acc[0], acc[1]); o.y = cvtpk(acc[2], acc[3]); o.z = cvtpk(acc[4], acc[5]); o.w = cvtpk(acc[6], acc[7]); *(LAS v4u*)(XB + tk * XBS + c8 * 8) = o; } }
    LDS_WAIT(); WG_SYNC();
    f32x4 ar[2][4], ai[2][4];
#pragma unroll
    for (int m = 0; m < 2; ++m)
#pragma unroll
        for (int n = 0; n < 4; ++n) { ar[m][n] = (f32x4){0.f, 0.f, 0.f, 0.f}; ai[m][n] = (f32x4){0.f, 0.f, 0.f, 0.f}; }
#pragma unroll
    for (int ks = 0; ks < 2; ++ks) { bf16x8 af[2];
#pragma unroll
        for (int m = 0; m < 2; ++m) af[m] = *(const LAS bf16x8*)(XB + (32 * mh + 16 * m + fr) * XBS + 64 * nb + 32 * ks + 8 * fq);
#pragma unroll
        for (int n = 0; n < 4; ++n) {
#pragma unroll
            for (int m = 0; m < 2; ++m) { ar[m][n] = __builtin_amdgcn_mfma_f32_16x16x32_bf16(af[m], bA[ks][n], ar[m][n], 0, 0, 0); ai[m][n] = __builtin_amdgcn_mfma_f32_16x16x32_bf16(af[m], bX[ks][n], ai[m][n], 0, 0, 0); } } }
    LDS_WAIT(); WG_SYNC();
#pragma unroll
    for (int n = 0; n < 4; ++n) { const int ch = 64 * nb + 16 * n + fr; const float lsl8 = -8.0f * log1pf(__expf(-lam[ch])), bav = ba[ch], bxv = bx[ch];
#pragma unroll
        for (int m = 0; m < 2; ++m)
#pragma unroll
            for (int i = 0; i < 4; ++i) { const int tk = 32 * mh + 16 * m + 4 * fq + i; const float gr = ar[m][n][i] + bav, gi = ai[m][n][i] + bxv; const float xcv = XC[tk * XS_ + ch];
                const float la = lsl8 * sigmoidf_(gr); const float a = fexp2(LOG2E * la); const float mult = __builtin_sqrtf(__builtin_fmaxf(1.0f - a * a, 0.f));
                A[tk * XS_ + ch] = a; XC[tk * XS_ + ch] = mult * sigmoidf_(gi) * xcv; } }
    LDS_WAIT(); WG_SYNC();
    if (tid < 256) { const int c = tid; float h = 0.f, p = 1.f; bf16* hl = HL + (size_t)row0 * DLRU + c; bf16* pl = PL + (size_t)row0 * DLRU + c;
#pragma unroll 8
        for (int tk = 0; tk < TM; ++tk) { const float a = A[tk * XS_ + c], u = XC[tk * XS_ + c]; p *= a; h = a * h + u; hl[(size_t)tk * DLRU] = (bf16)(cvtpk(h, 0.f) & 0xffffu); pl[(size_t)tk * DLRU] = (bf16)(cvtpk(p, 0.f) & 0xffffu); }
        SUMM[(size_t)ut * 512 + c] = p; SUMM[(size_t)ut * 512 + 256 + c] = h; }
    LDS_WAIT(); WG_SYNC();
}
}

__device__ __forceinline__ void fixup_unit(Frame& F, int ut, const bf16* PROJ, const bf16* HL, const bf16* PL, const float* SUMM, bf16* Y) {
    const int tid = opq((int)threadIdx.x), lane = tid & 63, wid = F.wave; const int row0 = ut * 64; const int cb = (row0 % SEQ) / 64, ub0 = ut - cb;
    LAS float* CAR = (LAS float*)F.lds;
    { const int c = tid & 255, hf = tid >> 8; const int mid = cb >> 1; const int j0 = hf ? mid : 0, j1 = hf ? cb : mid; float P = 1.f, H = 0.f;
#pragma unroll 16
      for (int j = j0; j < j1; ++j) { const float p = SUMM[(size_t)(ub0 + j) * 512 + c], h = SUMM[(size_t)(ub0 + j) * 512 + 256 + c]; H = p * H + h; P = p * P; }
      CAR[hf * 512 + c] = P; CAR[hf * 512 + 256 + c] = H; }
    LDS_WAIT(); WG_SYNC();
    f32x4 car;
    { const f32x4 h0 = *(const LAS f32x4*)(CAR + 256 + 4 * lane), p1 = *(const LAS f32x4*)(CAR + 512 + 4 * lane), h1 = *(const LAS f32x4*)(CAR + 768 + 4 * lane); car = p1 * h0 + h1; }
#pragma unroll 4
    for (int i = 0; i < 8; ++i) { const size_t row = (size_t)row0 + wid * 8 + i;
        const u32x2 hl = *(const GAS u32x2*)(HL + row * DLRU + 4 * lane), pl = *(const GAS u32x2*)(PL + row * DLRU + 4 * lane);
        const u32x2 xg = *(const GAS u32x2*)(PROJ + row * DIN + COL_XG + 4 * lane); const v4u ya = *(const GAS v4u*)(Y + row * DM + 8 * lane);
        const float hv[4] = {bflo(hl.x) + bflo(pl.x) * car.x, bfhi(hl.x) + bfhi(pl.x) * car.y, bflo(hl.y) + bflo(pl.y) * car.z, bfhi(hl.y) + bfhi(pl.y) * car.w};
        const float xv[4] = {bflo(xg.x), bfhi(xg.x), bflo(xg.y), bfhi(xg.y)}; float y[4];
#pragma unroll
        for (int j = 0; j < 4; ++j) { const float x = xv[j]; const float u2 = 1.5957691216057308f * (x + 0.044715f * x * x * x); y[j] = hv[j] * x * sigmoidf_(u2); }
        const float ssb = wave_sum((y[0] * y[0] + y[1] * y[1]) + (y[2] * y[2] + y[3] * y[3])); const float rsb = __builtin_amdgcn_rsqf(ssb * (1.0f / 256.0f) + EPSN);
        u32x2 w2; w2.x = cvtpk(y[0] * rsb, y[1] * rsb); w2.y = cvtpk(y[2] * rsb, y[3] * rsb); *(GAS u32x2*)(Y + row * DM + 512 + 4 * lane) = w2;
        float a[8] = {bflo(ya.x), bfhi(ya.x), bflo(ya.y), bfhi(ya.y), bflo(ya.z), bfhi(ya.z), bflo(ya.w), bfhi(ya.w)}; float ssa = 0.f;
#pragma unroll
        for (int j = 0; j < 8; ++j) ssa += a[j] * a[j];
        ssa = wave_sum(ssa); const float rsa = __builtin_amdgcn_rsqf(ssa * (1.0f / 512.0f) + EPSN);
        v4u oa; oa.x = cvtpk(a[0] * rsa, a[1] * rsa); oa.y = cvtpk(a[2] * rsa, a[3] * rsa); oa.z = cvtpk(a[4] * rsa, a[5] * rsa); oa.w = cvtpk(a[6] * rsa, a[7] * rsa);
        *(GAS v4u*)(Y + row * DM + 8 * lane) = oa; }
    LDS_WAIT(); WG_SYNC();
}

__device__ __forceinline__ void router_unit(Frame& F, int ut, int l, const bf16* X, float* RS2, int* TOKE, int* TOKR, int* STV, float* RSV, float* GTV) {
    const int tid = opq((int)threadIdx.x), lane = tid & 63, wid = F.wave, fr = lane & 15, fq = lane >> 4;
    constexpr int WROW = 1040, WHALF = NRTP * WROW;
    LAS unsigned char* WL_ = F.lds;
    LAS float* LG = (LAS float*)(F.lds + 102400) + wid * (16 * NRTP + 16);
    LAS int* CNT = (LAS int*)(F.lds + 102400 + 8 * (16 * NRTP + 16) * 4); LAS int* BASE = CNT + 32;
    if (tid < 32) CNT[tid] = 0;
    const int r0 = ut * 128 + wid * 16;
    const bf16* WRH = (const bf16*)(F.ws + WS_WR);
    f32x4 acc[3]; acc[0] = (f32x4){0.f, 0.f, 0.f, 0.f}; acc[1] = acc[0]; acc[2] = acc[0]; float ss = 0.f;
    const bf16* xp = X + (size_t)(r0 + fr) * DM + 8 * fq;
#pragma unroll 1
    for (int kh = 0; kh < 2; ++kh) {
        if (kh) { LDS_WAIT(); WG_SYNC(); }
        { v4u wv[12];
#pragma unroll
          for (int q = 0; q < 12; ++q) { const int ch = tid + q * NTHR, hl = ch / 3072, rr = (ch % 3072) >> 6, cc = ch & 63; wv[q] = *(const GAS v4u*)(WRH + (size_t)hl * NRTP * DM + (size_t)rr * DM + kh * 512 + cc * 8); }
#pragma unroll
          for (int q = 0; q < 12; ++q) { const int ch = tid + q * NTHR, hl = ch / 3072, rr = (ch % 3072) >> 6, cc = ch & 63; *(LAS v4u*)(WL_ + hl * WHALF + rr * WROW + cc * 16) = wv[q]; } }
        bf16x8 av[16];
#pragma unroll
        for (int s = 0; s < 16; ++s) av[s] = *(const GAS bf16x8*)(xp + kh * 512 + 32 * s);
        LDS_WAIT(); WG_SYNC();
#pragma unroll
        for (int s = 0; s < 16; ++s) {
#pragma unroll
            for (int j = 0; j < 8; ++j) { const float xv = __uint_as_float((unsigned)(unsigned short)av[s][j] << 16); ss += xv * xv; }
#pragma unroll
            for (int n = 0; n < 3; ++n) { const LAS unsigned char* wp = WL_ + (16 * n + fr) * WROW + (32 * s + 8 * fq) * 2;
                const bf16x8 bh = *(const LAS bf16x8*)wp, bl = *(const LAS bf16x8*)(wp + WHALF);
                acc[n] = __builtin_amdgcn_mfma_f32_16x16x32_bf16(av[s], bh, acc[n], 0, 0, 0); acc[n] = __builtin_amdgcn_mfma_f32_16x16x32_bf16(av[s], bl, acc[n], 0, 0, 0); } }
    }
    ss += __shfl_xor(ss, 16); ss += __shfl_xor(ss, 32);
    const float rs = __builtin_amdgcn_rsqf(ss * (1.0f / DM) + EPSN);
    if (fq == 0) LG[16 * NRTP + fr] = rs;
#pragma unroll
    for (int n = 0; n < 3; ++n)
#pragma unroll
        for (int i = 0; i < 4; ++i) LG[(4 * fq + i) * NRTP + 16 * n + fr] = acc[n][i];
    LDS_WAIT(); WG_SYNC();
    int e0 = 0, e1 = 0, lr0 = 0, lr1 = 0; float g0 = 0.f, g1 = 0.f, rsv = 0.f;
    if (lane < 16) { const LAS float* lg = LG + lane * NRTP; rsv = LG[16 * NRTP + lane];
        float c[4]; int grp = 0; float cm;
#pragma unroll
        for (int j = 0; j < 4; ++j) c[j] = lg[j] * rsv;
        cm = c[0];
#pragma unroll
        for (int j = 1; j < 4; ++j) if (c[j] > cm) { cm = c[j]; grp = j; }
        float den = 0.f;
#pragma unroll
        for (int j = 0; j < 4; ++j) den += __expf(c[j] - cm);
        const float wgrp = 1.0f / den;
        float v0 = -INFINITY, v1 = -INFINITY; int i0 = 0, i1 = 0;
#pragma unroll
        for (int j = 0; j < 8; ++j) { const float v = lg[4 + grp * 8 + j] * rsv; if (v > v0) { v1 = v0; i1 = i0; v0 = v; i0 = j; } else if (v > v1) { v1 = v; i1 = j; } }
        const float ex = __expf(v1 - v0); g0 = wgrp / (1.0f + ex); g1 = wgrp * ex / (1.0f + ex);
        e0 = grp * 8 + i0; e1 = grp * 8 + i1;
        lr0 = atomicAdd((int*)(CNT + e0), 1); lr1 = atomicAdd((int*)(CNT + e1), 1); }
    LDS_WAIT(); WG_SYNC();
    if (tid < 32) { const int c = CNT[tid]; int bse = 0; if (c > 0) bse = (int)__hip_atomic_fetch_add((unsigned*)(F.ctl + CW_CNT + 64 * l + tid), (unsigned)c, __ATOMIC_RELAXED, __HIP_MEMORY_SCOPE_AGENT); BASE[tid] = bse; }
    LDS_WAIT(); WG_SYNC();
    if (lane < 16) { const int tok = r0 + lane; const int k0 = BASE[e0] + lr0, k1 = BASE[e1] + lr1; RS2[tok] = rsv; TOKE[2 * tok] = e0; TOKE[2 * tok + 1] = e1; TOKR[2 * tok] = k0; TOKR[2 * tok + 1] = k1;
        STV[e0 * 32768 + k0] = tok; RSV[e0 * 32768 + k0] = rsv; GTV[e0 * 32768 + k0] = g0; STV[e1 * 32768 + k1] = tok; RSV[e1 * 32768 + k1] = rsv; GTV[e1 * 32768 + k1] = g1; }
    LDS_WAIT(); WG_SYNC();
}
__device__ __forceinline__ int moe_tables(Frame& F, int l, LAS int* PST, LAS int* CNT, LAS int* TE) {
    if (F.tid == 0) { int acc = 0; for (int e = 0; e < NE; ++e) { const int c = (int)__hip_atomic_load(F.ctl + CW_CNT + 64 * l + e, __ATOMIC_RELAXED, __HIP_MEMORY_SCOPE_AGENT); PST[e] = acc; CNT[e] = c; acc += (c + 255) & ~255; } PST[NE] = acc; }
    LDS_WAIT(); WG_SYNC();
    const int ntile = PST[NE] >> 8;
    for (int rt = F.tid; rt < ntile; rt += NTHR) { int e = 0;
        for (int j = 1; j < NE; ++j) if ((PST[j] >> 8) <= rt) e = j;
        TE[rt] = e; }
    LDS_WAIT(); WG_SYNC();
    return ntile;
}
__device__ __forceinline__ void combine_phase(Frame& F, int l, const bf16* X1, const int* TOKE, const int* TOKR, const bf16* OB, bool last_layer, bf16* X0, float* RS1, float* OUT) {
    LAS int* PST = (LAS int*)F.lds; LAS int* CNT = PST + 64; LAS int* TE = PST + 128;
    (void)moe_tables(F, l, PST, CNT, TE);
    const int gw = F.vcu * NWAVES + F.wave, NGW = F.G * NWAVES;
    for (int m = 2 * gw; m < MTOK; m += 2 * NGW) {
        u32x2 xv[2][4], oa[2][4], ob[2][4];
#pragma unroll
        for (int q = 0; q < 2; ++q) { const int mm = m + q; const int s0 = PST[TOKE[2 * mm]] + TOKR[2 * mm], s1 = PST[TOKE[2 * mm + 1]] + TOKR[2 * mm + 1];
            const GAS u32x2* xr = (const GAS u32x2*)(X1 + (size_t)mm * DM) + F.lane;
            const GAS u32x2* o0 = (const GAS u32x2*)(OB + (size_t)s0 * DM) + F.lane; const GAS u32x2* o1 = (const GAS u32x2*)(OB + (size_t)s1 * DM) + F.lane;
#pragma unroll
            for (int j = 0; j < 4; ++j) { xv[q][j] = xr[64 * j]; oa[q][j] = o0[64 * j]; ob[q][j] = o1[64 * j]; } }
#pragma unroll
        for (int q = 0; q < 2; ++q) { const int mm = m + q; float ss = 0.f; f32x4 v[4];
#pragma unroll
            for (int j = 0; j < 4; ++j) { const u32x2 x = xv[q][j], a = oa[q][j], b = ob[q][j];
                v[j].x = bflo(x.x) + (bflo(a.x) + bflo(b.x)); v[j].y = bfhi(x.x) + (bfhi(a.x) + bfhi(b.x)); v[j].z = bflo(x.y) + (bflo(a.y) + bflo(b.y)); v[j].w = bfhi(x.y) + (bfhi(a.y) + bfhi(b.y));
                ss += (v[j].x * v[j].x + v[j].y * v[j].y) + (v[j].z * v[j].z + v[j].w * v[j].w); }
            if (last_layer) { GAS f32x4* xw = (GAS f32x4*)(OUT + (size_t)mm * DM) + F.lane;
#pragma unroll
                for (int j = 0; j < 4; ++j) xw[64 * j] = v[j]; }
            else { ss = wave_sum(ss); GAS u32x2* o8 = (GAS u32x2*)(X0 + (size_t)mm * DM) + F.lane;
#pragma unroll
                for (int j = 0; j < 4; ++j) { u32x2 w; w.x = cvtpk(v[j].x, v[j].y); w.y = cvtpk(v[j].z, v[j].w); o8[64 * j] = w; }
                if (F.lane == 0) RS1[mm] = __builtin_amdgcn_rsqf(ss * (1.0f / DM) + EPSN); } }
    }
    LDS_WAIT(); WG_SYNC();
}

constexpr int PH_PER_LAYER = 8, N_PHASES = 1 + DEPTH * PH_PER_LAYER;
struct Args { const float* in[26]; float* out; unsigned char* ws; int ph_lo, ph_hi; };
__global__ void __launch_bounds__(NTHR, 2) mk_fwd(Args args) {
    extern __shared__ __attribute__((aligned(16))) unsigned char lds[];
    Frame F;
    F.lds = (LAS unsigned char*)lds;
    F.tid = threadIdx.x; F.lane = F.tid & 63; F.wave = __builtin_amdgcn_readfirstlane(F.tid >> 6);
    F.G = gridDim.x; { const int bx = blockIdx.x; F.vcu = (F.G % 8 == 0) ? (bx % 8) * (F.G / 8) + bx / 8 : bx; }
    F.in = args.in;
    F.out = args.out; F.ws = args.ws; F.ctl = (gu32*)(args.ws + WS_CTL);
    for (int u = F.tid; u < (LDS_BYTES - LDSCTL_OFF) / 4; u += NTHR) ((LAS unsigned*)(F.lds + LDSCTL_OFF))[u] = 0u;
    __syncthreads();
    const bool one_launch = (args.ph_hi - args.ph_lo) > 1;
    XcdBarrier bar; bar.bar = (unsigned*)(F.ctl + CW_BAR); bar.x = 0; bar.st = nullptr;
    if (one_launch) bar = xcd_barrier_post((unsigned*)(F.ctl + CW_BAR), (volatile LAS unsigned*)(F.lds + LDSCTL_OFF + 32));
    const int lo = args.ph_lo, hi = args.ph_hi;
#ifndef PH_MASK
#define PH_MASK 0x1fff
#endif
#define IN(k) (lo <= (k) && (k) < hi)
#define EN(j) (((PH_MASK) >> (j)) & 1)
#ifndef DBL_MASK
#define DBL_MASK 0
#endif
#define NREP(j) ((((DBL_MASK) >> (j)) & 1) ? 2 : 1)
#define PHASE_BEGIN() do { F.tid = opq((int)threadIdx.x); F.lane = F.tid & 63; F.wave = __builtin_amdgcn_readfirstlane(F.tid >> 6); { int v_ = F.vcu; asm volatile("" : "+s"(v_)); F.vcu = v_; } } while (0)
#define SEAM(k) do { if (IN(k) && IN((k) + 1)) xcd_barrier(bar); } while (0)
#define X0 ((bf16*)(F.ws + WS_X0))
#define X1 ((bf16*)(F.ws + WS_X1))
#define YB ((bf16*)F.out)
#define PROJ ((bf16*)(F.ws + WS_PROJ))
#define OB ((bf16*)(F.ws + WS_PROJ))
#define HB ((bf16*)(F.ws + WS_HP))
#define HL ((bf16*)(F.ws + WS_HP))
#define PL ((bf16*)(F.ws + WS_HP) + (size_t)MTOK * DLRU)
#define SUMM ((float*)(F.ws + WS_SUMM))
#define RS1 ((float*)(F.ws + WS_RS1))
#define RS2 ((float*)(F.ws + WS_RS2))
#define TOKE ((int*)(F.ws + WS_TOKE))
#define TOKR ((int*)(F.ws + WS_TOKR))
#define STV ((int*)(F.ws + WS_STV))
#define RSV ((float*)(F.ws + WS_RSV))
#define GTV ((float*)(F.ws + WS_GTV))
#define MOE_TABS() LAS int* PST = (LAS int*)(F.lds + SCR_BYTES - 2048); LAS int* CNTL = PST + 64; LAS int* TE = PST + 128; const int ntile = moe_tables(F, l, PST, CNTL, TE); \
    const pg8::MoeTabs tb{(const PG8_LAS int*)PST, (const PG8_LAS int*)CNTL, (const PG8_LAS int*)TE}

    if (EN(0) && IN(0)) { PHASE_BEGIN(); for (int rep = 0; rep < NREP(0); ++rep) { convert_weights(F, 0); x_to_bf16_rows(F, F.in[0], X0, RS1); }
        if (blockIdx.x == 0) { GAS unsigned* z = (GAS unsigned*)(X1 + (size_t)MTOK * DM); for (int i = F.tid; i < DM / 2; i += NTHR) z[i] = 0u; } }
    SEAM(0);
    if (NREP(13) > 1) for (int rep = 0; rep < 10; ++rep) SEAM(0);
#pragma unroll 1
    for (int l = 0; l < DEPTH; ++l) {
        const int pb = 1 + l * PH_PER_LAYER;
        if (EN(1) && IN(pb + 0)) { PHASE_BEGIN(); pg8::Gemm g{X0, (const bf16*)(F.ws + WS_WIN), MTOK, DIN, DM}; pg8::StaticOrder S; S.init(MTOK, DIN, F.G, (int)blockIdx.x);
            pg8::EpiProj E{PROJ, RS1, F.in[3] + l * HD, F.in[4] + l * HD, DIN, QSCALE};
            for (int rep = 0; rep < NREP(1); ++rep) pg8::gemm_phase<pg8::EpiProj, pg8::StaticOrder, true, true>(F.lds, g, S, E); }
        SEAM(pb + 0);
        if (EN(2) && IN(pb + 1)) { PHASE_BEGIN();
            if (EN(10)) for (int rep = 0; rep < NREP(2); ++rep) for (int a = F.vcu; a < NB * NH * (SEQ / 256); a += F.G) { const int qb = a & 31, bh = a >> 5; att::unit(F, bh >> 3, bh & 7, qb, PROJ, YB); }
            if (EN(11)) for (int rep = 0; rep < NREP(3); ++rep) for (int u = F.vcu; u < MTOK / 64; u += F.G) conf::unit(F, u, l, PROJ, YB);
            if (EN(12)) for (int rep = 0; rep < NREP(4); ++rep) for (int u = F.vcu; u < MTOK / 64; u += F.G) lru::unit(F, u, l, PROJ, HL, PL, SUMM);
        }
        SEAM(pb + 1);
        if (EN(3) && IN(pb + 2)) { PHASE_BEGIN(); for (int rep = 0; rep < NREP(5); ++rep) for (int u = F.vcu; u < MTOK / 64; u += F.G) fixup_unit(F, u, PROJ, HL, PL, SUMM, YB); }
        SEAM(pb + 2);
        if (EN(4) && IN(pb + 3)) { PHASE_BEGIN(); pg8::Gemm g{YB, (const bf16*)(F.ws + WS_WOUT), MTOK, DM, DM}; pg8::StaticOrder S; S.init(MTOK, DM, F.G, (int)blockIdx.x);
            pg8::EpiResid E{X0, X1, DM};
            for (int rep = 0; rep < NREP(6); ++rep) pg8::gemm_phase<pg8::EpiResid, pg8::StaticOrder, true, true>(F.lds, g, S, E); }
        SEAM(pb + 3);
        if (EN(5) && IN(pb + 4)) { PHASE_BEGIN(); for (int rep = NREP(10) - 1; rep >= 0; --rep) for (int u = F.vcu; u < MTOK / 128; u += F.G) router_unit(F, u, l + 2 * rep, X1, RS2, TOKE, TOKR, STV, RSV, GTV); }
        SEAM(pb + 4);
        if (EN(7) && IN(pb + 5)) { PHASE_BEGIN(); MOE_TABS();
            pg8::Gemm g{X1, (const bf16*)(F.ws + WS_W1), MAXSLOT, NE * 1024, DM}; pg8::MoeOrder<true> S{ntile * 4, F.G, F.vcu, tb, STV, MTOK};
            pg8::EpiSwiglu E{HB, RSV, DE, tb};
            for (int rep = 0; rep < NREP(8); ++rep) pg8::gemm_phase<pg8::EpiSwiglu, pg8::MoeOrder<true>, true, true>(F.lds, g, S, E); }
        SEAM(pb + 5);
        if (EN(8) && IN(pb + 6)) { PHASE_BEGIN(); MOE_TABS();
            pg8::Gemm g{HB, (const bf16*)(F.ws + WS_W2), MAXSLOT, NE * 1024, DE}; pg8::MoeOrder<false> S{ntile * 4, F.G, F.vcu, tb, STV, MTOK};
            pg8::EpiGate E{OB, GTV, DM, tb};
            for (int rep = 0; rep < NREP(9); ++rep) pg8::gemm_phase<pg8::EpiGate, pg8::MoeOrder<false>, true, true>(F.lds, g, S, E); }
        SEAM(pb + 6);
        if (EN(9) && IN(pb + 7)) { PHASE_BEGIN(); for (int rep = 0; rep < NREP(11); ++rep) combine_phase(F, l, X1, TOKE, TOKR, OB, l + 1 == DEPTH, X0, RS1, F.out); if (l + 1 < DEPTH) for (int rep = 0; rep < NREP(12); ++rep) convert_weights(F, l + 1); }
        if (l + 1 < DEPTH) SEAM(pb + 7);
    }
#undef IN
#undef SEAM
}

extern "C" void kernel_launch(void* const* d_in, const int* in_sizes, int n_in, void* d_out, int out_size, void* d_ws, size_t ws_size, hipStream_t stream) {
    static int grid = 0;
    if (grid == 0) {
        if (n_in != 26 || in_sizes[0] != MTOK * DM || out_size != MTOK * DM || ws_size < WS_END) { fprintf(stderr, "kernel_launch: unexpected shapes (n_in %d, in0 %d, out %d, ws %zu < %zu); nothing launched\n", n_in, n_in > 0 ? in_sizes[0] : -1, out_size, ws_size, (size_t)WS_END); grid = -1; return; }
        int dev = 0, cus = 0, per_cu = 0;
        if (hipGetDevice(&dev) != hipSuccess || hipDeviceGetAttribute(&cus, hipDeviceAttributeMultiprocessorCount, dev) != hipSuccess) { grid = -1; return; }
        if (hipFuncSetAttribute((const void*)mk_fwd, hipFuncAttributeMaxDynamicSharedMemorySize, LDS_BYTES) != hipSuccess) { fprintf(stderr, "kernel_launch: hipFuncSetAttribute failed\n"); grid = -1; return; }
        if (hipOccupancyMaxActiveBlocksPerMultiprocessor(&per_cu, (const void*)mk_fwd, NTHR, LDS_BYTES) != hipSuccess || per_cu < 1) { fprintf(stderr, "kernel_launch: occupancy query reports %d blocks per CU; nothing launched\n", per_cu); (void)hipGetLastError(); grid = -1; return; }
        grid = cus;
    }
    if (grid < 0) return;
    if (hipMemsetAsync((char*)d_ws + WS_CTL, 0, CTL_ZERO_BYTES, stream) != hipSuccess) { fprintf(stderr, "kernel_launch: memset failed\n"); return; }
    Args a{};
    for (int i = 0; i < 26; ++i) a.in[i] = (const float*)d_in[i];
    a.out = (float*)d_out; a.ws = (unsigned char*)d_ws;
#if defined(MK_PER_PHASE) && MK_PER_PHASE
    for (int p = 0; p < N_PHASES; ++p) { a.ph_lo = p; a.ph_hi = p + 1; hipLaunchKernelGGL(mk_fwd, dim3(grid), dim3(NTHR), LDS_BYTES, stream, a); }
#else
    a.ph_lo = 0; a.ph_hi = N_PHASES; hipLaunchKernelGGL(mk_fwd, dim3(grid), dim3(NTHR), LDS_BYTES, stream, a);
#endif
    const hipError_t le = hipPeekAtLastError();
    if (le != hipSuccess) fprintf(stderr, "kernel_launch: launch failed: %s\n", hipGetErrorName(le));
}
```

```cpp
#include <hip/hip_runtime.h>
#include <cstdio>
#include <cstdint>
namespace pg8 {
#define PG8_LAS __attribute__((address_space(3)))
typedef unsigned short bf16_t;
typedef short bf16x8 __attribute__((ext_vector_type(8)));
typedef float f32x4 __attribute__((ext_vector_type(4)));
typedef unsigned u32x4 __attribute__((ext_vector_type(4)));
constexpr int BM = 256, BK = 64, HALF = 128, HTB = HALF * BK * 2  , STAGE_BYTES = 8 * HTB, NXCD = 8, WGM = 8;

__host__ __device__ __forceinline__ int lds_byte(int r, int c) { const int st = (r >> 4) * 2 + (c >> 5), rr = r & 15, cc = c & 31, ob = rr * 64 + cc * 2; return st * 1024 + (ob ^ (((ob >> 9) & 1) << 5)); }
__host__ __device__ __forceinline__ void stage_rc(int b, int& R, int& C) { const int st = b / 1024, sb = b % 1024, swz = sb ^ (((sb >> 9) & 1) << 5); R = (st >> 1) * 16 + swz / 64; C = (st & 1) * 32 + (swz % 64) / 2; }
__host__ __device__ __forceinline__ int perm32(int rho) { const int n = rho >> 4, i = rho & 15; return 8 * (i >> 2) + 4 * n + (i & 3); }

struct Unit { int pm, pn; };
struct Gemm { const bf16_t* A; const bf16_t* Bt; int M, N, K; };

struct StaticOrder {
    static constexpr bool GATHER = false;
    int nM, nN, nwg, G, c;
    __host__ __device__ void init(int M, int N, int G_, int c_) { nM = M / BM; nN = N / BM; nwg = nM * nN; G = G_; c = c_; }
    __host__ __device__ bool next(int i, Unit& u) const {
        const long L = (long)i * G + c; if (L >= nwg) return false;
        int wgid = (int)L; { const int q = nwg / NXCD, r = nwg % NXCD, xcd = wgid % NXCD, off = wgid / NXCD; wgid = (xcd < r ? xcd * (q + 1) : r * (q + 1) + (xcd - r) * q) + off; }
        const int nig = WGM * nN, gid = wgid / nig, fm = gid * WGM, gsz = (nM - fm) < WGM ? (nM - fm) : WGM;
        u.pm = fm + ((wgid % nig) % gsz); u.pn = (wgid % nig) / gsz; return true;
    }
    __device__ __forceinline__ void a_ready(const Unit&) const {}
    __device__ __forceinline__ void done(const Unit&) const {}
};
__device__ __forceinline__ unsigned cvt_pk_bf16(float lo, float hi) { unsigned r; asm volatile("v_cvt_pk_bf16_f32 %0, %1, %2" : "=v"(r) : "v"(lo), "v"(hi)); return r; }
typedef float f32x2 __attribute__((ext_vector_type(2)));
typedef float f32x2 __attribute__((ext_vector_type(2)));
typedef unsigned u32x2 __attribute__((ext_vector_type(2)));
typedef int i32x8 __attribute__((ext_vector_type(8)));
typedef int i32x4 __attribute__((ext_vector_type(4)));
__device__ __forceinline__ i32x8 pg8_cat(bf16x8 lo, bf16x8 hi) { const i32x4 a = __builtin_bit_cast(i32x4, lo), b = __builtin_bit_cast(i32x4, hi); return (i32x8){a.x, a.y, a.z, a.w, b.x, b.y, b.z, b.w}; }
__device__ __forceinline__ unsigned pk_fp8x4(float a, float b, float c, float d) {
    a = __builtin_amdgcn_fmed3f(a, -448.f, 448.f); b = __builtin_amdgcn_fmed3f(b, -448.f, 448.f); c = __builtin_amdgcn_fmed3f(c, -448.f, 448.f); d = __builtin_amdgcn_fmed3f(d, -448.f, 448.f);
    int w = __builtin_amdgcn_cvt_pk_fp8_f32(a, b, 0, false); w = __builtin_amdgcn_cvt_pk_fp8_f32(c, d, w, true); return (unsigned)w; }
struct EpiProj {
    static constexpr bool PERM = true, AFTER_DRAIN = false;
    bf16_t* P; const float* rs; const float* gq; const float* gk; int ldp; float qscale;
    __device__ __forceinline__ void operator()(const f32x4 (&acc)[2][2][4][2], const Unit& u, int wr, int wc, int fr, int fq) const {
        const int pn = u.pn; const bool headnorm = pn < 4;
        f32x4 g[2][2];
        if (headnorm) { const float* gp = (pn < 2) ? gq : gk; const float s = (pn < 2) ? qscale : 1.0f;
#pragma unroll
            for (int bj = 0; bj < 2; ++bj)
#pragma unroll
                for (int n = 0; n < 2; ++n) g[bj][n] = *(const f32x4*)(gp + 32 * bj + 8 * fq + 4 * n) * s; }
#pragma unroll
        for (int ai = 0; ai < 2; ++ai)
#pragma unroll
            for (int m = 0; m < 4; ++m) {
                asm volatile("" ::: "memory");
                const int row = u.pm * BM + ai * HALF + wr * 64 + m * 16 + fr; const float r = rs[row];
                f32x4 v[2][2];
#pragma unroll
                for (int bj = 0; bj < 2; ++bj)
#pragma unroll
                    for (int n = 0; n < 2; ++n) v[bj][n] = acc[ai][bj][m][n] * r;
                if (headnorm) { float ss = 0.f;
#pragma unroll
                    for (int bj = 0; bj < 2; ++bj)
#pragma unroll
                        for (int n = 0; n < 2; ++n) { const f32x4 x = v[bj][n]; ss += (x[0] * x[0] + x[1] * x[1]) + (x[2] * x[2] + x[3] * x[3]); }
                    ss += __shfl_xor(ss, 16); ss += __shfl_xor(ss, 32);
                    const float sc = __builtin_amdgcn_rsqf(ss * (1.0f / 64.0f) + 1e-6f);
#pragma unroll
                    for (int bj = 0; bj < 2; ++bj)
#pragma unroll
                        for (int n = 0; n < 2; ++n) v[bj][n] = v[bj][n] * g[bj][n] * sc; }
                bf16_t* rowp = P + (size_t)row * ldp + pn * BM + 64 * wc + 8 * fq;
#pragma unroll
                for (int bj = 0; bj < 2; ++bj) { u32x4 w; w.x = cvt_pk_bf16(v[bj][0][0], v[bj][0][1]); w.y = cvt_pk_bf16(v[bj][0][2], v[bj][0][3]); w.z = cvt_pk_bf16(v[bj][1][0], v[bj][1][1]); w.w = cvt_pk_bf16(v[bj][1][2], v[bj][1][3]);
                    *(u32x4*)(rowp + 32 * bj) = w; }
            }
    }
};
struct EpiResid {
    static constexpr bool PERM = true, AFTER_DRAIN = false;
    const bf16_t* base; bf16_t* out; int ldc; unsigned char* out8;
    __device__ __forceinline__ void operator()(const f32x4 (&acc)[2][2][4][2], const Unit& u, int wr, int wc, int fr, int fq) const {
        const int col0 = u.pn * BM + wc * 32 + 8 * fq;
#pragma unroll
        for (int ai = 0; ai < 2; ++ai)
#pragma unroll
            for (int m = 0; m < 4; ++m) { const size_t off = (size_t)(u.pm * BM + ai * HALF + wr * 64 + m * 16 + fr) * ldc + col0;
                u32x4 b[2];
#pragma unroll
                for (int bj = 0; bj < 2; ++bj) b[bj] = *(const u32x4*)(base + off + bj * HALF);
#pragma unroll
                for (int bj = 0; bj < 2; ++bj) { const f32x4 v0 = acc[ai][bj][m][0], v1 = acc[ai][bj][m][1]; u32x4 w;
                    w.x = cvt_pk_bf16(v0[0] + __uint_as_float(b[bj].x << 16), v0[1] + __uint_as_float(b[bj].x & 0xffff0000u)); w.y = cvt_pk_bf16(v0[2] + __uint_as_float(b[bj].y << 16), v0[3] + __uint_as_float(b[bj].y & 0xffff0000u));
                    w.z = cvt_pk_bf16(v1[0] + __uint_as_float(b[bj].z << 16), v1[1] + __uint_as_float(b[bj].z & 0xffff0000u)); w.w = cvt_pk_bf16(v1[2] + __uint_as_float(b[bj].w << 16), v1[3] + __uint_as_float(b[bj].w & 0xffff0000u));
                    *(u32x4*)(out + off + bj * HALF) = w;
                    if (out8) { u32x2 q; q.x = pk_fp8x4(__uint_as_float(w.x << 16), __uint_as_float(w.x & 0xffff0000u), __uint_as_float(w.y << 16), __uint_as_float(w.y & 0xffff0000u));
                        q.y = pk_fp8x4(__uint_as_float(w.z << 16), __uint_as_float(w.z & 0xffff0000u), __uint_as_float(w.w << 16), __uint_as_float(w.w & 0xffff0000u)); *(u32x2*)(out8 + off + bj * HALF) = q; } }
                if (m & 1) asm volatile("" ::: "memory"); }
    }
};
struct MoeTabs { const PG8_LAS int* pst; const PG8_LAS int* cnt; const PG8_LAS int* tile_e; };
template <bool FP8> struct EpiSwiglu {
    static constexpr bool PERM = true, AFTER_DRAIN = false;
    bf16_t* H; const float* rsv; int ldh; MoeTabs tb;
    __device__ __forceinline__ void operator()(const f32x4 (&acc)[2][2][4][2], const Unit& u, int wr, int wc, int fr, int fq) const {
        const int col0 = (u.pn & 3) * 128 + 16 * wc + 4 * fq; const int ex = u.pn >> 2, br = u.pm * BM - tb.pst[ex], ce = tb.cnt[ex];
#pragma unroll
        for (int ai = 0; ai < 2; ++ai)
#pragma unroll
            for (int m = 0; m < 4; ++m) { const int rl = ai * HALF + wr * 64 + m * 16 + fr; const int row = u.pm * BM + rl; const int rank = br + rl; const float r = ((rank < ce) ? rsv[ex * 32768 + rank] : 0.f) * (FP8 ? (1.0f / 64.0f) : 1.0f);
#pragma unroll
                for (int bj = 0; bj < 2; ++bj) { const f32x4 g = acc[ai][bj][m][0] * r, up = acc[ai][bj][m][1] * r; float h[4];
#pragma unroll
                    for (int i = 0; i < 4; ++i) h[i] = g[i] * __builtin_amdgcn_rcpf(1.0f + __builtin_amdgcn_exp2f(-1.4426950408889634f * g[i])) * up[i];
                    if constexpr (FP8) { *(unsigned*)((unsigned char*)H + (size_t)row * ldh + col0 + 64 * bj) = pk_fp8x4(8.f * h[0], 8.f * h[1], 8.f * h[2], 8.f * h[3]); }
                    else { u32x2 w; w.x = cvt_pk_bf16(h[0], h[1]); w.y = cvt_pk_bf16(h[2], h[3]); *(u32x2*)(H + (size_t)row * ldh + col0 + 64 * bj) = w; } } }
    }
};
struct EpiGate {
    static constexpr bool PERM = true, AFTER_DRAIN = false;
    bf16_t* O; const float* gtv; int ldo; MoeTabs tb; float sc;
    __device__ __forceinline__ void operator()(const f32x4 (&acc)[2][2][4][2], const Unit& u, int wr, int wc, int fr, int fq) const {
        const int col0 = (u.pn & 3) * BM + wc * 32 + 8 * fq; const int ex = u.pn >> 2, br = u.pm * BM - tb.pst[ex], ce = tb.cnt[ex];
#pragma unroll
        for (int ai = 0; ai < 2; ++ai)
#pragma unroll
            for (int m = 0; m < 4; ++m) { const int rl = ai * HALF + wr * 64 + m * 16 + fr; const int row = u.pm * BM + rl; const int rank = br + rl; const float gt = ((rank < ce) ? gtv[ex * 32768 + rank] : 0.f) * sc;
#pragma unroll
                for (int bj = 0; bj < 2; ++bj) { const f32x4 v0 = acc[ai][bj][m][0] * gt, v1 = acc[ai][bj][m][1] * gt;
                    u32x4 w; w.x = cvt_pk_bf16(v0[0], v0[1]); w.y = cvt_pk_bf16(v0[2], v0[3]); w.z = cvt_pk_bf16(v1[0], v1[1]); w.w = cvt_pk_bf16(v1[2], v1[3]);
                    *(u32x4*)(O + (size_t)row * ldo + col0 + bj * HALF) = w; } }
    }
};
template <bool GATHER_> struct MoeOrder {
    static constexpr bool GATHER = GATHER_;
    int nunits, G, c; MoeTabs tb; const int* stv; int zrow;
    __device__ __forceinline__ bool next(int i, Unit& u) const { const int L = i * G + c; if (L >= nunits) return false; const int rt = L >> 2; u.pm = rt; u.pn = tb.tile_e[rt] * 4 + (L & 3); return true; }
    __device__ __forceinline__ void a_ready(const Unit&) const {}
    __device__ __forceinline__ void done(const Unit&) const {}
    __device__ __forceinline__ void rows(const Unit& u, const int (&R)[2], const unsigned (&C2)[2], unsigned (&v)[2][2], int K) const {
        const int ex = u.pn >> 2, br = u.pm * BM - tb.pst[ex], ce = tb.cnt[ex];
#pragma unroll
        for (int h = 0; h < 2; ++h)
#pragma unroll
            for (int i = 0; i < 2; ++i) { const int rank = br + HALF * h + R[i]; int tok = zrow; if (rank < ce) tok = stv[ex * 32768 + rank]; v[h][i] = (unsigned)tok * (unsigned)(K * 2) + C2[i]; }
    }
};
template <class Epi, class Sched, bool ALIGN_EPI = false, bool SP2 = false, bool FP8 = false>
__device__ __forceinline__ void gemm_phase(PG8_LAS unsigned char* lds, const Gemm g, const Sched& S, const Epi& E) {
    int tid_ = threadIdx.x; asm volatile("" : "+v"(tid_));
    const int tid = tid_, wid = __builtin_amdgcn_readfirstlane(tid >> 6), lane = tid & 63, wr = wid >> 2, wc = wid & 3, fr = lane & 15, fq = lane >> 4;
    const int K = g.K, nt = K / BK;
    unsigned voffA[2], voffB[2];
    int gR[2]; unsigned gC2[2];
    unsigned vC[2][2], vN[2][2];
#pragma unroll
    for (int i = 0; i < 2; ++i) { int R, C; stage_rc(tid * 16 + i * 8192, R, C); const int Rb = Epi::PERM ? ((R & ~31) + perm32(R & 31)) : R;
        voffA[i] = (unsigned)(R * K + C) * 2u; voffB[i] = (unsigned)(Rb * K + C) * 2u; gR[i] = R; gC2[i] = (unsigned)C * 2u; }
    const size_t kstep = (size_t)(BK * 2);
    const size_t hstep = (size_t)HALF * K * 2;
    const size_t tstep = 2 * hstep;
    const unsigned ldsw = (unsigned)wid * 1024u;
    const int aoff = lds_byte(wr * 64 + fr, fq * 8), boff = lds_byte(wc * 32 + fr, fq * 8);
#define PG8_SA(b, h) (((b) * 2 + (h)) * HTB)
#define PG8_SB(b, h) ((4 + (b) * 2 + (h)) * HTB)
#define PG8_STAGE(bufoff, gbase, voff) do { _Pragma("unroll") for (int _i = 0; _i < 2; ++_i) \
        __builtin_amdgcn_global_load_lds((const unsigned*)((const char*)(gbase) + (voff)[_i]), (PG8_LAS unsigned*)(lds + (bufoff) + ldsw + _i * 8192), 16, 0, 0); } while (0)
#define PG8_STAGEA(bufoff, P, h, V) do { if constexpr (Sched::GATHER) { PG8_STAGE(bufoff, P, (V)[h]); } else { PG8_STAGE(bufoff, (P) + (h) * hstep, voffA); } } while (0)
#define PG8_LDA(dst, b, h) do { if constexpr (FP8) { _Pragma("unroll") for (int m = 0; m < 4; ++m) dst##8[m] = pg8_cat(*(const PG8_LAS bf16x8*)(lds + PG8_SA(b, h) + aoff + m * 2048), *(const PG8_LAS bf16x8*)(lds + PG8_SA(b, h) + aoff + m * 2048 + 1024)); } else { \
        _Pragma("unroll") for (int m = 0; m < 4; ++m) _Pragma("unroll") for (int k = 0; k < 2; ++k) dst[m][k] = *(const PG8_LAS bf16x8*)(lds + PG8_SA(b, h) + aoff + m * 2048 + k * 1024); } } while (0)
#define PG8_LDB(dst, b, h) do { if constexpr (FP8) { _Pragma("unroll") for (int n = 0; n < 2; ++n) dst##8[n] = pg8_cat(*(const PG8_LAS bf16x8*)(lds + PG8_SB(b, h) + boff + n * 2048), *(const PG8_LAS bf16x8*)(lds + PG8_SB(b, h) + boff + n * 2048 + 1024)); } else { \
        _Pragma("unroll") for (int n = 0; n < 2; ++n) _Pragma("unroll") for (int k = 0; k < 2; ++k) dst[n][k] = *(const PG8_LAS bf16x8*)(lds + PG8_SB(b, h) + boff + n * 2048 + k * 1024); } } while (0)
#define PG8_MMA(ai, bj, At, Bt) do { __builtin_amdgcn_s_setprio(1); if constexpr (FP8) { asm volatile("s_nop 1"); _Pragma("unroll") for (int m = 0; m < 4; ++m) _Pragma("unroll") for (int n = 0; n < 2; ++n) \
        asm volatile("v_mfma_f32_16x16x128_f8f6f4 %0, %1, %2, %0" : "+v"(acc[ai][bj][m][n]) : "v"(Bt##8[n]), "v"(At##8[m])); } else { \
        _Pragma("unroll") for (int m = 0; m < 4; ++m) _Pragma("unroll") for (int n = 0; n < 2; ++n) _Pragma("unroll") for (int k = 0; k < 2; ++k) \
        acc[ai][bj][m][n] = __builtin_amdgcn_mfma_f32_16x16x32_bf16(Bt[n][k], At[m][k], acc[ai][bj][m][n], 0, 0, 0); } __builtin_amdgcn_s_setprio(0); } while (0)
#define PG8_WAIT_V(n) asm volatile("s_waitcnt vmcnt(" #n ")" ::: "memory")
#define PG8_WAIT_L(n) asm volatile("s_waitcnt lgkmcnt(" #n ")" ::: "memory")
#define PG8_BAR __builtin_amdgcn_s_barrier()
#define PG8_SCHED __builtin_amdgcn_sched_barrier(0)
    Unit cur, nxt; int ui = 0;
    if (!S.next(0, cur)) return;
    f32x4 acc[2][2][4][2];
#pragma unroll
    for (int a = 0; a < 2; ++a)
#pragma unroll
        for (int b = 0; b < 2; ++b)
#pragma unroll
            for (int m = 0; m < 4; ++m)
#pragma unroll
                for (int n = 0; n < 2; ++n) { acc[a][b][m][n] = (f32x4){0.f, 0.f, 0.f, 0.f}; if constexpr (FP8) asm volatile("" : "+v"(acc[a][b][m][n])); }
    bf16x8 At[4][2], B0[2][2], B1[2][2]; i32x8 At8[4], B08[2], B18[2];
    const char* cA = Sched::GATHER ? (const char*)g.A : (const char*)g.A + (size_t)cur.pm * tstep; const char* cB = (const char*)g.Bt + (size_t)cur.pn * tstep;
    S.a_ready(cur);
    if constexpr (Sched::GATHER) S.rows(cur, gR, gC2, vC, K);
    if constexpr (SP2) {
        PG8_STAGE(PG8_SB(0, 0), cB, voffB); PG8_STAGE(PG8_SB(0, 1), cB + hstep, voffB); PG8_STAGEA(PG8_SA(0, 0), cA, 0, vC); PG8_STAGEA(PG8_SA(0, 1), cA, 1, vC);
        if (wr == 1) PG8_BAR;
        PG8_WAIT_V(2); PG8_BAR;
        PG8_STAGE(PG8_SB(1, 0), cB + kstep, voffB); PG8_STAGEA(PG8_SA(1, 0), cA + kstep, 0, vC); PG8_STAGE(PG8_SB(1, 1), cB + hstep + kstep, voffB);
        PG8_WAIT_V(6); PG8_BAR;
    } else {
        PG8_STAGE(PG8_SB(0, 0), cB, voffB); PG8_STAGE(PG8_SA(0, 0), cA, voffA); PG8_STAGE(PG8_SB(0, 1), cB + hstep, voffB); PG8_STAGE(PG8_SA(0, 1), cA + hstep, voffA);
        if (wr == 1) PG8_BAR;
        PG8_WAIT_V(4); PG8_BAR;
        PG8_STAGE(PG8_SB(1, 0), cB + kstep, voffB); PG8_STAGE(PG8_SA(1, 0), cA + kstep, voffA); PG8_STAGE(PG8_SB(1, 1), cB + hstep + kstep, voffB);
        PG8_WAIT_V(6); PG8_BAR;
    }
    for (;;) {
        const bool has_next = S.next(ui + 1, nxt);
        const char* nA = (has_next && !Sched::GATHER) ? (const char*)g.A + (size_t)nxt.pm * tstep : cA; const char* nB = has_next ? (const char*)g.Bt + (size_t)nxt.pn * tstep : cB;
        for (int t = 0; t < nt; t += 2) {
            const bool last = (t == nt - 2);
            const char* a1 = cA + (size_t)(t + 1) * kstep;
            const char* a2 = last ? nA : cA + (size_t)(t + 2) * kstep; const char* b2 = last ? nB : cB + (size_t)(t + 2) * kstep;
            const char* a3 = a2 + kstep; const char* b3 = b2 + kstep;
            if (last && has_next) { S.a_ready(nxt); if constexpr (Sched::GATHER) S.rows(nxt, gR, gC2, vN, K); }
            unsigned v2[2][2];
            if constexpr (Sched::GATHER) { const bool usen = last && has_next;
#pragma unroll
                for (int h_ = 0; h_ < 2; ++h_)
#pragma unroll
                    for (int i_ = 0; i_ < 2; ++i_) v2[h_][i_] = usen ? vN[h_][i_] : vC[h_][i_]; }
            if constexpr (SP2) {
            PG8_LDB(B0, 0, 0); PG8_LDB(B1, 0, 1); PG8_SCHED; PG8_LDA(At, 0, 0); PG8_STAGEA(PG8_SA(1, 1), a1, 1, vC);
            PG8_WAIT_V(8); PG8_WAIT_L(0); PG8_BAR; PG8_MMA(0, 0, At, B0); PG8_MMA(0, 1, At, B1); PG8_BAR; PG8_SCHED;
            PG8_LDA(At, 0, 1); PG8_STAGE(PG8_SB(0, 0), b2, voffB); PG8_STAGE(PG8_SB(0, 1), b2 + hstep, voffB); PG8_STAGEA(PG8_SA(0, 0), a2, 0, v2);
            PG8_WAIT_V(8); PG8_WAIT_L(0); PG8_BAR; PG8_MMA(1, 0, At, B0); PG8_MMA(1, 1, At, B1); PG8_BAR; PG8_SCHED;
            PG8_LDB(B0, 1, 0); PG8_LDB(B1, 1, 1); PG8_SCHED; PG8_LDA(At, 1, 0); PG8_STAGEA(PG8_SA(0, 1), a2, 1, v2);
            PG8_WAIT_V(8); PG8_WAIT_L(0); PG8_BAR; PG8_MMA(0, 0, At, B0); PG8_MMA(0, 1, At, B1); PG8_BAR; PG8_SCHED;
            PG8_LDA(At, 1, 1); PG8_STAGE(PG8_SB(1, 0), b3, voffB); PG8_STAGE(PG8_SB(1, 1), b3 + hstep, voffB); PG8_STAGEA(PG8_SA(1, 0), a3, 0, v2);
            PG8_WAIT_V(8); PG8_WAIT_L(0); PG8_BAR; PG8_MMA(1, 0, At, B0); PG8_MMA(1, 1, At, B1); PG8_BAR; PG8_SCHED;
            } else {
            static_assert(SP2 || !Sched::GATHER, "gather mode: SP2 loop only");
            PG8_LDB(B0, 0, 0); PG8_SCHED; PG8_LDA(At, 0, 0); PG8_STAGE(PG8_SA(1, 1), a1 + hstep, voffA);
            PG8_WAIT_L(8); PG8_BAR; PG8_WAIT_L(0); PG8_MMA(0, 0, At, B0); PG8_BAR; PG8_SCHED;
            PG8_LDB(B1, 0, 1); PG8_STAGE(PG8_SB(0, 0), b2, voffB);
            PG8_BAR; PG8_WAIT_L(0); PG8_MMA(0, 1, At, B1); PG8_BAR;
            PG8_LDA(At, 0, 1); PG8_STAGE(PG8_SA(0, 0), a2, voffA);
            PG8_BAR; PG8_WAIT_L(0); PG8_MMA(1, 0, At, B0); PG8_BAR; PG8_SCHED;
            PG8_STAGE(PG8_SB(0, 1), b2 + hstep, voffB);
            PG8_WAIT_V(6); PG8_BAR; PG8_MMA(1, 1, At, B1); PG8_BAR;
            PG8_LDB(B0, 1, 0); PG8_SCHED; PG8_LDA(At, 1, 0); PG8_STAGE(PG8_SA(0, 1), a2 + hstep, voffA);
            PG8_WAIT_L(8); PG8_BAR; PG8_WAIT_L(0); PG8_MMA(0, 0, At, B0); PG8_BAR; PG8_SCHED;
            PG8_LDB(B1, 1, 1); PG8_STAGE(PG8_SB(1, 0), b3, voffB);
            PG8_BAR; PG8_WAIT_L(0); PG8_MMA(0, 1, At, B1); PG8_BAR;
            PG8_LDA(At, 1, 1); PG8_STAGE(PG8_SA(1, 0), a3, voffA);
            PG8_BAR; PG8_WAIT_L(0); PG8_MMA(1, 0, At, B0); PG8_BAR; PG8_SCHED;
            PG8_STAGE(PG8_SB(1, 1), b3 + hstep, voffB);
            PG8_WAIT_V(6); PG8_BAR; PG8_MMA(1, 1, At, B1); PG8_BAR;
            }
        }
        if constexpr (ALIGN_EPI) { if (wr == 0) PG8_BAR; }
        if constexpr (FP8) asm volatile("s_nop 15\n\ts_nop 7" ::: "memory");
        if constexpr (!Epi::AFTER_DRAIN) { E(acc, cur, wr, wc, fr, fq); S.done(cur); }
        if (!has_next) break;
#pragma unroll
        for (int a = 0; a < 2; ++a)
#pragma unroll
            for (int b = 0; b < 2; ++b)
#pragma unroll
                for (int m = 0; m < 4; ++m)
#pragma unroll
                    for (int n = 0; n < 2; ++n) { acc[a][b][m][n] = (f32x4){0.f, 0.f, 0.f, 0.f}; if constexpr (FP8) asm volatile("" : "+v"(acc[a][b][m][n])); }
        cur = nxt; cA = nA; cB = nB; ++ui;
        if constexpr (Sched::GATHER) {
#pragma unroll
            for (int h_ = 0; h_ < 2; ++h_)
#pragma unroll
                for (int i_ = 0; i_ < 2; ++i_) vC[h_][i_] = vN[h_][i_]; }
        if constexpr (ALIGN_EPI) { if (wr == 1) PG8_BAR; }
    }
    PG8_WAIT_V(0);
    if constexpr (!ALIGN_EPI) { if (wr == 0) PG8_BAR; }
    PG8_BAR;
    if constexpr (Epi::AFTER_DRAIN) { E.fused(acc, cur, wr, wc, fr, fq, lds, wid, lane); S.done(cur); }
#undef PG8_SA
#undef PG8_SB
#undef PG8_STAGE
#undef PG8_STAGEA
#undef PG8_LDA
#undef PG8_LDB
#undef PG8_MMA
#undef PG8_WAIT_V
#undef PG8_WAIT_L
#undef PG8_BAR
#undef PG8_SCHED
}
}
#define GAS __attribute__((address_space(1)))
#define LAS __attribute__((address_space(3)))
typedef unsigned short bf16;
typedef unsigned v4u __attribute__((ext_vector_type(4)));
typedef float f32x4 __attribute__((ext_vector_type(4)));
typedef short bf16x8 __attribute__((ext_vector_type(8)));
typedef GAS unsigned gu32;
typedef GAS unsigned long long gu64;
#define RLX_AGENT __ATOMIC_RELAXED, __HIP_MEMORY_SCOPE_AGENT
#define LDS_WAIT() asm volatile("s_waitcnt lgkmcnt(0)" ::: "memory")
#define VM_WAIT() asm volatile("s_waitcnt vmcnt(0)" ::: "memory")
__device__ __forceinline__ unsigned long long rt() { return __builtin_amdgcn_s_memrealtime(); }
__device__ __forceinline__ unsigned f2bf(float f) { unsigned u = __builtin_bit_cast(unsigned, f); return (u + 0x7fffu + ((u >> 16) & 1u)) >> 16; }
__device__ __forceinline__ unsigned pk2(float lo, float hi) { return f2bf(lo) | (f2bf(hi) << 16); }

#define XB_TMO      128
#define XB_XCNT(j)  (256  + 64 * (j))
#define XB_XSUB(j)  (1280 + 64 * (j))
#define XB_XGEN(j)  (2304 + 64 * (j))
#define XB_TOP      3328
#define XB_TOPGEN   3392
#define XCD_BAR_WORDS 3456
#define XB_SPIN_CAP (1u << 18)

__device__ __forceinline__ unsigned xb_ld(unsigned* p)              { return __hip_atomic_load(p, __ATOMIC_RELAXED, __HIP_MEMORY_SCOPE_AGENT); }
__device__ __forceinline__ unsigned xb_add(unsigned* p, unsigned v) { return __hip_atomic_fetch_add(p, v, __ATOMIC_RELAXED, __HIP_MEMORY_SCOPE_AGENT); }
__device__ __forceinline__ unsigned xb_xcc_id() { return (unsigned)__builtin_amdgcn_s_getreg((3 << 11) | 20) & 0xFu; }
#define XB_SPIN(cond, bar) do { unsigned _sp = 0; while (cond) { __builtin_amdgcn_s_sleep(1); \
    if ((++_sp & 255u) == 0u) { if (xb_ld(&(bar)[XB_TMO])) break; if (_sp > XB_SPIN_CAP) { atomicAdd(&(bar)[XB_TMO], 1u); break; } } } } while (0)

struct XcdBarrier {
    unsigned* bar; unsigned x;
    volatile LAS unsigned* st;
};

__device__ __forceinline__ XcdBarrier xcd_barrier_post(unsigned* bar, volatile LAS unsigned* st) {
    XcdBarrier b; b.bar = bar; b.x = xb_xcc_id(); b.st = st;
    if (threadIdx.x == 0) (void)xb_add(&bar[XB_XCNT(b.x)], 1u);
    return b;
}
__device__ __forceinline__ void xcd_barrier_complete(unsigned* bar, unsigned x, unsigned& nloc, unsigned& nx) {
    const unsigned G = gridDim.x * gridDim.y * gridDim.z;
    unsigned sum, cnt, mine, sp = 0u;
    for (;;) {
        sum = 0u; cnt = 0u; mine = 0u;
#pragma unroll
        for (unsigned j = 0; j < 16; ++j) { const unsigned c = xb_ld(&bar[XB_XCNT(j)]); sum += c; cnt += (c > 0u) ? 1u : 0u; mine = (j == x) ? c : mine; }
        if (sum == G) break;
        __builtin_amdgcn_s_sleep(1);
        if ((++sp & 255u) == 0u) { if (xb_ld(&bar[XB_TMO])) break; if (sp > XB_SPIN_CAP) { atomicAdd(&bar[XB_TMO], 1u); break; } }
    }
    nloc = mine > 0u ? mine : 1u; nx = cnt > 0u ? cnt : 1u;
}

__device__ __forceinline__ void xcd_barrier(const XcdBarrier& b) {
    asm volatile("s_waitcnt vmcnt(0)" ::: "memory");
    __syncthreads();
    if (threadIdx.x == 0) {
        unsigned* bar = b.bar;
        __builtin_amdgcn_s_waitcnt(0);
        unsigned nloc = b.st[0], nx = b.st[1];
        if (nloc == 0u) { xcd_barrier_complete(bar, b.x, nloc, nx); b.st[0] = nloc; b.st[1] = nx; }
        const unsigned old = xb_add(&bar[XB_XSUB(b.x)], 1u);
        const unsigned gen = old / nloc;
        if (old + 1u == (gen + 1u) * nloc) {
            __builtin_amdgcn_fence(__ATOMIC_RELEASE, "agent");
            asm volatile("s_waitcnt vmcnt(0)" ::: "memory");
            const unsigned og = xb_add(&bar[XB_TOP], 1u);
            const unsigned tg = og / nx;
            if (og + 1u == (tg + 1u) * nx) xb_add(&bar[XB_TOPGEN], 1u);
            else XB_SPIN(xb_ld(&bar[XB_TOPGEN]) == tg, bar);
            __builtin_amdgcn_fence(__ATOMIC_ACQUIRE, "agent");
            xb_add(&bar[XB_XGEN(b.x)], 1u);
            asm volatile("s_waitcnt vmcnt(0)" ::: "memory");
        } else {
            XB_SPIN(xb_ld(&bar[XB_XGEN(b.x)]) == gen, bar);
            __builtin_amdgcn_fence(__ATOMIC_ACQUIRE, "agent");
            asm volatile("s_waitcnt vmcnt(0)" ::: "memory");
        }
    }
    __syncthreads();
}

constexpr int NB = 4, SEQ = 8192, DM = 1024, MTOK = NB * SEQ, DEPTH = 2;
constexpr int DIN = 2560, NH = 8, HD = 64, DLRU = 256, DCONF = 256, NE = 32, DE = 512;
constexpr int COL_Q = 0, COL_K = 512, COL_V = 1024, COL_XR = 1536, COL_XG = 1792, COL_XC = 2048;
constexpr int NRT = 36, NRTP = 48;
constexpr int MAXSLOT = 73728;
constexpr float EPSN = 1e-6f;
constexpr float LOG2E = 1.4426950408889634f;
constexpr float QSCALE = 0.125f * LOG2E;
constexpr float EXIT_THR2 = 120.0f * LOG2E;

constexpr size_t MiB = 1u << 20;
constexpr size_t WS_CTL = 0, CTL_ZERO_BYTES = 1 * MiB;
constexpr size_t WS_WIN = 1 * MiB;
constexpr size_t WS_WOUT = 6 * MiB;
constexpr size_t WS_W1 = 8 * MiB;
constexpr size_t WS_W2 = 72 * MiB;
constexpr size_t WS_PW = 104 * MiB;
constexpr size_t WS_LRUW = WS_PW + 128 * 1024;
constexpr size_t WS_WR = WS_PW + 256 * 1024;
constexpr size_t WS_RS1 = 105 * MiB;
constexpr size_t WS_RS2 = WS_RS1 + 128 * 1024;
constexpr size_t WS_TOKE = WS_RS2 + 128 * 1024;
constexpr size_t WS_TOKR = WS_TOKE + 256 * 1024;
constexpr size_t WS_SUMM = 107 * MiB;
constexpr size_t WS_X0 = 109 * MiB;
constexpr size_t WS_X1 = 174 * MiB;
constexpr size_t WS_PROJ = 239 * MiB;
constexpr size_t WS_HP = 399 * MiB;
constexpr size_t WS_STV = 471 * MiB;
constexpr size_t WS_RSV = 475 * MiB;
constexpr size_t WS_GTV = 479 * MiB;
constexpr size_t WS_X1F8 = 483 * MiB;
constexpr size_t WS_END = 516 * MiB;
constexpr size_t WS_W1F8 = WS_W1, WS_W2F8 = WS_W1 + 32 * MiB;
#ifndef FP8_LAYERS
#define FP8_LAYERS 0x3
#endif
#if FP8_LAYERS == 0x3
__device__ __forceinline__ constexpr bool fp8_layer(int) { return true; }
#elif FP8_LAYERS == 0
__device__ __forceinline__ constexpr bool fp8_layer(int) { return false; }
#else
__device__ __forceinline__ bool fp8_layer(int l) { return ((FP8_LAYERS) >> l) & 1; }
#endif
constexpr int CW_TMO = 0, CW_BAR = 4096, CW_CNT = 8192;

constexpr int SCR_BYTES = 143360;
constexpr int LDSCTL_OFF = SCR_BYTES;
constexpr int LDS_BYTES = 147456;
constexpr int NWAVES = 8, NTHR = 512;

typedef float f32x16 __attribute__((ext_vector_type(16)));
typedef short s16x4 __attribute__((ext_vector_type(4)));
typedef unsigned u32x2 __attribute__((ext_vector_type(2)));
typedef float f32x2 __attribute__((ext_vector_type(2)));
typedef __bf16 bf16x2_t __attribute__((ext_vector_type(2)));

__device__ __forceinline__ unsigned cvtpk(float lo, float hi) { f32x2 v = {lo, hi}; bf16x2_t b = __builtin_convertvector(v, bf16x2_t); return __builtin_bit_cast(unsigned, b); }
__device__ __forceinline__ float bflo(unsigned w) { return __uint_as_float(w << 16); }
__device__ __forceinline__ float bfhi(unsigned w) { return __uint_as_float(w & 0xffff0000u); }
__device__ __forceinline__ float fexp2(float x) { return __builtin_amdgcn_exp2f(x); }
__device__ __forceinline__ float flog2(float x) { return __builtin_amdgcn_logf(x); }
__device__ __forceinline__ float frcp(float x) { return __builtin_amdgcn_rcpf(x); }
__device__ __forceinline__ float sigmoidf_(float x) { return frcp(1.0f + fexp2(-LOG2E * x)); }
__device__ __forceinline__ float wave_sum(float v) {
#pragma unroll
    for (int o = 1; o < 64; o <<= 1) v += __shfl_xor(v, o);
    return v;
}
#define WG_SYNC() __syncthreads()
__device__ __forceinline__ int opq(int x) { asm volatile("" : "+v"(x)); return x; }

struct Frame {
    LAS unsigned char* lds;
    gu32* ctl;
    int tid, lane, wave, vcu, G;
    const float* const* in;
    float* out; unsigned char* ws;
};

__device__ __forceinline__ int dest_row(int n, int mode) {
    if (mode == 1) { const int t = n & ~255, c = n & 255; return t + 128 * ((c >> 5) & 1) + 32 * (c >> 6) + (c & 31); }
    if (mode == 2) return 8 * (n >> 2) + (n & 3);
    if (mode == 3) return 8 * (n >> 2) + 4 + (n & 3);
    return n;
}
__device__ __forceinline__ void transpose_item(const float* W, int ldn, int k0, int n0, const float* gain, bf16* WT, int ldk, int mode, LAS float* scr  , int lane) {
    float v[64]; const float* p = W + (size_t)k0 * ldn + n0 + lane;
#pragma unroll
    for (int i = 0; i < 64; ++i) { v[i] = *(const GAS float*)p; p += ldn; }
    if (gain) {
#pragma unroll
        for (int i = 0; i < 64; ++i) v[i] *= gain[k0 + i]; }
#pragma unroll
    for (int i = 0; i < 64; ++i) scr[i * 65 + lane] = v[i];
    LDS_WAIT(); asm volatile("" ::: "memory");
    const int c = lane & 7;
#pragma unroll
    for (int j = 0; j < 8; ++j) { const int n = (lane >> 3) + 8 * j; const LAS float* s = scr + (8 * c) * 65 + n;
        v4u o; o.x = cvtpk(s[0 * 65], s[1 * 65]); o.y = cvtpk(s[2 * 65], s[3 * 65]); o.z = cvtpk(s[4 * 65], s[5 * 65]); o.w = cvtpk(s[6 * 65], s[7 * 65]);
        *(GAS v4u*)(WT + (size_t)dest_row(n0 + n, mode) * ldk + k0 + 8 * c) = o; }
    LDS_WAIT(); asm volatile("" ::: "memory");
}
__device__ __forceinline__ void transpose_item_f8(const float* W, int ldn, int k0, int n0, const float* gain, float scale, unsigned char* WT, int ldk, int mode, LAS float* scr, int lane) {
    float v[64]; const float* p = W + (size_t)k0 * ldn + n0 + lane;
#pragma unroll
    for (int i = 0; i < 64; ++i) { v[i] = *(const GAS float*)p; p += ldn; }
#pragma unroll
    for (int i = 0; i < 64; ++i) v[i] *= gain ? gain[k0 + i] * scale : scale;
#pragma unroll
    for (int i = 0; i < 64; ++i) scr[i * 65 + lane] = v[i];
    LDS_WAIT(); asm volatile("" ::: "memory");
    const int c = lane & 7;
#pragma unroll
    for (int j = 0; j < 8; ++j) { const int n = (lane >> 3) + 8 * j; const LAS float* s = scr + (8 * c) * 65 + n;
        u32x2 o; o.x = pg8::pk_fp8x4(s[0 * 65], s[1 * 65], s[2 * 65], s[3 * 65]); o.y = pg8::pk_fp8x4(s[4 * 65], s[5 * 65], s[6 * 65], s[7 * 65]);
        *(GAS u32x2*)(WT + (size_t)dest_row(n0 + n, mode) * ldk + k0 + 8 * c) = o; }
    LDS_WAIT(); asm volatile("" ::: "memory");
}
__device__ __forceinline__ void convert_weights(Frame& F, int l) {
    LAS float* scr = (LAS float*)(F.lds + F.wave * 16640);
    const int gw = F.vcu * NWAVES + F.wave, NGW = F.G * NWAVES;
    constexpr int I_IN = (DM / 64) * (DIN / 64), I_OUT = (DM / 64) * (DM / 64), I_GU = NE * (DM / 64) * (DE / 64), I_D = NE * (DE / 64) * (DM / 64);
    constexpr int I_PW = (DCONF / 64) * (DCONF / 64), I_LW = 8;
    constexpr int NITEMS = I_IN + I_OUT + 2 * I_GU + I_D + I_PW + I_LW;
    for (int it = gw; it < NITEMS; it += NGW) {
        int r = it;
        if (r < 2 * I_GU) { const int up = r >= I_GU; if (up) r -= I_GU; const int e = r / 128, q = r % 128, kb = q / 8, nb = q % 8; const float* src = F.in[up ? 24 : 23] + (size_t)l * NE * DM * DE + (size_t)e * DM * DE;
            if (fp8_layer(l)) transpose_item_f8(src, DE, 64 * kb, 64 * nb, F.in[20] + l * DM, 64.f, F.ws + WS_W1F8 + (size_t)e * 1024 * 1024, DM, up ? 3 : 2, scr, F.lane);
            else transpose_item(src, DE, 64 * kb, 64 * nb, F.in[20] + l * DM, (bf16*)(F.ws + WS_W1) + (size_t)e * 1024 * 1024, DM, up ? 3 : 2, scr, F.lane); continue; } r -= 2 * I_GU;
        if (r < I_D) { const int e = r / 128, q = r % 128, kb = q / 16, nb = q % 16; if (fp8_layer(l)) transpose_item_f8(F.in[25] + (size_t)l * NE * DE * DM + (size_t)e * DE * DM, DM, 64 * kb, 64 * nb, nullptr, 32.f, F.ws + WS_W2F8 + (size_t)e * 1024 * 512, DE, 0, scr, F.lane);
            else transpose_item(F.in[25] + (size_t)l * NE * DE * DM + (size_t)e * DE * DM, DM, 64 * kb, 64 * nb, nullptr, (bf16*)(F.ws + WS_W2) + (size_t)e * 1024 * 512, DE, 0, scr, F.lane); continue; } r -= I_D;
        if (r < I_IN) { const int kb = r / (DIN / 64), nb = r % (DIN / 64); transpose_item(F.in[2] + (size_t)l * DM * DIN, DIN, 64 * kb, 64 * nb, F.in[1] + l * DM, (bf16*)(F.ws + WS_WIN), DM, 1, scr, F.lane); continue; } r -= I_IN;
        if (r < I_OUT) { const int kb = r / 16, nb = r % 16; transpose_item(F.in[19] + (size_t)l * DM * DM, DM, 64 * kb, 64 * nb, F.in[18] + l * DM, (bf16*)(F.ws + WS_WOUT), DM, 0, scr, F.lane); continue; } r -= I_OUT;
        if (r < I_PW) { const int kb = r / 4, nb = r % 4; transpose_item(F.in[16] + (size_t)l * DCONF * DCONF, DCONF, 64 * kb, 64 * nb, nullptr, (bf16*)(F.ws + WS_PW), DCONF, 0, scr, F.lane); continue; } r -= I_PW;
        { const int mat = r; const float* src = F.in[mat < 4 ? 7 : 9] + (size_t)l * 4 * 64 * 64 + (size_t)(mat & 3) * 64 * 64; transpose_item(src, 64, 0, 0, nullptr, (bf16*)(F.ws + WS_LRUW) + (size_t)mat * 64 * 64, 64, 0, scr, F.lane); }
    }
    const float* g2 = F.in[20] + l * DM; const float* rc = F.in[21] + (size_t)l * DM * 4; const float* rf = F.in[22] + (size_t)l * DM * NE; bf16* WRH = (bf16*)(F.ws + WS_WR); bf16* WRL = WRH + NRTP * DM;
    for (int idx = (F.vcu * NTHR + F.tid); idx < NRTP * DM; idx += F.G * NTHR) { const int n = idx / DM, k = idx % DM;
        float v = 0.f; if (n < 4) v = rc[k * 4 + n] * g2[k]; else if (n < NRT) v = rf[k * NE + (n - 4)] * g2[k];
        const unsigned h = cvtpk(v, 0.f) & 0xffffu; const float r = v - __uint_as_float(h << 16); WRH[idx] = (bf16)h; WRL[idx] = (bf16)(cvtpk(r, 0.f) & 0xffffu); }
    LDS_WAIT(); WG_SYNC();
}
__device__ __forceinline__ void x_to_bf16_rows(Frame& F, const float* x, bf16* XB, float* RS1) {
    const int gw = F.vcu * NWAVES + F.wave, NGW = F.G * NWAVES;
    for (int m = 2 * gw; m < MTOK; m += 2 * NGW) {
        f32x4 v[2][4]; float s[2] = {0.f, 0.f};
#pragma unroll
        for (int q = 0; q < 2; ++q) { const GAS f32x4* xr = (const GAS f32x4*)(x + (size_t)(m + q) * DM) + F.lane;
#pragma unroll
            for (int j = 0; j < 4; ++j) v[q][j] = xr[64 * j]; }
#pragma unroll
        for (int q = 0; q < 2; ++q) {
#pragma unroll
            for (int j = 0; j < 4; ++j) s[q] += (v[q][j].x * v[q][j].x + v[q][j].y * v[q][j].y) + (v[q][j].z * v[q][j].z + v[q][j].w * v[q][j].w);
            s[q] = wave_sum(s[q]);
            GAS u32x2* o8 = (GAS u32x2*)(XB + (size_t)(m + q) * DM) + F.lane;
#pragma unroll
            for (int j = 0; j < 4; ++j) { u32x2 w; w.x = cvtpk(v[q][j].x, v[q][j].y); w.y = cvtpk(v[q][j].z, v[q][j].w); o8[64 * j] = w; }
            if (F.lane == 0) RS1[m + q] = __builtin_amdgcn_rsqf(s[q] * (1.0f / DM) + EPSN); }
    }
}

namespace att {
constexpr int SLOT16 = 16384, NSLOT = 5, L_OST = NSLOT * SLOT16, L_FLAG = L_OST + NWAVES * 4096;
__device__ __forceinline__ int crow(int r, int hi) { return (r & 3) + 8 * (r >> 2) + 4 * hi; }
typedef const LAS unsigned char* lptr;
template <bool DIAG> __device__ __forceinline__ void tile(lptr kslot, int vb, const bf16x8 (&qr)[4], f32x16 (&o)[2], float& R, int kbase, int qpos, int r32, int hi) {
    f32x16 p0 = f32x16{}, p1 = f32x16{};
    { lptr kb = kslot + hi * 1024 + r32 * 16;
#pragma unroll
      for (int d0 = 0; d0 < 4; ++d0) { const bf16x8 b0 = *(const LAS bf16x8*)(kb + d0 * 2048), b1 = *(const LAS bf16x8*)(kb + d0 * 2048 + 512);
          p0 = __builtin_amdgcn_mfma_f32_32x32x16_bf16(b0, qr[d0], p0, 0, 0, 0); p1 = __builtin_amdgcn_mfma_f32_32x32x16_bf16(b1, qr[d0], p1, 0, 0, 0); } }
    f32x16 K0, K1;
#pragma unroll
    for (int r = 0; r < 16; ++r) {
        const int kk = kbase + (r & 3) + 8 * (r >> 2);
        { const float x = __builtin_amdgcn_fmed3f(p0[r], -100.f, 100.f); const float e = fexp2(-x); float bt = frcp(1.0f + e); float kp = e * bt; if (DIAG && !(kk < qpos)) { kp = 1.f; bt = 0.f; } K0[r] = kp; p0[r] = bt; }
        { const float x = __builtin_amdgcn_fmed3f(p1[r], -100.f, 100.f); const float e = fexp2(-x); float bt = frcp(1.0f + e); float kp = e * bt; if (DIAG && !(kk + 32 < qpos)) { kp = 1.f; bt = 0.f; } K1[r] = kp; p1[r] = bt; }
    }
    float Gs[2][4], T[2][4];
#pragma unroll
    for (int bq = 0; bq < 4; ++bq) {
        const float g0 = (K0[4 * bq] * K0[4 * bq + 1]) * (K0[4 * bq + 2] * K0[4 * bq + 3]), g1 = (K1[4 * bq] * K1[4 * bq + 1]) * (K1[4 * bq + 2] * K1[4 * bq + 3]);
        auto r0 = __builtin_amdgcn_permlane32_swap(__float_as_uint(g0), __float_as_uint(g0), false, false);
        auto r1 = __builtin_amdgcn_permlane32_swap(__float_as_uint(g1), __float_as_uint(g1), false, false);
        Gs[0][bq] = hi ? 1.0f : __uint_as_float(r0[1]); T[0][bq] = __uint_as_float(r0[0]) * __uint_as_float(r0[1]);
        Gs[1][bq] = hi ? 1.0f : __uint_as_float(r1[1]); T[1][bq] = __uint_as_float(r1[0]) * __uint_as_float(r1[1]);
    }
    float cum = fexp2(R), tt0 = 1.0f, tt1 = 1.0f;
#pragma unroll
    for (int a = 1; a >= 0; --a)
#pragma unroll
        for (int bq = 3; bq >= 0; --bq) {
            const float s3 = cum * Gs[a][bq];
            if (a == 1) { const float s2 = s3 * K1[4 * bq + 3], s1 = s2 * K1[4 * bq + 2], s0 = s1 * K1[4 * bq + 1];
                p1[4 * bq + 3] *= s3; p1[4 * bq + 2] *= s2; p1[4 * bq + 1] *= s1; p1[4 * bq] *= s0; }
            else { const float s2 = s3 * K0[4 * bq + 3], s1 = s2 * K0[4 * bq + 2], s0 = s1 * K0[4 * bq + 1];
                p0[4 * bq + 3] *= s3; p0[4 * bq + 2] *= s2; p0[4 * bq + 1] *= s1; p0[4 * bq] *= s0; }
            cum *= T[a][bq]; if (a == 1) tt1 *= T[a][bq]; else tt0 *= T[a][bq];
        }
    R += flog2(tt1) + flog2(tt0);
    v4u pw0, pw1, pw2, pw3;
    pw0.x = cvtpk(p0[0], p0[1]); pw0.y = cvtpk(p0[2], p0[3]); pw0.z = cvtpk(p0[4], p0[5]); pw0.w = cvtpk(p0[6], p0[7]);
    pw1.x = cvtpk(p0[8], p0[9]); pw1.y = cvtpk(p0[10], p0[11]); pw1.z = cvtpk(p0[12], p0[13]); pw1.w = cvtpk(p0[14], p0[15]);
    pw2.x = cvtpk(p1[0], p1[1]); pw2.y = cvtpk(p1[2], p1[3]); pw2.z = cvtpk(p1[4], p1[5]); pw2.w = cvtpk(p1[6], p1[7]);
    pw3.x = cvtpk(p1[8], p1[9]); pw3.y = cvtpk(p1[10], p1[11]); pw3.z = cvtpk(p1[12], p1[13]); pw3.w = cvtpk(p1[14], p1[15]);
#pragma unroll
    for (int d0 = 0; d0 < 2; ++d0) { s16x4 lo[4], hh[4];
#pragma unroll
        for (int ks = 0; ks < 4; ++ks) {
            asm volatile("ds_read_b64_tr_b16 %0,%1 offset:%c2" : "=&v"(lo[ks]) : "v"(vb), "i"(d0 * 4096 + ks * 1024) : "memory");
            asm volatile("ds_read_b64_tr_b16 %0,%1 offset:%c2" : "=&v"(hh[ks]) : "v"(vb), "i"(d0 * 4096 + ks * 1024 + 512) : "memory"); }
        asm volatile("s_waitcnt lgkmcnt(0)" ::: "memory"); __builtin_amdgcn_sched_barrier(0);
#define ATT_PK(k) (bf16x8){lo[k][0], lo[k][1], lo[k][2], lo[k][3], hh[k][0], hh[k][1], hh[k][2], hh[k][3]}
        o[d0] = __builtin_amdgcn_mfma_f32_32x32x16_bf16(__builtin_bit_cast(bf16x8, pw0), ATT_PK(0), o[d0], 0, 0, 0);
        o[d0] = __builtin_amdgcn_mfma_f32_32x32x16_bf16(__builtin_bit_cast(bf16x8, pw1), ATT_PK(1), o[d0], 0, 0, 0);
        o[d0] = __builtin_amdgcn_mfma_f32_32x32x16_bf16(__builtin_bit_cast(bf16x8, pw2), ATT_PK(2), o[d0], 0, 0, 0);
        o[d0] = __builtin_amdgcn_mfma_f32_32x32x16_bf16(__builtin_bit_cast(bf16x8, pw3), ATT_PK(3), o[d0], 0, 0, 0);
#undef ATT_PK
    }
}
__device__ __forceinline__ void unit(Frame& F, int b, int h, int qb, const bf16* PROJ, bf16* Y) {
    const int lane = (opq((int)threadIdx.x) & 63), r32 = lane & 31, hi = lane >> 5, wid = F.wave;
    LAS unsigned char* shm = F.lds;
    const long rowbase = (long)b * SEQ; const int q0 = qb * 256;
    const bf16* Qw = PROJ + (rowbase + q0 + wid * 32) * DIN + COL_Q + h * HD;
    const bf16* Kh = PROJ + rowbase * DIN + COL_K + h * HD; const bf16* Vh = PROJ + rowbase * DIN + COL_V + h * HD;
    bf16x8 qr[4];
#pragma unroll
    for (int d0 = 0; d0 < 4; ++d0) qr[d0] = *(const GAS bf16x8*)(Qw + (long)r32 * DIN + d0 * 16 + hi * 8);
    f32x16 o[2]; o[0] = f32x16{}; o[1] = f32x16{};
    float R = 0.f;
    const int Dt = 4 * qb + (wid >> 1);
    const int qpos = q0 + wid * 32 + r32;
    bool wave_done = false;
    const bf16* ksrc = Kh + (long)lane * DIN + wid * 8;
    const bf16* vsrc = Vh + (long)(16 * (wid & 3) + (lane >> 2)) * DIN + (wid >> 2) * 32 + (lane & 3) * 8;
    LAS unsigned char* kdst = shm + wid * 1024 + lane * 16; LAS unsigned char* vdst = shm + 8192 + wid * 1024 + lane * 16;
    const int vb0 = (int)(uintptr_t)(shm + 8192) + ((lane >> 4) & 1) * 32 + (lane & 3) * 8 + (4 * hi + ((lane & 15) >> 2)) * 64;
    volatile LAS int* flag = (volatile LAS int*)(shm + L_FLAG);
    { v4u kr[4], vr[4];
#pragma unroll
      for (int p = 0; p < 4; ++p) { kr[p] = *(const GAS v4u*)(ksrc + (long)(4 * qb + p) * 64 * DIN); vr[p] = *(const GAS v4u*)(vsrc + (long)(4 * qb + p) * 64 * DIN); }
#pragma unroll
      for (int p = 0; p < 4; ++p) { const int sl = (4 * qb + p) % NSLOT; *(LAS v4u*)(kdst + sl * SLOT16) = kr[p]; *(LAS v4u*)(vdst + sl * SLOT16) = vr[p]; } }
    LDS_WAIT(); WG_SYNC();
    v4u kreg, vreg;
    for (int j = 0;; ++j) {
        const int tn = 4 * qb - j - 1;
        if (tn >= 0) { kreg = *(const GAS v4u*)(ksrc + (long)tn * 64 * DIN); vreg = *(const GAS v4u*)(vsrc + (long)tn * 64 * DIN); }
        const int t = Dt - j; const int s = (t >= 0) ? (t % NSLOT) : 0;
        if (t >= 0 && !wave_done) {
            if (j == 0) tile<true>(shm + s * SLOT16, vb0 + s * SLOT16, qr, o, R, t * 64 + 4 * hi, qpos, r32, hi);
            else tile<false>(shm + s * SLOT16, vb0 + s * SLOT16, qr, o, R, t * 64 + 4 * hi, qpos, r32, hi);
            wave_done = __all(R < -EXIT_THR2);
        }
        if (t <= 0) wave_done = true;
        if (lane == 0) flag[(j & 1) * 8 + wid] = wave_done ? 1 : 0;
        if (tn >= 0) { const int sl = tn % NSLOT; *(LAS v4u*)(kdst + sl * SLOT16) = kreg; *(LAS v4u*)(vdst + sl * SLOT16) = vreg; }
        LDS_WAIT(); WG_SYNC();
        int alld = 1;
#pragma unroll
        for (int w = 0; w < 8; ++w) alld &= flag[(j & 1) * 8 + w];
        if (alld) break;
    }
    { LAS bf16* stg = (LAS bf16*)(shm + L_OST) + wid * 2048;
#pragma unroll
      for (int r = 0; r < 16; ++r) { const int orow = crow(r, hi);
#pragma unroll
          for (int d0 = 0; d0 < 2; ++d0) stg[orow * 64 + d0 * 32 + r32] = (bf16)(cvtpk(o[d0][r], 0.f) & 0xffffu); }
      LDS_WAIT(); asm volatile("" ::: "memory");
      bf16* Ow = Y + (rowbase + q0 + wid * 32) * DM + h * HD;
#pragma unroll
      for (int i = 0; i < 4; ++i) { const int row = i * 8 + (lane >> 3), ch = lane & 7; const v4u v = *(const LAS v4u*)(stg + row * 64 + ch * 8); *(GAS v4u*)(Ow + (long)row * DM + ch * 8) = v; } }
    LDS_WAIT(); WG_SYNC();
}
}

namespace conf {
constexpr int TM = 64, HALO = 30, UROWS = TM + HALO;
constexpr int L_U = 0  , L_Z = 49152  , L_S = 0  , ZS = 260, SS = 264;
__device__ __forceinline__ void unit(Frame& F, int ut, int l, const bf16* PROJ, bf16* Y) {
    const int tid = opq((int)threadIdx.x), lane = tid & 63, wid = F.wave;
    const int row0 = ut * TM; const int t0 = row0 % SEQ;
    LAS bf16* U = (LAS bf16*)(F.lds + L_U); LAS float* Z = (LAS float*)(F.lds + L_Z); LAS bf16* S = (LAS bf16*)(F.lds + L_S);
    const float* dw_w = F.in[12] + (size_t)l * 31 * DCONF; const float* dw_b = F.in[13] + l * DCONF; const float* ln_g = F.in[14] + l * DCONF; const float* ln_b = F.in[15] + l * DCONF;
    const float* pw_b = F.in[17] + l * DCONF; const bf16* PW = (const bf16*)(F.ws + WS_PW);
    bf16x8 bfr[8][2];
    { const int fr_ = lane & 15, fq_ = lane >> 4;
#pragma unroll
      for (int ks = 0; ks < 8; ++ks)
#pragma unroll
          for (int n = 0; n < 2; ++n) bfr[ks][n] = *(const GAS bf16x8*)(PW + (size_t)(32 * wid + 16 * n + fr_) * DCONF + 32 * ks + 8 * fq_); }
    { const int c8 = tid & 31, ur0 = tid >> 5; v4u av[6], gv[6];
#pragma unroll
      for (int it = 0; it < 6; ++it) { const int ur = ur0 + 16 * it; const int t = t0 - HALO + ur; av[it] = (v4u){0u, 0u, 0u, 0u}; gv[it] = av[it];
          if (ur < UROWS && t >= 0) { const bf16* pr = PROJ + (size_t)(row0 - HALO + ur) * DIN + COL_XC + c8 * 8; av[it] = *(const GAS v4u*)pr; gv[it] = *(const GAS v4u*)(pr + 256); } }
#pragma unroll
      for (int it = 0; it < 6; ++it) { const int ur = ur0 + 16 * it; if (ur < UROWS) { const unsigned a4[4] = {av[it].x, av[it].y, av[it].z, av[it].w}, g4[4] = {gv[it].x, gv[it].y, gv[it].z, gv[it].w}; unsigned ov[4];
#pragma unroll
              for (int j = 0; j < 4; ++j) ov[j] = cvtpk(bflo(a4[j]) * sigmoidf_(bflo(g4[j])), bfhi(a4[j]) * sigmoidf_(bfhi(g4[j])));
              *(LAS v4u*)(U + ur * 256 + c8 * 8) = (v4u){ov[0], ov[1], ov[2], ov[3]}; } } }
    LDS_WAIT(); WG_SYNC();
    { const int c = tid & 255, hf = tid >> 8; float w[31];
#pragma unroll
      for (int j = 0; j < 31; ++j) w[j] = dw_w[j * DCONF + c];
      const float bias = dw_b[c]; float acc[32];
#pragma unroll
      for (int i = 0; i < 32; ++i) acc[i] = bias;
      const LAS bf16* up = U + (hf * 32) * 256 + c;
#pragma unroll
      for (int rho = 0; rho < 62; ++rho) { const float x = __uint_as_float((unsigned)up[rho * 256] << 16);
#pragma unroll
          for (int i = 0; i < 32; ++i) { const int j = rho - i; if (j >= 0 && j <= 30) acc[i] += w[j] * x; } }
#pragma unroll
      for (int i = 0; i < 32; ++i) Z[(hf * 32 + i) * ZS + c] = acc[i]; }
    LDS_WAIT(); WG_SYNC();
    { const f32x4 g = *(const GAS f32x4*)(ln_g + 4 * lane), bb = *(const GAS f32x4*)(ln_b + 4 * lane);
      for (int i = 0; i < 8; ++i) { const int tk = wid * 8 + i; f32x4 v = *(const LAS f32x4*)(Z + tk * ZS + 4 * lane);
          const float mean = wave_sum((v.x + v.y) + (v.z + v.w)) * (1.0f / 256.0f); v = v - mean;
          const float var = wave_sum((v.x * v.x + v.y * v.y) + (v.z * v.z + v.w * v.w)) * (1.0f / 256.0f); const float rstd = __builtin_amdgcn_rsqf(var + EPSN);
          f32x4 y = v * rstd * g + bb; y.x *= sigmoidf_(y.x); y.y *= sigmoidf_(y.y); y.z *= sigmoidf_(y.z); y.w *= sigmoidf_(y.w);
          u32x2 w2; w2.x = cvtpk(y.x, y.y); w2.y = cvtpk(y.z, y.w); *(LAS u32x2*)(S + tk * SS + 4 * lane) = w2; } }
    LDS_WAIT(); WG_SYNC();
    { const int fr = lane & 15, fq = lane >> 4; f32x4 acc[4][2];
#pragma unroll
      for (int m = 0; m < 4; ++m) { acc[m][0] = (f32x4){0.f, 0.f, 0.f, 0.f}; acc[m][1] = (f32x4){0.f, 0.f, 0.f, 0.f}; }
#pragma unroll
      for (int ks = 0; ks < 8; ++ks) { bf16x8 afr[4];
#pragma unroll
          for (int m = 0; m < 4; ++m) afr[m] = *(const LAS bf16x8*)(S + (16 * m + fr) * SS + 32 * ks + 8 * fq);
#pragma unroll
          for (int m = 0; m < 4; ++m)
#pragma unroll
              for (int n = 0; n < 2; ++n) acc[m][n] = __builtin_amdgcn_mfma_f32_16x16x32_bf16(afr[m], bfr[ks][n], acc[m][n], 0, 0, 0); }
#pragma unroll
      for (int m = 0; m < 4; ++m)
#pragma unroll
          for (int n = 0; n < 2; ++n)
#pragma unroll
              for (int i = 0; i < 4; ++i) Z[(16 * m + 4 * fq + i) * ZS + 32 * wid + 16 * n + fr] = acc[m][n][i]; }
    LDS_WAIT(); WG_SYNC();
    { const f32x4 pb = *(const GAS f32x4*)(pw_b + 4 * lane);
      for (int i = 0; i < 8; ++i) { const int tk = wid * 8 + i; f32x4 v = *(const LAS f32x4*)(Z + tk * ZS + 4 * lane) + pb;
          const float ss = wave_sum((v.x * v.x + v.y * v.y) + (v.z * v.z + v.w * v.w)); const float rs = __builtin_amdgcn_rsqf(ss * (1.0f / 256.0f) + EPSN); v = v * rs;
          u32x2 w2; w2.x = cvtpk(v.x, v.y); w2.y = cvtpk(v.z, v.w); *(GAS u32x2*)(Y + (size_t)(row0 + tk) * DM + 768 + 4 * lane) = w2; } }
    LDS_WAIT(); WG_SYNC();
}
}

namespace lru {
constexpr int TM = 64, XS_ = 260, XBS = 264;
constexpr int L_XC = 0  , L_A = 66560  , L_XB = 66560  ;
__device__ __forceinline__ void unit(Frame& F, int ut, int l, const bf16* PROJ, bf16* HL, bf16* PL, float* SUMM) {
    const int tid = opq((int)threadIdx.x), lane = tid & 63, wid = F.wave;
    const int row0 = ut * TM; const int t0 = row0 % SEQ;
    LAS float* XC = (LAS float*)(F.lds + L_XC); LAS float* A = (LAS float*)(F.lds + L_A); LAS bf16* XB = (LAS bf16*)(F.lds + L_XB);
    const float* cw = F.in[5] + (size_t)l * 4 * DLRU; const float* cb = F.in[6] + l * DLRU; const float* ba = F.in[8] + l * DLRU; const float* bx = F.in[10] + l * DLRU; const float* lam = F.in[11] + l * DLRU;
    const bf16* LW = (const bf16*)(F.ws + WS_LRUW);
    const int nb = wid >> 1, mh = wid & 1, fr = lane & 15, fq = lane >> 4;
    bf16x8 bA[2][4], bX[2][4];
#pragma unroll
    for (int ks = 0; ks < 2; ++ks)
#pragma unroll
        for (int n = 0; n < 4; ++n) { bA[ks][n] = *(const GAS bf16x8*)(LW + (size_t)nb * 4096 + (16 * n + fr) * 64 + 32 * ks + 8 * fq); bX[ks][n] = *(const GAS bf16x8*)(LW + (size_t)(4 + nb) * 4096 + (16 * n + fr) * 64 + 32 * ks + 8 * fq); }
    { const int c8 = tid & 31, tk0 = tid >> 5; f32x4 w0[4], w1[4];
#pragma unroll
      for (int j = 0; j < 4; ++j) { w0[j] = *(const GAS f32x4*)(cw + j * DLRU + c8 * 8); w1[j] = *(const GAS f32x4*)(cw + j * DLRU + c8 * 8 + 4); }
      const f32x4 b0 = *(const GAS f32x4*)(cb + c8 * 8), b1 = *(const GAS f32x4*)(cb + c8 * 8 + 4);
      v4u xr[4][4];
#pragma unroll
      for (int it = 0; it < 4; ++it)
#pragma unroll
          for (int j = 0; j < 4; ++j) { const int tk = tk0 + 16 * it; xr[it][j] = (v4u){0u, 0u, 0u, 0u}; if (t0 + tk - 3 + j >= 0) xr[it][j] = *(const GAS v4u*)(PROJ + (size_t)(row0 + tk - 3 + j) * DIN + COL_XR + c8 * 8); }
#pragma unroll
      for (int it = 0; it < 4; ++it) { const int tk = tk0 + 16 * it; float acc[8] = {b0.x, b0.y, b0.z, b0.w, b1.x, b1.y, b1.z, b1.w};
#pragma unroll
          for (int j = 0; j < 4; ++j) { const v4u a = xr[it][j];
              acc[0] += w0[j].x * bflo(a.x); acc[1] += w0[j].y * bfhi(a.x); acc[2] += w0[j].z * bflo(a.y); acc[3] += w0[j].w * bfhi(a.y);
              acc[4] += w1[j].x * bflo(a.z); acc[5] += w1[j].y * bfhi(a.z); acc[6] += w1[j].z * bflo(a.w); acc[7] += w1[j].w * bfhi(a.w); }
          *(LAS f32x4*)(XC + tk * XS_ + c8 * 8) = (f32x4){acc[0], acc[1], acc[2], acc[3]}; *(LAS f32x4*)(XC + tk * XS_ + c8 * 8 + 4) = (f32x4){acc[4], acc[5], acc[6], acc[7]};
          v4u o; o.x = cvtpk(acc[0], acc[1]); o.y = cvtpk(acc[2], acc[3]); o.z = cvtpk(acc[4], acc[5]); o.w = cvtpk(acc[6], acc[7]); *(LAS v4u*)(XB + tk * XBS + c8 * 8) = o; } }
    LDS_WAIT(); WG_SYNC();
    f32x4 ar[2][4], ai[2][4];
#pragma unroll
    for (int m = 0; m < 2; ++m)
#pragma unroll
        for (int n = 0; n < 4; ++n) { ar[m][n] = (f32x4){0.f, 0.f, 0.f, 0.f}; ai[m][n] = (f32x4){0.f, 0.f, 0.f, 0.f}; }
#pragma unroll
    for (int ks = 0; ks < 2; ++ks) { bf16x8 af[2];
#pragma unroll
        for (int m = 0; m < 2; ++m) af[m] = *(const LAS bf16x8*)(XB + (32 * mh + 16 * m + fr) * XBS + 64 * nb + 32 * ks + 8 * fq);
#pragma unroll
        for (int n = 0; n < 4; ++n) {
#pragma unroll
            for (int m = 0; m < 2; ++m) { ar[m][n] = __builtin_amdgcn_mfma_f32_16x16x32_bf16(af[m], bA[ks][n], ar[m][n], 0, 0, 0); ai[m][n] = __builtin_amdgcn_mfma_f32_16x16x32_bf16(af[m], bX[ks][n], ai[m][n], 0, 0, 0); } } }
    LDS_WAIT(); WG_SYNC();
#pragma unroll
    for (int n = 0; n < 4; ++n) { const int ch = 64 * nb + 16 * n + fr; const float lsl8 = -8.0f * log1pf(__expf(-lam[ch])), bav = ba[ch], bxv = bx[ch];
#pragma unroll
        for (int m = 0; m < 2; ++m)
#pragma unroll
            for (int i = 0; i < 4; ++i) { const int tk = 32 * mh + 16 * m + 4 * fq + i; const float gr = ar[m][n][i] + bav, gi = ai[m][n][i] + bxv; const float xcv = XC[tk * XS_ + ch];
                const float la = lsl8 * sigmoidf_(gr); const float a = fexp2(LOG2E * la); const float mult = __builtin_sqrtf(__builtin_fmaxf(1.0f - a * a, 0.f));
                A[tk * XS_ + ch] = a; XC[tk * XS_ + ch] = mult * sigmoidf_(gi) * xcv; } }
    LDS_WAIT(); WG_SYNC();
    if (tid < 256) { const int c = tid; float h = 0.f, p = 1.f; bf16* hl = HL + (size_t)row0 * DLRU + c; bf16* pl = PL + (size_t)row0 * DLRU + c;
#pragma unroll 8
        for (int tk = 0; tk < TM; ++tk) { const float a = A[tk * XS_ + c], u = XC[tk * XS_ + c]; p *= a; h = a * h + u; hl[(size_t)tk * DLRU] = (bf16)(cvtpk(h, 0.f) & 0xffffu); pl[(size_t)tk * DLRU] = (bf16)(cvtpk(p, 0.f) & 0xffffu); }
        SUMM[(size_t)ut * 512 + c] = p; SUMM[(size_t)ut * 512 + 256 + c] = h; }
    LDS_WAIT(); WG_SYNC();
}
}

__device__ __forceinline__ void fixup_unit(Frame& F, int ut, const bf16* PROJ, const bf16* HL, const bf16* PL, const float* SUMM, bf16* Y) {
    const int tid = opq((int)threadIdx.x), lane = tid & 63, wid = F.wave; const int row0 = ut * 64; const int cb = (row0 % SEQ) / 64, ub0 = ut - cb;
    LAS float* CAR = (LAS float*)F.lds;
    { const int c = tid & 255, hf = tid >> 8; const int mid = cb >> 1; const int j0 = hf ? mid : 0, j1 = hf ? cb : mid; float P = 1.f, H = 0.f;
#pragma unroll 16
      for (int j = j0; j < j1; ++j) { const float p = SUMM[(size_t)(ub0 + j) * 512 + c], h = SUMM[(size_t)(ub0 + j) * 512 + 256 + c]; H = p * H + h; P = p * P; }
      CAR[hf * 512 + c] = P; CAR[hf * 512 + 256 + c] = H; }
    LDS_WAIT(); WG_SYNC();
    f32x4 car;
    { const f32x4 h0 = *(const LAS f32x4*)(CAR + 256 + 4 * lane), p1 = *(const LAS f32x4*)(CAR + 512 + 4 * lane), h1 = *(const LAS f32x4*)(CAR + 768 + 4 * lane); car = p1 * h0 + h1; }
#pragma unroll 4
    for (int i = 0; i < 8; ++i) { const size_t row = (size_t)row0 + wid * 8 + i;
        const u32x2 hl = *(const GAS u32x2*)(HL + row * DLRU + 4 * lane), pl = *(const GAS u32x2*)(PL + row * DLRU + 4 * lane);
        const u32x2 xg = *(const GAS u32x2*)(PROJ + row * DIN + COL_XG + 4 * lane); const v4u ya = *(const GAS v4u*)(Y + row * DM + 8 * lane);
        const float hv[4] = {bflo(hl.x) + bflo(pl.x) * car.x, bfhi(hl.x) + bfhi(pl.x) * car.y, bflo(hl.y) + bflo(pl.y) * car.z, bfhi(hl.y) + bfhi(pl.y) * car.w};
        const float xv[4] = {bflo(xg.x), bfhi(xg.x), bflo(xg.y), bfhi(xg.y)}; float y[4];
#pragma unroll
        for (int j = 0; j < 4; ++j) { const float x = xv[j]; const float u2 = 1.5957691216057308f * (x + 0.044715f * x * x * x); y[j] = hv[j] * x * sigmoidf_(u2); }
        const float ssb = wave_sum((y[0] * y[0] + y[1] * y[1]) + (y[2] * y[2] + y[3] * y[3])); const float rsb = __builtin_amdgcn_rsqf(ssb * (1.0f / 256.0f) + EPSN);
        u32x2 w2; w2.x = cvtpk(y[0] * rsb, y[1] * rsb); w2.y = cvtpk(y[2] * rsb, y[3] * rsb); *(GAS u32x2*)(Y + row * DM + 512 + 4 * lane) = w2;
        float a[8] = {bflo(ya.x), bfhi(ya.x), bflo(ya.y), bfhi(ya.y), bflo(ya.z), bfhi(ya.z), bflo(ya.w), bfhi(ya.w)}; float ssa = 0.f;
#pragma unroll
        for (int j = 0; j < 8; ++j) ssa += a[j] * a[j];
        ssa = wave_sum(ssa); const float rsa = __builtin_amdgcn_rsqf(ssa * (1.0f / 512.0f) + EPSN);
        v4u oa; oa.x = cvtpk(a[0] * rsa, a[1] * rsa); oa.y = cvtpk(a[2] * rsa, a[3] * rsa); oa.z = cvtpk(a[4] * rsa, a[5] * rsa); oa.w = cvtpk(a[6] * rsa, a[7] * rsa);
        *(GAS v4u*)(Y + row * DM + 8 * lane) = oa; }
    LDS_WAIT(); WG_SYNC();
}

__device__ __forceinline__ void router_unit(Frame& F, int ut, int l, const bf16* X, float* RS2, int* TOKE, int* TOKR, int* STV, float* RSV, float* GTV) {
    const int tid = opq((int)threadIdx.x), lane = tid & 63, wid = F.wave, fr = lane & 15, fq = lane >> 4;
    constexpr int WROW = 1040, WHALF = NRTP * WROW;
    LAS unsigned char* WL_ = F.lds;
    LAS float* LG = (LAS float*)(F.lds + 102400) + wid * (16 * NRTP + 16);
    LAS int* CNT = (LAS int*)(F.lds + 102400 + 8 * (16 * NRTP + 16) * 4); LAS int* BASE = CNT + 32;
    if (tid < 32) CNT[tid] = 0;
    const int r0 = ut * 128 + wid * 16;
    const bf16* WRH = (const bf16*)(F.ws + WS_WR);
    f32x4 acc[3]; acc[0] = (f32x4){0.f, 0.f, 0.f, 0.f}; acc[1] = acc[0]; acc[2] = acc[0]; float ss = 0.f;
    const bf16* xp = X + (size_t)(r0 + fr) * DM + 8 * fq;
#pragma unroll 1
    for (int kh = 0; kh < 2; ++kh) {
        if (kh) { LDS_WAIT(); WG_SYNC(); }
        { v4u wv[12];
#pragma unroll
          for (int q = 0; q < 12; ++q) { const int ch = tid + q * NTHR, hl = ch / 3072, rr = (ch % 3072) >> 6, cc = ch & 63; wv[q] = *(const GAS v4u*)(WRH + (size_t)hl * NRTP * DM + (size_t)rr * DM + kh * 512 + cc * 8); }
#pragma unroll
          for (int q = 0; q < 12; ++q) { const int ch = tid + q * NTHR, hl = ch / 3072, rr = (ch % 3072) >> 6, cc = ch & 63; *(LAS v4u*)(WL_ + hl * WHALF + rr * WROW + cc * 16) = wv[q]; } }
        bf16x8 av[16];
#pragma unroll
        for (int s = 0; s < 16; ++s) av[s] = *(const GAS bf16x8*)(xp + kh * 512 + 32 * s);
        LDS_WAIT(); WG_SYNC();
#pragma unroll
        for (int s = 0; s < 16; ++s) {
#pragma unroll
            for (int j = 0; j < 8; ++j) { const float xv = __uint_as_float((unsigned)(unsigned short)av[s][j] << 16); ss += xv * xv; }
#pragma unroll
            for (int n = 0; n < 3; ++n) { const LAS unsigned char* wp = WL_ + (16 * n + fr) * WROW + (32 * s + 8 * fq) * 2;
                const bf16x8 bh = *(const LAS bf16x8*)wp, bl = *(const LAS bf16x8*)(wp + WHALF);
                acc[n] = __builtin_amdgcn_mfma_f32_16x16x32_bf16(av[s], bh, acc[n], 0, 0, 0); acc[n] = __builtin_amdgcn_mfma_f32_16x16x32_bf16(av[s], bl, acc[n], 0, 0, 0); } }
    }
    ss += __shfl_xor(ss, 16); ss += __shfl_xor(ss, 32);
    const float rs = __builtin_amdgcn_rsqf(ss * (1.0f / DM) + EPSN);
    if (fq == 0) LG[16 * NRTP + fr] = rs;
#pragma unroll
    for (int n = 0; n < 3; ++n)
#pragma unroll
        for (int i = 0; i < 4; ++i) LG[(4 * fq + i) * NRTP + 16 * n + fr] = acc[n][i];
    LDS_WAIT(); WG_SYNC();
    int e0 = 0, e1 = 0, lr0 = 0, lr1 = 0; float g0 = 0.f, g1 = 0.f, rsv = 0.f;
    if (lane < 16) { const LAS float* lg = LG + lane * NRTP; rsv = LG[16 * NRTP + lane];
        float c[4]; int grp = 0; float cm;
#pragma unroll
        for (int j = 0; j < 4; ++j) c[j] = lg[j] * rsv;
        cm = c[0];
#pragma unroll
        for (int j = 1; j < 4; ++j) if (c[j] > cm) { cm = c[j]; grp = j; }
        float den = 0.f;
#pragma unroll
        for (int j = 0; j < 4; ++j) den += __expf(c[j] - cm);
        const float wgrp = 1.0f / den;
        float v0 = -INFINITY, v1 = -INFINITY; int i0 = 0, i1 = 0;
#pragma unroll
        for (int j = 0; j < 8; ++j) { const float v = lg[4 + grp * 8 + j] * rsv; if (v > v0) { v1 = v0; i1 = i0; v0 = v; i0 = j; } else if (v > v1) { v1 = v; i1 = j; } }
        const float ex = __expf(v1 - v0); g0 = wgrp / (1.0f + ex); g1 = wgrp * ex / (1.0f + ex);
        e0 = grp * 8 + i0; e1 = grp * 8 + i1;
        lr0 = atomicAdd((int*)(CNT + e0), 1); lr1 = atomicAdd((int*)(CNT + e1), 1); }
    LDS_WAIT(); WG_SYNC();
    if (tid < 32) { const int c = CNT[tid]; int bse = 0; if (c > 0) bse = (int)__hip_atomic_fetch_add((unsigned*)(F.ctl + CW_CNT + 64 * l + tid), (unsigned)c, __ATOMIC_RELAXED, __HIP_MEMORY_SCOPE_AGENT); BASE[tid] = bse; }
    LDS_WAIT(); WG_SYNC();
    if (lane < 16) { const int tok = r0 + lane; const int k0 = BASE[e0] + lr0, k1 = BASE[e1] + lr1; RS2[tok] = rsv; TOKE[2 * tok] = e0; TOKE[2 * tok + 1] = e1; TOKR[2 * tok] = k0; TOKR[2 * tok + 1] = k1;
        STV[e0 * 32768 + k0] = tok; RSV[e0 * 32768 + k0] = rsv; GTV[e0 * 32768 + k0] = g0; STV[e1 * 32768 + k1] = tok; RSV[e1 * 32768 + k1] = rsv; GTV[e1 * 32768 + k1] = g1; }
    LDS_WAIT(); WG_SYNC();
}
__device__ __forceinline__ int moe_tables(Frame& F, int l, LAS int* PST, LAS int* CNT, LAS int* TE) {
    if (F.tid < 64) { const int e = F.tid & 31; const int c = (int)__hip_atomic_load(F.ctl + CW_CNT + 64 * l + e, __ATOMIC_RELAXED, __HIP_MEMORY_SCOPE_AGENT); const int pc = (c + 255) & ~255; int inc = pc;
#pragma unroll
        for (int o = 1; o < 32; o <<= 1) { const int t = __shfl_up(inc, o, 64); if ((F.tid & 31) >= o) inc += t; }
        if (F.tid < 32) { PST[e] = inc - pc; CNT[e] = c; if (e == 31) PST[NE] = inc; } }
    LDS_WAIT(); WG_SYNC();
    const int ntile = PST[NE] >> 8;
    for (int rt = F.tid; rt < ntile; rt += NTHR) { int e = 0;
        for (int j = 1; j < NE; ++j) if ((PST[j] >> 8) <= rt) e = j;
        TE[rt] = e; }
    LDS_WAIT(); WG_SYNC();
    return ntile;
}
__device__ __forceinline__ void combine_phase(Frame& F, int l, const bf16* X1, const int* TOKE, const int* TOKR, const bf16* OB, bool last_layer, bf16* X0, float* RS1, float* OUT) {
    LAS int* PST = (LAS int*)F.lds; LAS int* CNT = PST + 64; LAS int* TE = PST + 128;
    (void)moe_tables(F, l, PST, CNT, TE);
    const int gw = F.vcu * NWAVES + F.wave, NGW = F.G * NWAVES;
    for (int m = 2 * gw; m < MTOK; m += 2 * NGW) {
        u32x2 xv[2][4], oa[2][4], ob[2][4];
#pragma unroll
        for (int q = 0; q < 2; ++q) { const int mm = m + q; const int s0 = PST[TOKE[2 * mm]] + TOKR[2 * mm], s1 = PST[TOKE[2 * mm + 1]] + TOKR[2 * mm + 1];
            const GAS u32x2* xr = (const GAS u32x2*)(X1 + (size_t)mm * DM) + F.lane;
            const GAS u32x2* o0 = (const GAS u32x2*)(OB + (size_t)s0 * DM) + F.lane; const GAS u32x2* o1 = (const GAS u32x2*)(OB + (size_t)s1 * DM) + F.lane;
#pragma unroll
            for (int j = 0; j < 4; ++j) { xv[q][j] = xr[64 * j]; oa[q][j] = o0[64 * j]; ob[q][j] = o1[64 * j]; } }
#pragma unroll
        for (int q = 0; q < 2; ++q) { const int mm = m + q; float ss = 0.f; f32x4 v[4];
#pragma unroll
            for (int j = 0; j < 4; ++j) { const u32x2 x = xv[q][j], a = oa[q][j], b = ob[q][j];
                v[j].x = bflo(x.x) + (bflo(a.x) + bflo(b.x)); v[j].y = bfhi(x.x) + (bfhi(a.x) + bfhi(b.x)); v[j].z = bflo(x.y) + (bflo(a.y) + bflo(b.y)); v[j].w = bfhi(x.y) + (bfhi(a.y) + bfhi(b.y));
                ss += (v[j].x * v[j].x + v[j].y * v[j].y) + (v[j].z * v[j].z + v[j].w * v[j].w); }
            if (last_layer) { GAS f32x4* xw = (GAS f32x4*)(OUT + (size_t)mm * DM) + F.lane;
#pragma unroll
                for (int j = 0; j < 4; ++j) xw[64 * j] = v[j]; }
            else { ss = wave_sum(ss); GAS u32x2* o8 = (GAS u32x2*)(X0 + (size_t)mm * DM) + F.lane;
#pragma unroll
                for (int j = 0; j < 4; ++j) { u32x2 w; w.x = cvtpk(v[j].x, v[j].y); w.y = cvtpk(v[j].z, v[j].w); o8[64 * j] = w; }
                if (F.lane == 0) RS1[mm] = __builtin_amdgcn_rsqf(ss * (1.0f / DM) + EPSN); } }
    }
    LDS_WAIT(); WG_SYNC();
}

constexpr int PH_PER_LAYER = 8, N_PHASES = 1 + DEPTH * PH_PER_LAYER;
struct Args { const float* in[26]; float* out; unsigned char* ws; int ph_lo, ph_hi; };
__global__ void __launch_bounds__(NTHR, 2) mk_fwd(Args args) {
    extern __shared__ __attribute__((aligned(16))) unsigned char lds[];
    Frame F;
    F.lds = (LAS unsigned char*)lds;
    F.tid = threadIdx.x; F.lane = F.tid & 63; F.wave = __builtin_amdgcn_readfirstlane(F.tid >> 6);
    F.G = gridDim.x; { const int bx = blockIdx.x; F.vcu = (F.G % 8 == 0) ? (bx % 8) * (F.G / 8) + bx / 8 : bx; }
    F.in = args.in;
    F.out = args.out; F.ws = args.ws; F.ctl = (gu32*)(args.ws + WS_CTL);
    for (int u = F.tid; u < (LDS_BYTES - LDSCTL_OFF) / 4; u += NTHR) ((LAS unsigned*)(F.lds + LDSCTL_OFF))[u] = 0u;
    __syncthreads();
    const bool one_launch = (args.ph_hi - args.ph_lo) > 1;
    XcdBarrier bar; bar.bar = (unsigned*)(F.ctl + CW_BAR); bar.x = 0; bar.st = nullptr;
    if (one_launch) bar = xcd_barrier_post((unsigned*)(F.ctl + CW_BAR), (volatile LAS unsigned*)(F.lds + LDSCTL_OFF + 32));
    const int lo = args.ph_lo, hi = args.ph_hi;
#ifndef PH_MASK
#define PH_MASK 0x1fff
#endif
#define IN(k) (lo <= (k) && (k) < hi)
#define EN(j) (((PH_MASK) >> (j)) & 1)
#ifndef DBL_MASK
#define DBL_MASK 0
#endif
#define NREP(j) ((((DBL_MASK) >> (j)) & 1) ? 2 : 1)
#define PHASE_BEGIN() do { F.tid = opq((int)threadIdx.x); F.lane = F.tid & 63; F.wave = __builtin_amdgcn_readfirstlane(F.tid >> 6); { int v_ = F.vcu; asm volatile("" : "+s"(v_)); F.vcu = v_; } } while (0)
#define SEAM(k) do { if (IN(k) && IN((k) + 1)) xcd_barrier(bar); } while (0)
#define X0 ((bf16*)(F.ws + WS_X0))
#define X1 ((bf16*)(F.ws + WS_X1))
#define YB ((bf16*)F.out)
#define PROJ ((bf16*)(F.ws + WS_PROJ))
#define OB ((bf16*)(F.ws + WS_PROJ))
#define HB ((bf16*)(F.ws + WS_HP))
#define HL ((bf16*)(F.ws + WS_HP))
#define PL ((bf16*)(F.ws + WS_HP) + (size_t)MTOK * DLRU)
#define SUMM ((float*)(F.ws + WS_SUMM))
#define RS1 ((float*)(F.ws + WS_RS1))
#define RS2 ((float*)(F.ws + WS_RS2))
#define TOKE ((int*)(F.ws + WS_TOKE))
#define TOKR ((int*)(F.ws + WS_TOKR))
#define STV ((int*)(F.ws + WS_STV))
#define RSV ((float*)(F.ws + WS_RSV))
#define GTV ((float*)(F.ws + WS_GTV))
#define MOE_TABS() LAS int* PST = (LAS int*)(F.lds + SCR_BYTES - 2048); LAS int* CNTL = PST + 64; LAS int* TE = PST + 128; const int ntile = moe_tables(F, l, PST, CNTL, TE); \
    const pg8::MoeTabs tb{(const PG8_LAS int*)PST, (const PG8_LAS int*)CNTL, (const PG8_LAS int*)TE}

    if (EN(0) && IN(0)) { PHASE_BEGIN(); for (int rep = 0; rep < NREP(0); ++rep) { convert_weights(F, 0); x_to_bf16_rows(F, F.in[0], X0, RS1); }
        if (blockIdx.x == 0) { GAS unsigned* z = (GAS unsigned*)(X1 + (size_t)MTOK * DM); for (int i = F.tid; i < DM / 2; i += NTHR) z[i] = 0u;
            GAS unsigned* z8 = (GAS unsigned*)(F.ws + WS_X1F8 + (size_t)MTOK * DM); for (int i = F.tid; i < DM / 4; i += NTHR) z8[i] = 0u; } }
    SEAM(0);
    if (NREP(13) > 1) for (int rep = 0; rep < 10; ++rep) SEAM(0);
#pragma unroll 1
    for (int l = 0; l < DEPTH; ++l) {
        const int pb = 1 + l * PH_PER_LAYER;
        if (EN(1) && IN(pb + 0)) { PHASE_BEGIN(); pg8::Gemm g{X0, (const bf16*)(F.ws + WS_WIN), MTOK, DIN, DM}; pg8::StaticOrder S; S.init(MTOK, DIN, F.G, (int)blockIdx.x);
            pg8::EpiProj E{PROJ, RS1, F.in[3] + l * HD, F.in[4] + l * HD, DIN, QSCALE};
            for (int rep = 0; rep < NREP(1); ++rep) pg8::gemm_phase<pg8::EpiProj, pg8::StaticOrder, true, true>(F.lds, g, S, E); }
        SEAM(pb + 0);
        if (EN(2) && IN(pb + 1)) { PHASE_BEGIN();
            if (EN(10)) for (int rep = 0; rep < NREP(2); ++rep) for (int a = F.vcu; a < NB * NH * (SEQ / 256); a += F.G) { const int qb = a & 31, bh = a >> 5; att::unit(F, bh >> 3, bh & 7, qb, PROJ, YB); }
            if (EN(11)) for (int rep = 0; rep < NREP(3); ++rep) for (int u = F.vcu; u < MTOK / 64; u += F.G) conf::unit(F, u, l, PROJ, YB);
            if (EN(12)) for (int rep = 0; rep < NREP(4); ++rep) for (int u = F.vcu; u < MTOK / 64; u += F.G) lru::unit(F, u, l, PROJ, HL, PL, SUMM);
        }
        SEAM(pb + 1);
        if (EN(3) && IN(pb + 2)) { PHASE_BEGIN(); for (int rep = 0; rep < NREP(5); ++rep) for (int u = F.vcu; u < MTOK / 64; u += F.G) fixup_unit(F, u, PROJ, HL, PL, SUMM, YB); }
        SEAM(pb + 2);
        if (EN(4) && IN(pb + 3)) { PHASE_BEGIN(); pg8::Gemm g{YB, (const bf16*)(F.ws + WS_WOUT), MTOK, DM, DM}; pg8::StaticOrder S; S.init(MTOK, DM, F.G, (int)blockIdx.x);
            pg8::EpiResid E{X0, X1, DM, fp8_layer(l) ? (unsigned char*)(F.ws + WS_X1F8) : nullptr};
            for (int rep = 0; rep < NREP(6); ++rep) pg8::gemm_phase<pg8::EpiResid, pg8::StaticOrder, true, true>(F.lds, g, S, E); }
        SEAM(pb + 3);
        if (EN(5) && IN(pb + 4)) { PHASE_BEGIN(); for (int rep = NREP(10) - 1; rep >= 0; --rep) for (int u = F.vcu; u < MTOK / 128; u += F.G) router_unit(F, u, l + 2 * rep, X1, RS2, TOKE, TOKR, STV, RSV, GTV); }
        SEAM(pb + 4);
        if (EN(7) && IN(pb + 5)) { PHASE_BEGIN(); MOE_TABS();
            pg8::MoeOrder<true> S{ntile * 4, F.G, F.vcu, tb, STV, MTOK};
            if (fp8_layer(l)) { pg8::Gemm g{(const bf16*)(F.ws + WS_X1F8), (const bf16*)(F.ws + WS_W1F8), MAXSLOT, NE * 1024, DM / 2}; pg8::EpiSwiglu<true> E{HB, RSV, DE, tb};
                for (int rep = 0; rep < NREP(8); ++rep) pg8::gemm_phase<pg8::EpiSwiglu<true>, pg8::MoeOrder<true>, true, true, true>(F.lds, g, S, E); }
            else { pg8::Gemm g{X1, (const bf16*)(F.ws + WS_W1), MAXSLOT, NE * 1024, DM}; pg8::EpiSwiglu<false> E{HB, RSV, DE, tb};
                for (int rep = 0; rep < NREP(8); ++rep) pg8::gemm_phase<pg8::EpiSwiglu<false>, pg8::MoeOrder<true>, true, true, false>(F.lds, g, S, E); } }
        SEAM(pb + 5);
        if (EN(8) && IN(pb + 6)) { PHASE_BEGIN(); MOE_TABS();
            pg8::MoeOrder<false> S{ntile * 4, F.G, F.vcu, tb, STV, MTOK};
            if (fp8_layer(l)) { pg8::Gemm g{HB, (const bf16*)(F.ws + WS_W2F8), MAXSLOT, NE * 1024, DE / 2}; pg8::EpiGate E{OB, GTV, DM, tb, 1.0f / 256.0f};
                for (int rep = 0; rep < NREP(9); ++rep) pg8::gemm_phase<pg8::EpiGate, pg8::MoeOrder<false>, true, true, true>(F.lds, g, S, E); }
            else { pg8::Gemm g{HB, (const bf16*)(F.ws + WS_W2), MAXSLOT, NE * 1024, DE}; pg8::EpiGate E{OB, GTV, DM, tb, 1.0f};
                for (int rep = 0; rep < NREP(9); ++rep) pg8::gemm_phase<pg8::EpiGate, pg8::MoeOrder<false>, true, true, false>(F.lds, g, S, E); } }
        SEAM(pb + 6);
        if (EN(9) && IN(pb + 7)) { PHASE_BEGIN(); for (int rep = 0; rep < NREP(11); ++rep) combine_phase(F, l, X1, TOKE, TOKR, OB, l + 1 == DEPTH, X0, RS1, F.out); if (l + 1 < DEPTH) for (int rep = 0; rep < NREP(12); ++rep) convert_weights(F, l + 1); }
        if (l + 1 < DEPTH) SEAM(pb + 7);
    }
#undef IN
#undef SEAM
}

extern "C" void kernel_launch(void* const* d_in, const int* in_sizes, int n_in, void* d_out, int out_size, void* d_ws, size_t ws_size, hipStream_t stream) {
    static int grid = 0;
    if (grid == 0) {
        if (n_in != 26 || in_sizes[0] != MTOK * DM || out_size != MTOK * DM || ws_size < WS_END) { fprintf(stderr, "kernel_launch: unexpected shapes (n_in %d, in0 %d, out %d, ws %zu < %zu); nothing launched\n", n_in, n_in > 0 ? in_sizes[0] : -1, out_size, ws_size, (size_t)WS_END); grid = -1; return; }
        int dev = 0, cus = 0, per_cu = 0;
        if (hipGetDevice(&dev) != hipSuccess || hipDeviceGetAttribute(&cus, hipDeviceAttributeMultiprocessorCount, dev) != hipSuccess) { grid = -1; return; }
        if (hipFuncSetAttribute((const void*)mk_fwd, hipFuncAttributeMaxDynamicSharedMemorySize, LDS_BYTES) != hipSuccess) { fprintf(stderr, "kernel_launch: hipFuncSetAttribute failed\n"); grid = -1; return; }
        if (hipOccupancyMaxActiveBlocksPerMultiprocessor(&per_cu, (const void*)mk_fwd, NTHR, LDS_BYTES) != hipSuccess || per_cu < 1) { fprintf(stderr, "kernel_launch: occupancy query reports %d blocks per CU; nothing launched\n", per_cu); (void)hipGetLastError(); grid = -1; return; }
        grid = cus;
    }
    if (grid < 0) return;
    if (hipMemsetAsync((char*)d_ws + WS_CTL, 0, CTL_ZERO_BYTES, stream) != hipSuccess) { fprintf(stderr, "kernel_launch: memset failed\n"); return; }
    Args a{};
    for (int i = 0; i < 26; ++i) a.in[i] = (const float*)d_in[i];
    a.out = (float*)d_out; a.ws = (unsigned char*)d_ws;
#if defined(MK_PER_PHASE) && MK_PER_PHASE
    for (int p = 0; p < N_PHASES; ++p) { a.ph_lo = p; a.ph_hi = p + 1; hipLaunchKernelGGL(mk_fwd, dim3(grid), dim3(NTHR), LDS_BYTES, stream, a); }
#else
    a.ph_lo = 0; a.ph_hi = N_PHASES; hipLaunchKernelGGL(mk_fwd, dim3(grid), dim3(NTHR), LDS_BYTES, stream, a);
#endif
    const hipError_t le = hipPeekAtLastError();
    if (le != hipSuccess) fprintf(stderr, "kernel_launch: launch failed: %s\n", hipGetErrorName(le));
}
```
